# Optimizing an MI355X kernel written in HIP

```python
import math
import jax, jax.numpy as jnp
from jax import lax
import numpy as np

D_MODEL = 1024
BATCH = 2
SEQ = 16384
DEPTH = 1

MIX_WIDTH = D_MODEL
CONV_WIDTH = MIX_WIDTH // 2
ATTN_HEADS = 8
HEAD_DIM = (MIX_WIDTH - CONV_WIDTH) // ATTN_HEADS
ATTN_WIDTH = ATTN_HEADS * HEAD_DIM
CONV_K = 3
DILATED_CONFIGS = ((128, 1), (512, 4), (2048, 16))
Q_BLOCK = 128
NUM_BUCKETS = 32
MAX_DISTANCE = 1024
EPS = 1e-6
NEG = -1e30

kernel_name = "hybrid_shortconv_dilated_attn_block"


def rmsnorm(x, w):
    xf = x.astype(jnp.float32)
    y = xf * lax.rsqrt(jnp.mean(xf * xf, axis=-1, keepdims=True) + EPS)
    return (y * w.astype(jnp.float32)).astype(x.dtype)


def t5_bucket(rel):
    half_b = NUM_BUCKETS // 2
    max_exact = half_b // 2
    ret = jnp.where(rel > 0, half_b, 0)
    n = jnp.abs(rel)
    nf = jnp.maximum(n, 1).astype(jnp.float32)
    large = max_exact + (jnp.log(nf / max_exact) / math.log(MAX_DISTANCE / max_exact)
                         * (half_b - max_exact)).astype(jnp.int32)
    large = jnp.minimum(large, half_b - 1)
    return ret + jnp.where(n < max_exact, n, large)


def dilated_window_attention(q, k, v, rel_bias, window, dilation):
    b, s, nh, dh = q.shape
    half = window // (2 * dilation)
    length = s // dilation
    n_blk = -(-length // Q_BLOCK)
    padded = n_blk * Q_BLOCK
    kb_len = Q_BLOCK + 2 * half
    bd = b * dilation

    def to_residue(t):
        t = t.reshape(b, length, dilation, nh, dh)
        return t.transpose(0, 2, 3, 1, 4).reshape(bd, nh, length, dh)

    qr = jnp.pad(to_residue(q), ((0, 0), (0, 0), (0, padded - length), (0, 0)))
    qr = qr.reshape(bd, nh, n_blk, Q_BLOCK, dh)
    pad_kv = ((0, 0), (0, 0), (half, padded - length + half), (0, 0))
    kr = jnp.pad(to_residue(k), pad_kv)
    vr = jnp.pad(to_residue(v), pad_kv)

    key_idx = jnp.arange(n_blk)[:, None] * Q_BLOCK + jnp.arange(kb_len)[None, :]
    kblk = kr[:, :, key_idx]
    vblk = vr[:, :, key_idx]

    logits = jnp.einsum('bhnqd,bhnkd->bhnqk', qr, kblk,
                        preferred_element_type=jnp.float32) * (dh ** -0.5)

    rel = jnp.arange(kb_len)[None, :] - half - jnp.arange(Q_BLOCK)[:, None]
    band = jnp.abs(rel) <= half
    buckets = t5_bucket(jnp.clip(rel, -half, half) * dilation)
    bias = rel_bias[buckets].astype(jnp.float32).transpose(2, 0, 1)
    key_pos = key_idx - half
    key_ok = (key_pos >= 0) & (key_pos < length)
    mask = band[None, :, :] & key_ok[:, None, :]
    logits = jnp.where(mask[None, None], logits + bias[None, :, None], NEG)

    m = jnp.max(logits, axis=-1, keepdims=True)
    p = jnp.exp(logits - m)
    denom = jnp.sum(p, axis=-1, keepdims=True)
    o = jnp.einsum('bhnqk,bhnkd->bhnqd', p, vblk.astype(jnp.float32)) / denom
    lse = (m + jnp.log(denom))[..., 0]

    o = o.reshape(bd, nh, padded, dh)[:, :, :length]
    o = o.reshape(b, dilation, nh, length, dh).transpose(0, 3, 1, 2, 4).reshape(b, s, nh, dh)
    lse = lse.reshape(bd, nh, padded)[:, :, :length]
    lse = lse.reshape(b, dilation, nh, length).transpose(0, 3, 1, 2).reshape(b, s, nh)
    return o, lse


def short_gated_conv(u, gate_b, gate_c, conv_w, conv_b):
    pad = (CONV_K - 1) // 2
    z = lax.conv_general_dilated(gate_c * u, conv_w[:, None, :].astype(u.dtype),
                                 window_strides=(1,), padding=((pad, pad),),
                                 dimension_numbers=('NWC', 'WIO', 'NWC'),
                                 feature_group_count=CONV_WIDTH)
    return gate_b * (z + conv_b.astype(u.dtype))


def setup_inputs(seed: int = 0) -> dict:
    key = jax.random.key(seed)
    ks = jax.random.split(key, 9)
    proj_cols = 4 * CONV_WIDTH + 4 * ATTN_WIDTH
    x = jax.random.normal(ks[0], (BATCH, SEQ, D_MODEL), jnp.float32)
    norm_w = 1.0 + 0.05 * jax.random.normal(ks[1], (D_MODEL,), jnp.float32)
    w_in = jax.random.normal(ks[2], (D_MODEL, proj_cols), jnp.float32) * D_MODEL ** -0.5
    conv_w = jax.random.normal(ks[3], (CONV_K, CONV_WIDTH), jnp.float32) * CONV_K ** -0.5
    conv_b = 0.01 * jax.random.normal(ks[4], (CONV_WIDTH,), jnp.float32)
    q_norm_w = 1.0 + 0.05 * jax.random.normal(ks[5], (HEAD_DIM,), jnp.float32)
    k_norm_w = 1.0 + 0.05 * jax.random.normal(ks[6], (HEAD_DIM,), jnp.float32)
    rel_bias = 0.5 * jax.random.normal(ks[7], (NUM_BUCKETS, ATTN_HEADS), jnp.float32)
    w_out = jax.random.normal(ks[8], (MIX_WIDTH, D_MODEL), jnp.float32) * MIX_WIDTH ** -0.5
    return {"x": x, "norm_w": norm_w, "w_in": w_in, "conv_w": conv_w, "conv_b": conv_b,
            "q_norm_w": q_norm_w, "k_norm_w": k_norm_w, "rel_bias": rel_bias, "w_out": w_out}


def reference(x, norm_w, w_in, conv_w, conv_b, q_norm_w, k_norm_w, rel_bias, w_out):
    b, s, _ = x.shape
    for _layer in range(DEPTH):
        h = rmsnorm(x, norm_w)
        proj = jnp.einsum('bsd,de->bse', h, w_in)
        c, a = CONV_WIDTH, ATTN_WIDTH
        splits = [c, 2 * c, 3 * c, 4 * c, 4 * c + a, 4 * c + 2 * a, 4 * c + 3 * a]
        u, g_b, g_c, z_conv, q, k, v, z_attn = jnp.split(proj, splits, axis=-1)

        y_conv = short_gated_conv(u, g_b, g_c, conv_w, conv_b) * jax.nn.silu(z_conv)

        q = rmsnorm(q.reshape(b, s, ATTN_HEADS, HEAD_DIM), q_norm_w)
        k = rmsnorm(k.reshape(b, s, ATTN_HEADS, HEAD_DIM), k_norm_w)
        v = v.reshape(b, s, ATTN_HEADS, HEAD_DIM)
        outs, lses = [], []
        for window, dilation in DILATED_CONFIGS:
            o_i, lse_i = dilated_window_attention(q, k, v, rel_bias, window, dilation)
            outs.append(o_i)
            lses.append(lse_i)
        mix = jax.nn.softmax(jnp.stack(lses, axis=0), axis=0)
        o = jnp.einsum('gbsh,gbshd->bshd', mix, jnp.stack(outs, axis=0))
        y_attn = o.reshape(b, s, ATTN_WIDTH).astype(x.dtype) * jax.nn.silu(z_attn)

        y = jnp.concatenate([y_conv, y_attn], axis=-1)
        x = x + jnp.einsum('bse,ed->bsd', y, w_out)
    return x
```

```cpp
#include <hip/hip_runtime.h>
#include <cstdio>
#include <cstdint>

namespace {
constexpr int D_MODEL = 1024, BATCH = 2, SEQ = 16384, NPROJ = 4096, CW = 512, NH = 8, HD = 64;
constexpr float EPS = 1e-6f;

__device__ __forceinline__ float wave_sum(float v) {
#pragma unroll
    for (int o = 1; o < 64; o <<= 1) v += __shfl_xor(v, o);
    return v;
}
__device__ __forceinline__ float wave_max(float v) {
#pragma unroll
    for (int o = 1; o < 64; o <<= 1) v = fmaxf(v, __shfl_xor(v, o));
    return v;
}

__global__ void __launch_bounds__(256) k_rstd(const float* x, float* rstd, int rows) {
    const int w = (blockIdx.x * 256 + threadIdx.x) >> 6, lane = threadIdx.x & 63;
    if (w >= rows) return;
    const float4* xr = (const float4*)(x + (size_t)w * D_MODEL);
    float s = 0.f;
#pragma unroll
    for (int j = 0; j < 4; ++j) { float4 v = xr[lane + 64 * j]; s += v.x * v.x + v.y * v.y + v.z * v.z + v.w * v.w; }
    s = wave_sum(s);
    if (lane == 0) rstd[w] = rsqrtf(s * (1.f / D_MODEL) + EPS);
}

__global__ void k_bias(const float* rel_bias, float* bias) {
    const int i = blockIdx.x * blockDim.x + threadIdx.x;
    if (i >= 3 * 129 * 8) return;
    const int h = i & 7, j = (i >> 3) % 129, c = (i >> 3) / 129;
    const int d = c == 0 ? 1 : (c == 1 ? 4 : 16);
    const int rel = (j - 64) * d;
    const int n = rel < 0 ? -rel : rel;
    int bucket = rel > 0 ? 16 : 0;
    if (n < 8) bucket += n;
    else {
        const float nf = (float)n;
        int large = 8 + (int)(logf(nf / 8.f) / logf(128.f) * 8.f);
        if (large > 15) large = 15;
        bucket += large;
    }
    bias[i] = rel_bias[bucket * 8 + h];
}

template <bool NORM_A, bool RESID>
__global__ void __launch_bounds__(256) k_gemm(const float* A, int lda, const float* B, int ldb, float* C, int ldc, int K,
                                             const float* rowscale, const float* colscale, const float* R, int ldr) {
    __shared__ float As[16][132];
    __shared__ float Bs[16][132];
    const int t = threadIdx.x, m0 = blockIdx.y * 128, n0 = blockIdx.x * 128;
    const int ar = t >> 1, ak = (t & 1) * 8, bk = t >> 4, bn = (t & 15) * 8;
    const int ty = t >> 4, tx = t & 15;
    float acc[8][8];
#pragma unroll
    for (int i = 0; i < 8; ++i)
#pragma unroll
        for (int j = 0; j < 8; ++j) acc[i][j] = 0.f;
    const float rs = NORM_A ? rowscale[m0 + ar] : 1.f;
    for (int k0 = 0; k0 < K; k0 += 16) {
        const float4 a0 = *(const float4*)(A + (size_t)(m0 + ar) * lda + k0 + ak);
        const float4 a1 = *(const float4*)(A + (size_t)(m0 + ar) * lda + k0 + ak + 4);
        float av[8] = {a0.x, a0.y, a0.z, a0.w, a1.x, a1.y, a1.z, a1.w};
        if (NORM_A) {
#pragma unroll
            for (int i = 0; i < 8; ++i) av[i] = av[i] * rs * colscale[k0 + ak + i];
        }
        const float4 b0 = *(const float4*)(B + (size_t)(k0 + bk) * ldb + n0 + bn);
        const float4 b1 = *(const float4*)(B + (size_t)(k0 + bk) * ldb + n0 + bn + 4);
        __syncthreads();
#pragma unroll
        for (int i = 0; i < 8; ++i) As[ak + i][ar] = av[i];
        *(float4*)&Bs[bk][bn] = b0; *(float4*)&Bs[bk][bn + 4] = b1;
        __syncthreads();
#pragma unroll
        for (int k = 0; k < 16; ++k) {
            float a[8], b[8];
#pragma unroll
            for (int i = 0; i < 8; ++i) a[i] = As[k][ty * 8 + i];
#pragma unroll
            for (int j = 0; j < 8; ++j) b[j] = Bs[k][tx * 8 + j];
#pragma unroll
            for (int i = 0; i < 8; ++i)
#pragma unroll
                for (int j = 0; j < 8; ++j) acc[i][j] = fmaf(a[i], b[j], acc[i][j]);
        }
    }
#pragma unroll
    for (int i = 0; i < 8; ++i) {
        const size_t row = (size_t)(m0 + ty * 8 + i);
#pragma unroll
        for (int j = 0; j < 8; ++j) {
            float v = acc[i][j];
            if (RESID) v += R[row * ldr + n0 + tx * 8 + j];
            C[row * ldc + n0 + tx * 8 + j] = v;
        }
    }
}

__global__ void __launch_bounds__(256) k_qknorm(float* proj, const float* qw, const float* kw, int rows) {
    const int w = (blockIdx.x * 256 + threadIdx.x) >> 6, lane = threadIdx.x & 63;
    if (w >= rows * 16) return;
    const int row = w >> 4, which = (w >> 3) & 1, h = w & 7;
    float* p = proj + (size_t)row * NPROJ + 2048 + which * 512 + h * 64 + lane;
    const float v = *p;
    const float ss = wave_sum(v * v);
    const float wt = which ? kw[lane] : qw[lane];
    *p = v * rsqrtf(ss * (1.f / 64.f) + EPS) * wt;
}

__global__ void __launch_bounds__(256) k_conv(const float* proj, const float* conv_w, const float* conv_b, float* y, int S) {
    const int i = blockIdx.x * 256 + threadIdx.x;
    const int s = i >> 9, c = i & 511;
    if (s >= S) return;
    const float* pr = proj + (size_t)s * NPROJ;
    float t0 = 0.f, t2 = 0.f;
    const float t1 = pr[1024 + c] * pr[c];
    if (s > 0) t0 = pr[-NPROJ + 1024 + c] * pr[-NPROJ + c];
    if (s < S - 1) t2 = pr[NPROJ + 1024 + c] * pr[NPROJ + c];
    const float z = conv_w[c] * t0 + conv_w[512 + c] * t1 + conv_w[1024 + c] * t2 + conv_b[c];
    const float zc = pr[1536 + c];
    y[(size_t)s * D_MODEL + c] = pr[512 + c] * z * (zc / (1.f + expf(-zc)));
}

__global__ void __launch_bounds__(64) k_attn(const float* proj, const float* bias, float* y, int S) {
    __shared__ float qs[64];
    __shared__ float ps[3 * 129];
    __shared__ int toks[3 * 129];
    const int lane = threadIdx.x, h = blockIdx.x & 7, s = blockIdx.x >> 3;
    const float* pr = proj + (size_t)s * NPROJ;
    qs[lane] = pr[2048 + h * 64 + lane];
    __syncthreads();
    float mx = -1e30f;
    for (int c = 0; c < 3; ++c) {
        const int d = c == 0 ? 1 : (c == 1 ? 4 : 16);
        for (int j = lane; j < 129; j += 64) {
            const int tk = s + (j - 64) * d;
            float lg = -1e30f; int tkv = -1;
            if (tk >= 0 && tk < S) {
                const float* kr = proj + (size_t)tk * NPROJ + 2560 + h * 64;
                float dot = 0.f;
                for (int e = 0; e < 64; ++e) dot = fmaf(qs[e], kr[e], dot);
                lg = dot * 0.125f + bias[(c * 129 + j) * 8 + h];
                tkv = tk;
            }
            ps[c * 129 + j] = lg; toks[c * 129 + j] = tkv;
            mx = fmaxf(mx, lg);
        }
    }
    mx = wave_max(mx);
    __syncthreads();
    float lsum = 0.f;
    for (int j = lane; j < 387; j += 64) { const float p = toks[j] >= 0 ? expf(ps[j] - mx) : 0.f; ps[j] = p; lsum += p; }
    lsum = wave_sum(lsum);
    __syncthreads();
    float o = 0.f;
    for (int j = 0; j < 387; ++j) {
        const int tk = toks[j];
        if (tk >= 0) o = fmaf(ps[j], proj[(size_t)tk * NPROJ + 3072 + h * 64 + lane], o);
    }
    const float za = pr[3584 + h * 64 + lane];
    y[(size_t)s * D_MODEL + 512 + h * 64 + lane] = (o / lsum) * (za / (1.f + expf(-za)));
}
}

extern "C" void kernel_launch(void* const* d_in, const int* in_sizes, int n_in, void* d_out, int out_size, void* d_ws, size_t ws_size,
                              hipStream_t stream) {
    const float* x = (const float*)d_in[0];
    const float* norm_w = (const float*)d_in[1];
    const float* w_in = (const float*)d_in[2];
    const float* conv_w = (const float*)d_in[3];
    const float* conv_b = (const float*)d_in[4];
    const float* qw = (const float*)d_in[5];
    const float* kw = (const float*)d_in[6];
    const float* rel_bias = (const float*)d_in[7];
    const float* w_out = (const float*)d_in[8];
    float* out = (float*)d_out;
    char* ws = (char*)d_ws;
    const size_t MiB = 1u << 20;
    float* proj = (float*)ws;
    float* y = (float*)(ws + 256 * MiB);
    float* rstd = (float*)(ws + 320 * MiB);
    float* bias = (float*)(ws + 321 * MiB);
    if (ws_size < 322 * MiB) { fprintf(stderr, "ws too small\n"); return; }
    k_bias<<<(3 * 129 * 8 + 255) / 256, 256, 0, stream>>>(rel_bias, bias);
    for (int b = 0; b < BATCH; ++b) {
        const float* xb = x + (size_t)b * SEQ * D_MODEL;
        float* ob = out + (size_t)b * SEQ * D_MODEL;
        k_rstd<<<SEQ / 4, 256, 0, stream>>>(xb, rstd, SEQ);
        k_gemm<true, false><<<dim3(NPROJ / 128, SEQ / 128), 256, 0, stream>>>(xb, D_MODEL, w_in, NPROJ, proj, NPROJ, D_MODEL, rstd, norm_w, nullptr, 0);
        k_qknorm<<<SEQ * 16 / 4, 256, 0, stream>>>(proj, qw, kw, SEQ);
        k_conv<<<SEQ * 512 / 256, 256, 0, stream>>>(proj, conv_w, conv_b, y, SEQ);
        k_attn<<<SEQ * 8, 64, 0, stream>>>(proj, bias, y, SEQ);
        k_gemm<false, true><<<dim3(D_MODEL / 128, SEQ / 128), 256, 0, stream>>>(y, D_MODEL, w_out, D_MODEL, ob, D_MODEL, D_MODEL, nullptr, nullptr, xb, D_MODEL);
    }
}
```

```cpp
#include <hip/hip_runtime.h>
#include <cstdio>
#include <cstdint>

#ifndef STAGE
#define STAGE 4
#endif

namespace pg8 {
#define PG8_LAS __attribute__((address_space(3)))
typedef unsigned short bf16_t;
typedef short bf16x8 __attribute__((ext_vector_type(8)));
typedef float f32x4 __attribute__((ext_vector_type(4)));
typedef unsigned u32x4 __attribute__((ext_vector_type(4)));
typedef unsigned u32x2 __attribute__((ext_vector_type(2)));
constexpr int BM = 256, BK = 64, HALF = 128, HTB = HALF * BK * 2, STAGE_BYTES = 8 * HTB, NXCD = 8, WGM = 8;

__host__ __device__ __forceinline__ int lds_byte(int r, int c) { const int st = (r >> 4) * 2 + (c >> 5), rr = r & 15, cc = c & 31, ob = rr * 64 + cc * 2; return st * 1024 + (ob ^ (((ob >> 9) & 1) << 5)); }
__host__ __device__ __forceinline__ void stage_rc(int b, int& R, int& C) { const int st = b / 1024, sb = b % 1024, swz = sb ^ (((sb >> 9) & 1) << 5); R = (st >> 1) * 16 + swz / 64; C = (st & 1) * 32 + (swz % 64) / 2; }

struct Unit { int pm, pn; };
struct Gemm { const bf16_t* A; const bf16_t* Bt; int M, N, K; };

struct StaticOrder {
    int nM, nN, nwg, G, c;
    __host__ __device__ void init(int M, int N, int G_, int c_) { nM = M / BM; nN = N / BM; nwg = nM * nN; G = G_; c = c_; }
    __host__ __device__ bool next(int i, Unit& u) const {
        const long L = (long)i * G + c; if (L >= nwg) return false;
        int wgid = (int)L; { const int q = nwg / NXCD, r = nwg % NXCD, xcd = wgid % NXCD, off = wgid / NXCD; wgid = (xcd < r ? xcd * (q + 1) : r * (q + 1) + (xcd - r) * q) + off; }
        const int nig = WGM * nN, gid = wgid / nig, fm = gid * WGM, gsz = (nM - fm) < WGM ? (nM - fm) : WGM;
        u.pm = fm + ((wgid % nig) % gsz); u.pn = (wgid % nig) / gsz; return true;
    }
};

__device__ __forceinline__ unsigned cvt_pk_bf16(float lo, float hi) { unsigned r; asm volatile("v_cvt_pk_bf16_f32 %0, %1, %2" : "=v"(r) : "v"(lo), "v"(hi)); return r; }
__device__ __forceinline__ float silu_f(float z) { return z * __builtin_amdgcn_rcpf(1.f + __builtin_amdgcn_exp2f(-1.4426950408889634f * z)); }

struct EpiProj {
    static constexpr bool PERM = false, AFTER_DRAIN = false;
    bf16_t *T, *G, *QKVZ; const float *qw, *kw;
    __device__ __forceinline__ void operator()(const f32x4 (&acc)[2][2][4][2], const Unit& u, int wr, int wc, int fr, int fq) const {
        const int row0 = u.pm * BM + wr * 64 + fr;
        if (u.pn < 8) {
            const int ch0 = 64 * u.pn + 16 * wc + 4 * fq;
#pragma unroll
            for (int ai = 0; ai < 2; ++ai)
#pragma unroll
                for (int m = 0; m < 4; ++m) {
                    const size_t off = (size_t)(row0 + ai * HALF + m * 16) * 512 + ch0;
                    const f32x4 uu = acc[ai][0][m][0], gb = acc[ai][0][m][1], gc = acc[ai][1][m][0], z = acc[ai][1][m][1];
                    f32x4 t = gc * uu, g;
#pragma unroll
                    for (int i = 0; i < 4; ++i) g[i] = gb[i] * silu_f(z[i]);
                    u32x2 tw, gw; tw.x = cvt_pk_bf16(t[0], t[1]); tw.y = cvt_pk_bf16(t[2], t[3]); gw.x = cvt_pk_bf16(g[0], g[1]); gw.y = cvt_pk_bf16(g[2], g[3]);
                    *(u32x2*)(T + off) = tw; *(u32x2*)(G + off) = gw;
                }
        } else {
            const int grp = (u.pn - 8) >> 1, head = 4 * ((u.pn - 8) & 1) + wc;
            bf16_t* dst = QKVZ + (size_t)grp * (size_t)(16u << 20);
            const int col0 = head * 64 + 8 * fq;
            f32x4 wv[2][2];
            if (grp < 2) { const float* w = grp == 0 ? qw : kw;
#pragma unroll
                for (int bj = 0; bj < 2; ++bj)
#pragma unroll
                    for (int n = 0; n < 2; ++n) wv[bj][n] = *(const f32x4*)(w + 32 * bj + 8 * fq + 4 * n); }
            const float sc = grp == 0 ? 0.125f * 1.4426950408889634f : 1.f;
#pragma unroll
            for (int ai = 0; ai < 2; ++ai)
#pragma unroll
                for (int m = 0; m < 4; ++m) {
                    f32x4 v[2][2];
#pragma unroll
                    for (int bj = 0; bj < 2; ++bj)
#pragma unroll
                        for (int n = 0; n < 2; ++n) v[bj][n] = acc[ai][bj][m][n];
                    if (grp < 2) {
                        float ss = 0.f;
#pragma unroll
                        for (int bj = 0; bj < 2; ++bj)
#pragma unroll
                            for (int n = 0; n < 2; ++n) ss += (v[bj][n][0] * v[bj][n][0] + v[bj][n][1] * v[bj][n][1]) + (v[bj][n][2] * v[bj][n][2] + v[bj][n][3] * v[bj][n][3]);
                        ss += __shfl_xor(ss, 16); ss += __shfl_xor(ss, 32);
                        const float rs = __builtin_amdgcn_rsqf(ss * (1.f / 64.f) + 1e-6f) * sc;
#pragma unroll
                        for (int bj = 0; bj < 2; ++bj)
#pragma unroll
                            for (int n = 0; n < 2; ++n) v[bj][n] = v[bj][n] * rs * wv[bj][n];
                    } else if (grp == 3) {
#pragma unroll
                        for (int bj = 0; bj < 2; ++bj)
#pragma unroll
                            for (int n = 0; n < 2; ++n)
#pragma unroll
                                for (int i = 0; i < 4; ++i) v[bj][n][i] = silu_f(v[bj][n][i]);
                    }
                    bf16_t* rowp = dst + (size_t)(row0 + ai * HALF + m * 16) * 512 + col0;
#pragma unroll
                    for (int bj = 0; bj < 2; ++bj) { u32x4 w; w.x = cvt_pk_bf16(v[bj][0][0], v[bj][0][1]); w.y = cvt_pk_bf16(v[bj][0][2], v[bj][0][3]); w.z = cvt_pk_bf16(v[bj][1][0], v[bj][1][1]); w.w = cvt_pk_bf16(v[bj][1][2], v[bj][1][3]);
                        *(u32x4*)(rowp + 32 * bj) = w; }
                }
        }
    }
};
struct EpiRes {
    static constexpr bool PERM = false, AFTER_DRAIN = false;
    const float* X; float* O; int ldc;
    __device__ __forceinline__ void operator()(const f32x4 (&acc)[2][2][4][2], const Unit& u, int wr, int wc, int fr, int fq) const {
        const int row0 = u.pm * BM + wr * 64 + fr, col0 = u.pn * BM + wc * 32 + 4 * fq;
#pragma unroll
        for (int ai = 0; ai < 2; ++ai)
#pragma unroll
            for (int m = 0; m < 4; ++m) { const size_t off = (size_t)(row0 + ai * HALF + m * 16) * ldc + col0;
#pragma unroll
                for (int bj = 0; bj < 2; ++bj)
#pragma unroll
                    for (int n = 0; n < 2; ++n) *(f32x4*)(O + off + bj * HALF + n * 16) = acc[ai][bj][m][n] + *(const f32x4*)(X + off + bj * HALF + n * 16); }
    }
};

template <class Epi, class Sched, bool ALIGN_EPI = false, bool SP2 = false>
__device__ __forceinline__ void gemm_phase(PG8_LAS unsigned char* lds, const Gemm g, const Sched& S, const Epi& E) {
    const int tid = threadIdx.x, wid = __builtin_amdgcn_readfirstlane(tid >> 6), lane = tid & 63, wr = wid >> 2, wc = wid & 3, fr = lane & 15, fq = lane >> 4;
    const int K = g.K, nt = K / BK;
    unsigned voffA[2], voffB[2];
#pragma unroll
    for (int i = 0; i < 2; ++i) { int R, C; stage_rc(tid * 16 + i * 8192, R, C);
        voffA[i] = (unsigned)(R * K + C) * 2u; voffB[i] = (unsigned)(R * K + C) * 2u; }
    const size_t kstep = (size_t)(BK * 2);
    const size_t hstep = (size_t)HALF * K * 2;
    const size_t tstep = 2 * hstep;
    const unsigned ldsw = (unsigned)wid * 1024u;
    const int aoff = lds_byte(wr * 64 + fr, fq * 8), boff = lds_byte(wc * 32 + fr, fq * 8);
#define PG8_SA(b, h) (((b) * 2 + (h)) * HTB)
#define PG8_SB(b, h) ((4 + (b) * 2 + (h)) * HTB)
#define PG8_STAGE(bufoff, gbase, voff) do { _Pragma("unroll") for (int _i = 0; _i < 2; ++_i) \
        __builtin_amdgcn_global_load_lds((const unsigned*)((const char*)(gbase) + (voff)[_i]), (PG8_LAS unsigned*)(lds + (bufoff) + ldsw + _i * 8192), 16, 0, 0); } while (0)
#define PG8_LDA(dst, b, h) do { _Pragma("unroll") for (int m = 0; m < 4; ++m) _Pragma("unroll") for (int k = 0; k < 2; ++k) dst[m][k] = *(const PG8_LAS bf16x8*)(lds + PG8_SA(b, h) + aoff + m * 2048 + k * 1024); } while (0)
#define PG8_LDB(dst, b, h) do { _Pragma("unroll") for (int n = 0; n < 2; ++n) _Pragma("unroll") for (int k = 0; k < 2; ++k) dst[n][k] = *(const PG8_LAS bf16x8*)(lds + PG8_SB(b, h) + boff + n * 2048 + k * 1024); } while (0)
#define PG8_MMA(ai, bj, At, Bt) do { __builtin_amdgcn_s_setprio(1); _Pragma("unroll") for (int m = 0; m < 4; ++m) _Pragma("unroll") for (int n = 0; n < 2; ++n) _Pragma("unroll") for (int k = 0; k < 2; ++k) \
        acc[ai][bj][m][n] = __builtin_amdgcn_mfma_f32_16x16x32_bf16(Bt[n][k], At[m][k], acc[ai][bj][m][n], 0, 0, 0); __builtin_amdgcn_s_setprio(0); } while (0)
#define PG8_WAIT_V(n) asm volatile("s_waitcnt vmcnt(" #n ")" ::: "memory")
#define PG8_WAIT_L(n) asm volatile("s_waitcnt lgkmcnt(" #n ")" ::: "memory")
#define PG8_BAR __builtin_amdgcn_s_barrier()
#define PG8_SCHED __builtin_amdgcn_sched_barrier(0)
    Unit cur, nxt; int ui = 0;
    if (!S.next(0, cur)) return;
    f32x4 acc[2][2][4][2];
#pragma unroll
    for (int a = 0; a < 2; ++a)
#pragma unroll
        for (int b = 0; b < 2; ++b)
#pragma unroll
            for (int m = 0; m < 4; ++m)
#pragma unroll
                for (int n = 0; n < 2; ++n) acc[a][b][m][n] = (f32x4){0.f, 0.f, 0.f, 0.f};
    bf16x8 At[4][2], B0[2][2], B1[2][2];
    const char* cA = (const char*)g.A + (size_t)cur.pm * tstep; const char* cB = (const char*)g.Bt + (size_t)cur.pn * tstep;
    if constexpr (SP2) {
        PG8_STAGE(PG8_SB(0, 0), cB, voffB); PG8_STAGE(PG8_SB(0, 1), cB + hstep, voffB); PG8_STAGE(PG8_SA(0, 0), cA, voffA); PG8_STAGE(PG8_SA(0, 1), cA + hstep, voffA);
        if (wr == 1) PG8_BAR;
        PG8_WAIT_V(2); PG8_BAR;
        PG8_STAGE(PG8_SB(1, 0), cB + kstep, voffB); PG8_STAGE(PG8_SA(1, 0), cA + kstep, voffA); PG8_STAGE(PG8_SB(1, 1), cB + hstep + kstep, voffB);
        PG8_WAIT_V(6); PG8_BAR;
    } else {
        PG8_STAGE(PG8_SB(0, 0), cB, voffB); PG8_STAGE(PG8_SA(0, 0), cA, voffA); PG8_STAGE(PG8_SB(0, 1), cB + hstep, voffB); PG8_STAGE(PG8_SA(0, 1), cA + hstep, voffA);
        if (wr == 1) PG8_BAR;
        PG8_WAIT_V(4); PG8_BAR;
        PG8_STAGE(PG8_SB(1, 0), cB + kstep, voffB); PG8_STAGE(PG8_SA(1, 0), cA + kstep, voffA); PG8_STAGE(PG8_SB(1, 1), cB + hstep + kstep, voffB);
        PG8_WAIT_V(6); PG8_BAR;
    }
    for (;;) {
        const bool has_next = S.next(ui + 1, nxt);
        const char* nA = has_next ? (const char*)g.A + (size_t)nxt.pm * tstep : cA; const char* nB = has_next ? (const char*)g.Bt + (size_t)nxt.pn * tstep : cB;
        for (int t = 0; t < nt; t += 2) {
            const bool last = (t == nt - 2);
            const char* a1 = cA + (size_t)(t + 1) * kstep;
            const char* a2 = last ? nA : cA + (size_t)(t + 2) * kstep; const char* b2 = last ? nB : cB + (size_t)(t + 2) * kstep;
            const char* a3 = a2 + kstep; const char* b3 = b2 + kstep;
            if constexpr (SP2) {
            PG8_LDB(B0, 0, 0); PG8_LDB(B1, 0, 1); PG8_SCHED; PG8_LDA(At, 0, 0); PG8_STAGE(PG8_SA(1, 1), a1 + hstep, voffA);
            PG8_WAIT_V(8); PG8_WAIT_L(0); PG8_BAR; PG8_MMA(0, 0, At, B0); PG8_MMA(0, 1, At, B1); PG8_BAR; PG8_SCHED;
            PG8_LDA(At, 0, 1); PG8_STAGE(PG8_SB(0, 0), b2, voffB); PG8_STAGE(PG8_SB(0, 1), b2 + hstep, voffB); PG8_STAGE(PG8_SA(0, 0), a2, voffA);
            PG8_WAIT_V(8); PG8_WAIT_L(0); PG8_BAR; PG8_MMA(1, 0, At, B0); PG8_MMA(1, 1, At, B1); PG8_BAR; PG8_SCHED;
            PG8_LDB(B0, 1, 0); PG8_LDB(B1, 1, 1); PG8_SCHED; PG8_LDA(At, 1, 0); PG8_STAGE(PG8_SA(0, 1), a2 + hstep, voffA);
            PG8_WAIT_V(8); PG8_WAIT_L(0); PG8_BAR; PG8_MMA(0, 0, At, B0); PG8_MMA(0, 1, At, B1); PG8_BAR; PG8_SCHED;
            PG8_LDA(At, 1, 1); PG8_STAGE(PG8_SB(1, 0), b3, voffB); PG8_STAGE(PG8_SB(1, 1), b3 + hstep, voffB); PG8_STAGE(PG8_SA(1, 0), a3, voffA);
            PG8_WAIT_V(8); PG8_WAIT_L(0); PG8_BAR; PG8_MMA(1, 0, At, B0); PG8_MMA(1, 1, At, B1); PG8_BAR; PG8_SCHED;
            } else {
            PG8_LDB(B0, 0, 0); PG8_SCHED; PG8_LDA(At, 0, 0); PG8_STAGE(PG8_SA(1, 1), a1 + hstep, voffA);
            PG8_WAIT_L(8); PG8_BAR; PG8_WAIT_L(0); PG8_MMA(0, 0, At, B0); PG8_BAR; PG8_SCHED;
            PG8_LDB(B1, 0, 1); PG8_STAGE(PG8_SB(0, 0), b2, voffB);
            PG8_BAR; PG8_WAIT_L(0); PG8_MMA(0, 1, At, B1); PG8_BAR;
            PG8_LDA(At, 0, 1); PG8_STAGE(PG8_SA(0, 0), a2, voffA);
            PG8_BAR; PG8_WAIT_L(0); PG8_MMA(1, 0, At, B0); PG8_BAR; PG8_SCHED;
            PG8_STAGE(PG8_SB(0, 1), b2 + hstep, voffB);
            PG8_WAIT_V(6); PG8_BAR; PG8_MMA(1, 1, At, B1); PG8_BAR;
            PG8_LDB(B0, 1, 0); PG8_SCHED; PG8_LDA(At, 1, 0); PG8_STAGE(PG8_SA(0, 1), a2 + hstep, voffA);
            PG8_WAIT_L(8); PG8_BAR; PG8_WAIT_L(0); PG8_MMA(0, 0, At, B0); PG8_BAR; PG8_SCHED;
            PG8_LDB(B1, 1, 1); PG8_STAGE(PG8_SB(1, 0), b3, voffB);
            PG8_BAR; PG8_WAIT_L(0); PG8_MMA(0, 1, At, B1); PG8_BAR;
            PG8_LDA(At, 1, 1); PG8_STAGE(PG8_SA(1, 0), a3, voffA);
            PG8_BAR; PG8_WAIT_L(0); PG8_MMA(1, 0, At, B0); PG8_BAR; PG8_SCHED;
            PG8_STAGE(PG8_SB(1, 1), b3 + hstep, voffB);
            PG8_WAIT_V(6); PG8_BAR; PG8_MMA(1, 1, At, B1); PG8_BAR;
            }
        }
        if constexpr (ALIGN_EPI) { if (wr == 0) PG8_BAR; }
        E(acc, cur, wr, wc, fr, fq);
        if (!has_next) break;
#pragma unroll
        for (int a = 0; a < 2; ++a)
#pragma unroll
            for (int b = 0; b < 2; ++b)
#pragma unroll
                for (int m = 0; m < 4; ++m)
#pragma unroll
                    for (int n = 0; n < 2; ++n) acc[a][b][m][n] = (f32x4){0.f, 0.f, 0.f, 0.f};
        cur = nxt; cA = nA; cB = nB; ++ui;
        if constexpr (ALIGN_EPI) { if (wr == 1) PG8_BAR; }
    }
    PG8_WAIT_V(0);
    if constexpr (!ALIGN_EPI) { if (wr == 0) PG8_BAR; }
    PG8_BAR;
#undef PG8_SA
#undef PG8_SB
#undef PG8_STAGE
#undef PG8_LDA
#undef PG8_LDB
#undef PG8_MMA
#undef PG8_WAIT_V
#undef PG8_WAIT_L
#undef PG8_BAR
#undef PG8_SCHED
}
}

constexpr int D_MODEL = 1024, BATCH = 2, SEQ = 16384, M = BATCH * SEQ, NPROJ = 4096, AW = 512, NHEAD = 8;
constexpr int NWAVES = 8;
constexpr size_t MiB = 1u << 20;
constexpr size_t WS_CTL = 0, CTL_ZERO_BYTES = 1 * MiB;
constexpr size_t WS_TBG = 1 * MiB;
constexpr size_t WS_WIN = 2 * MiB;
constexpr size_t WS_WOUT = 10 * MiB;
constexpr size_t WS_LP4 = 12 * MiB, WS_LP16 = 13 * MiB;
constexpr size_t WS_XN = 16 * MiB;
constexpr size_t WS_T = 80 * MiB, WS_G = 112 * MiB, WS_Q = 144 * MiB, WS_K = 176 * MiB, WS_V = 208 * MiB, WS_ZG = 240 * MiB;
constexpr size_t WS_OP4 = 272 * MiB, WS_OP16 = 304 * MiB;
constexpr size_t WS_Y = 336 * MiB;
constexpr size_t WS_END = 400 * MiB;
constexpr int CW_BAR = 4096;

constexpr int RING_OFF = 0, RING_BYTES = 131072;
constexpr int LDSCTL_OFF = RING_BYTES, MISC_OFF = LDSCTL_OFF + 320;
constexpr int LDS_BYTES = 147456;

#define GAS __attribute__((address_space(1)))
#define LAS __attribute__((address_space(3)))
typedef unsigned short bf16;
typedef unsigned v4u __attribute__((ext_vector_type(4)));
typedef float f32x4 __attribute__((ext_vector_type(4)));
typedef float f32x16 __attribute__((ext_vector_type(16)));
typedef short bf16x8 __attribute__((ext_vector_type(8)));
typedef short s16x4 __attribute__((ext_vector_type(4)));
typedef GAS unsigned gu32;
#define RLX_AGENT __ATOMIC_RELAXED, __HIP_MEMORY_SCOPE_AGENT
#define LDS_WAIT() asm volatile("s_waitcnt lgkmcnt(0)" ::: "memory")
__device__ __forceinline__ unsigned f2bf(float f) { unsigned u = __builtin_bit_cast(unsigned, f); return (u + 0x7fffu + ((u >> 16) & 1u)) >> 16; }
__device__ __forceinline__ unsigned pk2(float lo, float hi) { return f2bf(lo) | (f2bf(hi) << 16); }
__device__ __forceinline__ float bf2f(unsigned short b) { return __builtin_bit_cast(float, (unsigned)b << 16); }
__device__ __forceinline__ float bflo(unsigned w) { return __builtin_bit_cast(float, w << 16); }
__device__ __forceinline__ float bfhi(unsigned w) { return __builtin_bit_cast(float, w & 0xffff0000u); }

#define XB_TMO      128
#define XB_XCNT(j)  (256  + 64 * (j))
#define XB_XSUB(j)  (1280 + 64 * (j))
#define XB_XGEN(j)  (2304 + 64 * (j))
#define XB_TOP      3328
#define XB_TOPGEN   3392
#define XCD_BAR_WORDS 3456
#define XB_SPIN_CAP (1u << 18)
__device__ __forceinline__ unsigned xb_ld(unsigned* p)              { return __hip_atomic_load(p, __ATOMIC_RELAXED, __HIP_MEMORY_SCOPE_AGENT); }
__device__ __forceinline__ unsigned xb_add(unsigned* p, unsigned v) { return __hip_atomic_fetch_add(p, v, __ATOMIC_RELAXED, __HIP_MEMORY_SCOPE_AGENT); }
__device__ __forceinline__ unsigned xb_xcc_id() { return (unsigned)__builtin_amdgcn_s_getreg((3 << 11) | 20) & 0xFu; }
#define XB_SPIN(cond, bar) do { unsigned _sp = 0; while (cond) { __builtin_amdgcn_s_sleep(1); \
    if ((++_sp & 255u) == 0u) { if (xb_ld(&(bar)[XB_TMO])) break; if (_sp > XB_SPIN_CAP) { atomicAdd(&(bar)[XB_TMO], 1u); break; } } } } while (0)
struct XcdBarrier { unsigned* bar; unsigned x; volatile LAS unsigned* st; };
__device__ __forceinline__ XcdBarrier xcd_barrier_post(unsigned* bar, volatile LAS unsigned* st) {
    XcdBarrier b; b.bar = bar; b.x = xb_xcc_id(); b.st = st;
    if (threadIdx.x == 0) (void)xb_add(&bar[XB_XCNT(b.x)], 1u);
    return b;
}
__device__ __forceinline__ void xcd_barrier_complete(unsigned* bar, unsigned x, unsigned& nloc, unsigned& nx) {
    const unsigned G = gridDim.x * gridDim.y * gridDim.z;
    unsigned sum, cnt, mine, sp = 0u;
    for (;;) {
        sum = 0u; cnt = 0u; mine = 0u;
#pragma unroll
        for (unsigned j = 0; j < 16; ++j) { const unsigned c = xb_ld(&bar[XB_XCNT(j)]); sum += c; cnt += (c > 0u) ? 1u : 0u; mine = (j == x) ? c : mine; }
        if (sum == G) break;
        __builtin_amdgcn_s_sleep(1);
        if ((++sp & 255u) == 0u) { if (xb_ld(&bar[XB_TMO])) break; if (sp > XB_SPIN_CAP) { atomicAdd(&bar[XB_TMO], 1u); break; } }
    }
    nloc = mine > 0u ? mine : 1u; nx = cnt > 0u ? cnt : 1u;
}
__device__ __forceinline__ void xcd_barrier(const XcdBarrier& b) {
    asm volatile("s_waitcnt vmcnt(0)" ::: "memory");
    __syncthreads();
    if (threadIdx.x == 0) {
        unsigned* bar = b.bar;
        __builtin_amdgcn_s_waitcnt(0);
        unsigned nloc = b.st[0], nx = b.st[1];
        if (nloc == 0u) { xcd_barrier_complete(bar, b.x, nloc, nx); b.st[0] = nloc; b.st[1] = nx; }
        const unsigned old = xb_add(&bar[XB_XSUB(b.x)], 1u);
        const unsigned gen = old / nloc;
        if (old + 1u == (gen + 1u) * nloc) {
            __builtin_amdgcn_fence(__ATOMIC_RELEASE, "agent");
            asm volatile("s_waitcnt vmcnt(0)" ::: "memory");
            const unsigned og = xb_add(&bar[XB_TOP], 1u);
            const unsigned tg = og / nx;
            if (og + 1u == (tg + 1u) * nx) xb_add(&bar[XB_TOPGEN], 1u);
            else XB_SPIN(xb_ld(&bar[XB_TOPGEN]) == tg, bar);
            __builtin_amdgcn_fence(__ATOMIC_ACQUIRE, "agent");
            xb_add(&bar[XB_XGEN(b.x)], 1u);
            asm volatile("s_waitcnt vmcnt(0)" ::: "memory");
        } else {
            XB_SPIN(xb_ld(&bar[XB_XGEN(b.x)]) == gen, bar);
            __builtin_amdgcn_fence(__ATOMIC_ACQUIRE, "agent");
            asm volatile("s_waitcnt vmcnt(0)" ::: "memory");
        }
    }
    __syncthreads();
}

struct Frame {
    LAS unsigned char* lds;
    volatile LAS unsigned* MISC;
    gu32* ctl;
    int tid, lane, wave, vcu, G;
    const float *x, *norm_w, *w_in, *conv_w, *conv_b, *qw, *kw, *rel_bias, *w_out; float* out;
    bf16 *WinT, *WoutT, *XN, *T, *Gt, *Q, *K, *V, *ZG, *OP4, *OP16, *Y;
    float *TBG, *LP4, *LP16;
};
__device__ __forceinline__ float wave_sum(float v) {
#pragma unroll
    for (int o = 1; o < 64; o <<= 1) v += __shfl_xor(v, o);
    return v;
}
__device__ __forceinline__ float wave_max(float v) {
#pragma unroll
    for (int o = 1; o < 64; o <<= 1) v = fmaxf(v, __shfl_xor(v, o));
    return v;
}
__device__ __forceinline__ int win_row(int L) {
    int pn, wc, bj, n, fq, reg;
    if (L < 2048) { const int which = L >> 9, ch = L & 511; pn = ch >> 6; wc = (ch >> 4) & 3; fq = (ch >> 2) & 3; reg = ch & 3; bj = which >> 1; n = which & 1; }
    else { const int Lp = L - 2048, grp = Lp >> 9, head = (Lp >> 6) & 7, e = Lp & 63; pn = 8 + 2 * grp + (head >> 2); wc = head & 3; bj = e >> 5; fq = (e >> 3) & 3; n = (e >> 2) & 1; reg = e & 3; }
    return pn * 256 + 128 * bj + 32 * wc + 16 * n + 4 * fq + reg;
}
template <bool PERMUTE>
__device__ __forceinline__ void p0_transpose_item(const float* W, int K, int N, bf16* WT, LAS float* scr, int item, int lane) {
    const int nblk = N / 32, kb = item / nblk, nb = item % nblk, k0 = 64 * kb, n0 = 32 * nb;
#pragma unroll 8
    for (int i = 0; i < 32; ++i) { const int kk = 2 * i + (lane >> 5); scr[kk * 33 + (lane & 31)] = W[(size_t)(k0 + kk) * N + n0 + (lane & 31)]; }
    LDS_WAIT(); asm volatile("" ::: "memory");
    const int c = lane & 7;
#pragma unroll
    for (int j = 0; j < 4; ++j) { const int n = (lane >> 3) + 8 * j; const LAS float* s = scr + (8 * c) * 33 + n;
        v4u o; o.x = pk2(s[0 * 33], s[1 * 33]); o.y = pk2(s[2 * 33], s[3 * 33]); o.z = pk2(s[4 * 33], s[5 * 33]); o.w = pk2(s[6 * 33], s[7 * 33]);
        const int dr = PERMUTE ? win_row(n0 + n) : (n0 + n);
        *(GAS v4u*)(WT + (size_t)dr * K + k0 + 8 * c) = o; }
    LDS_WAIT(); asm volatile("" ::: "memory");
}
__device__ __forceinline__ int t5_bucket(int rel) {
    const int n = rel < 0 ? -rel : rel; int b = rel > 0 ? 16 : 0;
    if (n < 8) return b + n;
    int large = 8 + (int)(logf((float)n / 8.f) / logf(128.f) * 8.f);
    if (large > 15) large = 15;
    return b + large;
}
__device__ __forceinline__ void p0_prologue(Frame& F) {
    LAS float* scr = (LAS float*)(F.lds + RING_OFF + F.wave * 16384);
    const int gw = F.vcu * NWAVES + F.wave, NGW = F.G * NWAVES;
    constexpr int I_IN = (D_MODEL / 64) * (NPROJ / 32), I_OUT = (D_MODEL / 64) * (D_MODEL / 32);
    for (int it = gw; it < I_IN + I_OUT; it += NGW) {
        if (it < I_IN) p0_transpose_item<true>(F.w_in, D_MODEL, NPROJ, F.WinT, scr, it, F.lane);
        else p0_transpose_item<false>(F.w_out, D_MODEL, D_MODEL, F.WoutT, scr, it - I_IN, F.lane);
    }
    f32x4 nw[4];
#pragma unroll
    for (int j = 0; j < 4; ++j) nw[j] = ((const f32x4*)F.norm_w)[F.lane + 64 * j];
    for (int m = gw; m < M; m += NGW) {
        const GAS f32x4* xr = (const GAS f32x4*)(F.x + (size_t)m * D_MODEL) + F.lane;
        f32x4 v[4]; float s = 0.f;
#pragma unroll
        for (int j = 0; j < 4; ++j) { v[j] = xr[64 * j]; s += (v[j].x * v[j].x + v[j].y * v[j].y) + (v[j].z * v[j].z + v[j].w * v[j].w); }
        const float rstd = 1.f / sqrtf(wave_sum(s) * (1.f / D_MODEL) + 1e-6f);
        GAS unsigned long long* o8 = (GAS unsigned long long*)(F.XN + (size_t)m * D_MODEL) + F.lane;
#pragma unroll
        for (int j = 0; j < 4; ++j) { const f32x4 y = v[j] * rstd * nw[j]; o8[64 * j] = (unsigned long long)pk2(y.x, y.y) | ((unsigned long long)pk2(y.z, y.w) << 32); }
    }
    if (blockIdx.x == 0) {
        const float mq = wave_max(fabsf(F.qw[F.lane])), mk = wave_max(fabsf(F.kw[F.lane]));
        float mb = 0.f;
#pragma unroll
        for (int j = 0; j < 4; ++j) mb = fmaxf(mb, fabsf(F.rel_bias[F.lane + 64 * j]));
        mb = wave_max(mb);
        const float M2 = (8.f * mq * mk + mb) * 1.4426950408889634f;
        for (int i = F.tid; i < 3 * 8 * 192; i += NWAVES * 64) {
            const int jp = i % 192, h = (i / 192) & 7, c = i / (192 * 8), j = jp - 32;
            const int dil = c == 0 ? 1 : (c == 1 ? 4 : 16);
            float v = -1e30f;
            if (j >= 0 && j <= 128) v = F.rel_bias[t5_bucket((j - 64) * dil) * 8 + h] * 1.4426950408889634f - M2;
            F.TBG[i] = v;
        }
    }
}

__device__ __forceinline__ int crow(int r, int hi) { return (r & 3) + 8 * (r >> 2) + 4 * hi; }
__device__ __forceinline__ unsigned cvtpk_s(float lo, float hi) { typedef float f2 __attribute__((ext_vector_type(2))); typedef __bf16 b2 __attribute__((ext_vector_type(2))); f2 v = {lo, hi}; b2 b = __builtin_convertvector(v, b2); return __builtin_bit_cast(unsigned, b); }
typedef short v4i16_t __attribute__((ext_vector_type(4)));
__device__ __forceinline__ s16x4 vtr(LAS const unsigned char* p) { return __builtin_bit_cast(s16x4, __builtin_amdgcn_ds_read_tr16_b64_v4i16((LAS v4i16_t*)p)); }

template <bool FINAL>
__device__ __forceinline__ void attn_task(Frame& F, int c, int b, int h, int r, int sb, LAS unsigned char* wl, int lane) {
    const int dil = c == 0 ? 1 : (c == 1 ? 4 : 16);
    const int L = SEQ / dil, i0 = sb * 32, r32 = lane & 31, hi = lane >> 5;
    const size_t tok0 = (size_t)b * SEQ + r;
    LAS float* tbl = (LAS float*)(wl + 8192);
    { const float* tg = F.TBG + (c * 8 + h) * 192; tbl[lane] = tg[lane]; tbl[lane + 64] = tg[lane + 64]; tbl[lane + 128] = tg[lane + 128]; }
    bf16x8 qr[4];
    { const bf16* qp = F.Q + (tok0 + (size_t)dil * (i0 + r32)) * AW + h * 64 + hi * 8;
#pragma unroll
      for (int d0 = 0; d0 < 4; ++d0) qr[d0] = *(const bf16x8*)(qp + d0 * 16); }
    f32x16 o0 = {}, o1 = {}; float lsum = 0.f;
    bf16x8 kfA[4], kfB[4], vrA[4], vrB[4];
#define LOADKV(kc, KF, VR) do { const int k0_ = i0 - 64 + 32 * (kc); int kk_ = k0_ + r32; kk_ = kk_ < 0 ? 0 : (kk_ > L - 1 ? L - 1 : kk_); \
        const bf16* kp_ = F.K + (tok0 + (size_t)dil * kk_) * AW + h * 64 + hi * 8; \
        _Pragma("unroll") for (int d0 = 0; d0 < 4; ++d0) KF[d0] = *(const bf16x8*)(kp_ + d0 * 16); \
        _Pragma("unroll") for (int pc = 0; pc < 4; ++pc) { int vk_ = k0_ + 16 * (pc & 1) + (lane >> 2); vk_ = vk_ < 0 ? 0 : (vk_ > L - 1 ? L - 1 : vk_); \
            VR[pc] = *(const bf16x8*)(F.V + (tok0 + (size_t)dil * vk_) * AW + h * 64 + 32 * (pc >> 1) + 8 * (lane & 3)); } } while (0)
    const int vaddr = ((lane >> 4) & 1) * 32 + (lane & 3) * 8 + (4 * hi + ((lane & 15) >> 2)) * 64;
#define CHUNK(kc, KF, VR) do { const int buf_ = ((kc) & 1) * 4096; const int k0_ = i0 - 64 + 32 * (kc); \
        _Pragma("unroll") for (int pc = 0; pc < 4; ++pc) *(LAS bf16x8*)(wl + buf_ + pc * 1024 + lane * 16) = VR[pc]; \
        f32x16 a_; { const LAS float* tp_ = tbl + (32 + 32 * (kc) + 4 * hi - r32); \
            _Pragma("unroll") for (int rr = 0; rr < 16; ++rr) a_[rr] = tp_[(rr & 3) + 8 * (rr >> 2)]; } \
        if (k0_ < 0 || k0_ + 32 > L) { _Pragma("unroll") for (int rr = 0; rr < 16; ++rr) { const int key_ = k0_ + crow(rr, hi); if (key_ < 0 || key_ >= L) a_[rr] = -1e30f; } } \
        _Pragma("unroll") for (int d0 = 0; d0 < 4; ++d0) a_ = __builtin_amdgcn_mfma_f32_32x32x16_bf16(KF[d0], qr[d0], a_, 0, 0, 0); \
        _Pragma("unroll") for (int rr = 0; rr < 16; ++rr) { a_[rr] = __builtin_amdgcn_exp2f(a_[rr]); lsum += a_[rr]; } \
        v4u pw0_, pw1_; pw0_.x = cvtpk_s(a_[0], a_[1]); pw0_.y = cvtpk_s(a_[2], a_[3]); pw0_.z = cvtpk_s(a_[4], a_[5]); pw0_.w = cvtpk_s(a_[6], a_[7]); \
        pw1_.x = cvtpk_s(a_[8], a_[9]); pw1_.y = cvtpk_s(a_[10], a_[11]); pw1_.z = cvtpk_s(a_[12], a_[13]); pw1_.w = cvtpk_s(a_[14], a_[15]); \
        const LAS unsigned char* vb_ = wl + buf_ + vaddr; \
        { s16x4 l0 = vtr(vb_), h0 = vtr(vb_ + 512), l1 = vtr(vb_ + 1024), h1 = vtr(vb_ + 1536), l2 = vtr(vb_ + 2048), h2 = vtr(vb_ + 2560), l3 = vtr(vb_ + 3072), h3 = vtr(vb_ + 3584); \
          o0 = __builtin_amdgcn_mfma_f32_32x32x16_bf16(__builtin_bit_cast(bf16x8, pw0_), (bf16x8){l0[0], l0[1], l0[2], l0[3], h0[0], h0[1], h0[2], h0[3]}, o0, 0, 0, 0); \
          o0 = __builtin_amdgcn_mfma_f32_32x32x16_bf16(__builtin_bit_cast(bf16x8, pw1_), (bf16x8){l1[0], l1[1], l1[2], l1[3], h1[0], h1[1], h1[2], h1[3]}, o0, 0, 0, 0); \
          o1 = __builtin_amdgcn_mfma_f32_32x32x16_bf16(__builtin_bit_cast(bf16x8, pw0_), (bf16x8){l2[0], l2[1], l2[2], l2[3], h2[0], h2[1], h2[2], h2[3]}, o1, 0, 0, 0); \
          o1 = __builtin_amdgcn_mfma_f32_32x32x16_bf16(__builtin_bit_cast(bf16x8, pw1_), (bf16x8){l3[0], l3[1], l3[2], l3[3], h3[0], h3[1], h3[2], h3[3]}, o1, 0, 0, 0); } } while (0)
    LOADKV(0, kfA, vrA);
    LOADKV(1, kfB, vrB); CHUNK(0, kfA, vrA);
    LOADKV(2, kfA, vrA); CHUNK(1, kfB, vrB);
    LOADKV(3, kfB, vrB); CHUNK(2, kfA, vrA);
    LOADKV(4, kfA, vrA); CHUNK(3, kfB, vrB);
    CHUNK(4, kfA, vrA);
#undef LOADKV
#undef CHUNK
    lsum += __shfl_xor(lsum, 32);
    LAS float* stg = (LAS float*)wl;
#pragma unroll
    for (int rr = 0; rr < 16; ++rr) { const int q = crow(rr, hi); stg[q * 64 + r32] = o0[rr]; stg[q * 64 + 32 + r32] = o1[rr]; }
    LAS float* lw = (LAS float*)(wl + 9216);
    if (FINAL) { if (hi == 0) lw[r32] = lsum; }
    else { if (hi == 0) { float* lp = F.LP4 + (size_t)(c - 1) * (size_t)(256u << 10) + (tok0 + (size_t)dil * (i0 + r32)) * 8 + h; *lp = lsum; } }
#pragma unroll
    for (int i = 0; i < 4; ++i) {
        const int row = i * 8 + (lane >> 3), ch = lane & 7;
        const size_t tok = tok0 + (size_t)dil * (i0 + row);
        const f32x4 a = *(const LAS f32x4*)(stg + row * 64 + ch * 8), bq = *(const LAS f32x4*)(stg + row * 64 + ch * 8 + 4);
        if (!FINAL) {
            v4u w; w.x = cvtpk_s(a[0], a[1]); w.y = cvtpk_s(a[2], a[3]); w.z = cvtpk_s(bq[0], bq[1]); w.w = cvtpk_s(bq[2], bq[3]);
            *(v4u*)(F.OP4 + (size_t)(c - 1) * (size_t)(16u << 20) + tok * AW + h * 64 + ch * 8) = w;
        } else {
            const v4u p4 = *(const v4u*)(F.OP4 + tok * AW + h * 64 + ch * 8), p16 = *(const v4u*)(F.OP16 + tok * AW + h * 64 + ch * 8), zg = *(const v4u*)(F.ZG + tok * AW + h * 64 + ch * 8);
            const float lt = lw[row] + F.LP4[tok * 8 + h] + F.LP16[tok * 8 + h];
            const float inv = 1.f / lt;
            float y[8];
            y[0] = (a[0] + bflo(p4.x) + bflo(p16.x)) * inv * bflo(zg.x); y[1] = (a[1] + bfhi(p4.x) + bfhi(p16.x)) * inv * bfhi(zg.x);
            y[2] = (a[2] + bflo(p4.y) + bflo(p16.y)) * inv * bflo(zg.y); y[3] = (a[3] + bfhi(p4.y) + bfhi(p16.y)) * inv * bfhi(zg.y);
            y[4] = (bq[0] + bflo(p4.z) + bflo(p16.z)) * inv * bflo(zg.z); y[5] = (bq[1] + bfhi(p4.z) + bfhi(p16.z)) * inv * bfhi(zg.z);
            y[6] = (bq[2] + bflo(p4.w) + bflo(p16.w)) * inv * bflo(zg.w); y[7] = (bq[3] + bfhi(p4.w) + bfhi(p16.w)) * inv * bfhi(zg.w);
            v4u w; w.x = cvtpk_s(y[0], y[1]); w.y = cvtpk_s(y[2], y[3]); w.z = cvtpk_s(y[4], y[5]); w.w = cvtpk_s(y[6], y[7]);
            *(v4u*)(F.Y + tok * D_MODEL + 512 + h * 64 + ch * 8) = w;
        }
    }
}
__device__ __forceinline__ void conv_rows(Frame& F, int s0, int s1, int lane) {
    float w0[8], w1[8], w2[8], cb[8];
#pragma unroll
    for (int i = 0; i < 8; ++i) { w0[i] = F.conv_w[8 * lane + i]; w1[i] = F.conv_w[512 + 8 * lane + i]; w2[i] = F.conv_w[1024 + 8 * lane + i]; cb[i] = F.conv_b[8 * lane + i]; }
    const v4u zero = {0u, 0u, 0u, 0u};
    v4u tp = (s0 % SEQ == 0) ? zero : *(const v4u*)(F.T + (size_t)(s0 - 1) * AW + 8 * lane);
    v4u tc = *(const v4u*)(F.T + (size_t)s0 * AW + 8 * lane);
    for (int s = s0; s < s1; ++s) {
        const v4u tn = (s % SEQ == SEQ - 1) ? zero : *(const v4u*)(F.T + (size_t)(s + 1) * AW + 8 * lane);
        const v4u g = *(const v4u*)(F.Gt + (size_t)s * AW + 8 * lane);
        float y[8];
#define CV(i, P, C, N, GG, sel) y[i] = sel(GG) * (w0[i] * sel(P) + w1[i] * sel(C) + w2[i] * sel(N) + cb[i])
        CV(0, tp.x, tc.x, tn.x, g.x, bflo); CV(1, tp.x, tc.x, tn.x, g.x, bfhi); CV(2, tp.y, tc.y, tn.y, g.y, bflo); CV(3, tp.y, tc.y, tn.y, g.y, bfhi);
        CV(4, tp.z, tc.z, tn.z, g.z, bflo); CV(5, tp.z, tc.z, tn.z, g.z, bfhi); CV(6, tp.w, tc.w, tn.w, g.w, bflo); CV(7, tp.w, tc.w, tn.w, g.w, bfhi);
#undef CV
        v4u w; w.x = cvtpk_s(y[0], y[1]); w.y = cvtpk_s(y[2], y[3]); w.z = cvtpk_s(y[4], y[5]); w.w = cvtpk_s(y[6], y[7]);
        *(v4u*)(F.Y + (size_t)s * D_MODEL + 8 * lane) = w;
        tp = tc; tc = tn;
    }
}
__device__ __forceinline__ void attn_pass_a(Frame& F) {
    LAS unsigned char* wl = F.lds + RING_OFF + F.wave * 16384;
    const int gw = F.vcu * NWAVES + F.wave, NGW = F.G * NWAVES;
    constexpr int NT = 16384;
    const int per = (NT + NGW - 1) / NGW;
    for (int t = gw * per; t < (gw + 1) * per && t < NT; ++t) {
        const int c = 1 + (t >> 13), u = t & 8191;
        int sb, r; const int h = (u >> 9) & 7, b = u >> 12;
        if (c == 1) { sb = u & 127; r = (u >> 7) & 3; } else { sb = u & 31; r = (u >> 5) & 15; }
        attn_task<false>(F, c, b, h, r, sb, wl, F.lane);
    }
    const int rper = (M + NGW - 1) / NGW;
    const int s0 = gw * rper, s1 = (s0 + rper < M) ? s0 + rper : M;
    if (s0 < M) conv_rows(F, s0, s1, F.lane);
}
__device__ __forceinline__ void attn_pass_b(Frame& F) {
    LAS unsigned char* wl = F.lds + RING_OFF + F.wave * 16384;
    const int gw = F.vcu * NWAVES + F.wave, NGW = F.G * NWAVES;
    constexpr int NT = 8192;
    const int per = (NT + NGW - 1) / NGW;
    for (int t = gw * per; t < (gw + 1) * per && t < NT; ++t) {
        const int sb = t & 511, h = (t >> 9) & 7, b = t >> 12;
        attn_task<true>(F, 0, b, h, 0, sb, wl, F.lane);
    }
}

struct Args { const float* in[9]; float* out; unsigned char* ws; int ph_lo, ph_hi; };
__global__ void __launch_bounds__(NWAVES * 64, 2) mega(Args args) {
    extern __shared__ __attribute__((aligned(16))) unsigned char lds[];
    Frame F;
    F.lds = (LAS unsigned char*)lds;
    F.MISC = (volatile LAS unsigned*)(F.lds + MISC_OFF);
    F.tid = threadIdx.x; F.lane = F.tid & 63; F.wave = __builtin_amdgcn_readfirstlane(F.tid >> 6);
    F.G = gridDim.x; { const int bx = blockIdx.x; F.vcu = (F.G % 8 == 0) ? (bx % 8) * (F.G / 8) + bx / 8 : bx; }
    unsigned char* ws = args.ws;
    F.ctl = (gu32*)(ws + WS_CTL);
    F.x = args.in[0]; F.norm_w = args.in[1]; F.w_in = args.in[2]; F.conv_w = args.in[3]; F.conv_b = args.in[4]; F.qw = args.in[5]; F.kw = args.in[6]; F.rel_bias = args.in[7]; F.w_out = args.in[8];
    F.out = args.out;
    F.WinT = (bf16*)(ws + WS_WIN); F.WoutT = (bf16*)(ws + WS_WOUT); F.XN = (bf16*)(ws + WS_XN);
    F.T = (bf16*)(ws + WS_T); F.Gt = (bf16*)(ws + WS_G); F.Q = (bf16*)(ws + WS_Q); F.K = (bf16*)(ws + WS_K); F.V = (bf16*)(ws + WS_V); F.ZG = (bf16*)(ws + WS_ZG);
    F.OP4 = (bf16*)(ws + WS_OP4); F.OP16 = (bf16*)(ws + WS_OP16); F.Y = (bf16*)(ws + WS_Y);
    F.TBG = (float*)(ws + WS_TBG); F.LP4 = (float*)(ws + WS_LP4); F.LP16 = (float*)(ws + WS_LP16);
    for (int u = F.tid; u < (LDS_BYTES - LDSCTL_OFF) / 4; u += NWAVES * 64) ((LAS unsigned*)(F.lds + LDSCTL_OFF))[u] = 0u;
    __syncthreads();
    const int lo = args.ph_lo, hi = args.ph_hi;
    const bool multi = (hi - lo) > 1;
    XcdBarrier bar; bar.bar = (unsigned*)(F.ctl + CW_BAR); bar.x = 0; bar.st = nullptr;
    if (multi) bar = xcd_barrier_post((unsigned*)(F.ctl + CW_BAR), F.MISC + 8);
#define IN(k) (lo <= (k) && (k) < hi)
#define BOTH(k) (IN(k) && IN((k) + 1))
    if (IN(0)) { p0_prologue(F); if (BOTH(0)) xcd_barrier(bar); }
    if (IN(1)) {
        pg8::Gemm g{F.XN, F.WinT, M, NPROJ, D_MODEL}; pg8::StaticOrder S; S.init(M, NPROJ, F.G, (int)blockIdx.x);
        pg8::EpiProj E{F.T, F.Gt, F.Q, F.qw, F.kw};
        pg8::gemm_phase<pg8::EpiProj, pg8::StaticOrder, true, true>(F.lds + RING_OFF, g, S, E);
        if (BOTH(1)) xcd_barrier(bar);
    }
    if (IN(2)) { attn_pass_a(F); if (BOTH(2)) xcd_barrier(bar); }
    if (IN(3)) { attn_pass_b(F); if (BOTH(3)) xcd_barrier(bar); }
    if (IN(4)) {
        pg8::Gemm g{F.Y, F.WoutT, M, D_MODEL, D_MODEL}; pg8::StaticOrder S; S.init(M, D_MODEL, F.G, (int)blockIdx.x);
        pg8::EpiRes E{F.x, F.out, D_MODEL};
        pg8::gemm_phase<pg8::EpiRes, pg8::StaticOrder, true, true>(F.lds + RING_OFF, g, S, E);
    }
#undef IN
#undef BOTH
}

namespace naive {
__global__ void __launch_bounds__(256) k_conv(const bf16* T, const bf16* G, const float* conv_w, const float* conv_b, bf16* Y) {
    const int i = blockIdx.x * 256 + threadIdx.x;
    const int s = i >> 9, c = i & 511;
    if (s >= M) return;
    const float t1 = bf2f(T[(size_t)s * AW + c]);
    const float t0 = (s % SEQ == 0) ? 0.f : bf2f(T[(size_t)(s - 1) * AW + c]);
    const float t2 = (s % SEQ == SEQ - 1) ? 0.f : bf2f(T[(size_t)(s + 1) * AW + c]);
    const float z = conv_w[c] * t0 + conv_w[512 + c] * t1 + conv_w[1024 + c] * t2 + conv_b[c];
    Y[(size_t)s * D_MODEL + c] = (bf16)f2bf(bf2f(G[(size_t)s * AW + c]) * z);
}
__global__ void __launch_bounds__(64) k_attn(const bf16* Q, const bf16* K, const bf16* V, const bf16* ZG, const float* TBG, bf16* Y) {
    __shared__ float qs[64];
    __shared__ float ps[3 * 129];
    __shared__ int toks[3 * 129];
    const int lane = threadIdx.x, h = blockIdx.x & 7, tok = blockIdx.x >> 3, b = tok / SEQ, s = tok % SEQ;
    qs[lane] = bf2f(Q[(size_t)tok * AW + h * 64 + lane]);
    __syncthreads();
    for (int c = 0; c < 3; ++c) {
        const int d = c == 0 ? 1 : (c == 1 ? 4 : 16);
        for (int j = lane; j < 129; j += 64) {
            const int tk = s + (j - 64) * d;
            float lg = -1e30f; int tkv = -1;
            if (tk >= 0 && tk < SEQ) {
                const bf16* kr = K + ((size_t)b * SEQ + tk) * AW + h * 64;
                float dot = 0.f;
                for (int e = 0; e < 64; ++e) dot = fmaf(qs[e], bf2f(kr[e]), dot);
                lg = dot + TBG[(c * 8 + h) * 192 + 32 + j];
                tkv = b * SEQ + tk;
            }
            ps[c * 129 + j] = lg; toks[c * 129 + j] = tkv;
        }
    }
    __syncthreads();
    float lsum = 0.f;
    for (int j = lane; j < 387; j += 64) { const float p = toks[j] >= 0 ? exp2f(ps[j]) : 0.f; ps[j] = p; lsum += p; }
    lsum = wave_sum(lsum);
    __syncthreads();
    float o = 0.f;
    for (int j = 0; j < 387; ++j) { const int tk = toks[j]; if (tk >= 0) o = fmaf(ps[j], bf2f(V[(size_t)tk * AW + h * 64 + lane]), o); }
    Y[(size_t)tok * D_MODEL + 512 + h * 64 + lane] = (bf16)f2bf((o / lsum) * bf2f(ZG[(size_t)tok * AW + h * 64 + lane]));
}
__global__ void __launch_bounds__(256) k_gemm2(const bf16* A, const float* B, const float* X, float* C) {
    __shared__ float As[16][132];
    __shared__ float Bs[16][132];
    const int t = threadIdx.x, m0 = blockIdx.y * 128, n0 = blockIdx.x * 128;
    const int ar = t >> 1, ak = (t & 1) * 8, bk = t >> 4, bn = (t & 15) * 8, ty = t >> 4, tx = t & 15;
    float acc[8][8];
#pragma unroll
    for (int i = 0; i < 8; ++i)
#pragma unroll
        for (int j = 0; j < 8; ++j) acc[i][j] = 0.f;
    for (int k0 = 0; k0 < 1024; k0 += 16) {
        const v4u a = *(const v4u*)(A + (size_t)(m0 + ar) * 1024 + k0 + ak);
        const float av[8] = {bflo(a.x), bfhi(a.x), bflo(a.y), bfhi(a.y), bflo(a.z), bfhi(a.z), bflo(a.w), bfhi(a.w)};
        const float4 b0 = *(const float4*)(B + (size_t)(k0 + bk) * 1024 + n0 + bn);
        const float4 b1 = *(const float4*)(B + (size_t)(k0 + bk) * 1024 + n0 + bn + 4);
        __syncthreads();
#pragma unroll
        for (int i = 0; i < 8; ++i) As[ak + i][ar] = av[i];
        *(float4*)&Bs[bk][bn] = b0; *(float4*)&Bs[bk][bn + 4] = b1;
        __syncthreads();
#pragma unroll
        for (int k = 0; k < 16; ++k) {
            float a8[8], b8[8];
#pragma unroll
            for (int i = 0; i < 8; ++i) a8[i] = As[k][ty * 8 + i];
#pragma unroll
            for (int j = 0; j < 8; ++j) b8[j] = Bs[k][tx * 8 + j];
#pragma unroll
            for (int i = 0; i < 8; ++i)
#pragma unroll
                for (int j = 0; j < 8; ++j) acc[i][j] = fmaf(a8[i], b8[j], acc[i][j]);
        }
    }
#pragma unroll
    for (int i = 0; i < 8; ++i) { const size_t row = (size_t)(m0 + ty * 8 + i);
#pragma unroll
        for (int j = 0; j < 8; ++j) C[row * 1024 + n0 + tx * 8 + j] = acc[i][j] + X[row * 1024 + n0 + tx * 8 + j]; }
}
}

extern "C" void kernel_launch(void* const* d_in, const int* in_sizes, int n_in, void* d_out, int out_size, void* d_ws, size_t ws_size, hipStream_t stream) {
    static int grid = 0;
    if (grid == 0) {
        if (n_in != 9 || in_sizes[0] != M * D_MODEL || out_size != M * D_MODEL || ws_size < WS_END) { fprintf(stderr, "kernel_launch: unexpected shapes (n_in %d, in0 %d, out %d, ws %zu)\n", n_in, n_in > 0 ? in_sizes[0] : -1, out_size, ws_size); grid = -1; return; }
        int dev = 0, cus = 0, per_cu = 0;
        if (hipGetDevice(&dev) != hipSuccess || hipDeviceGetAttribute(&cus, hipDeviceAttributeMultiprocessorCount, dev) != hipSuccess) { grid = -1; return; }
        if (hipFuncSetAttribute((const void*)mega, hipFuncAttributeMaxDynamicSharedMemorySize, LDS_BYTES) != hipSuccess) { fprintf(stderr, "kernel_launch: hipFuncSetAttribute failed\n"); grid = -1; return; }
        if (hipOccupancyMaxActiveBlocksPerMultiprocessor(&per_cu, (const void*)mega, NWAVES * 64, LDS_BYTES) != hipSuccess || per_cu < 1) { fprintf(stderr, "kernel_launch: occupancy query says %d blocks per CU\n", per_cu); (void)hipGetLastError(); grid = -1; return; }
        grid = cus;
    }
    if (grid < 0) return;
    (void)hipMemsetAsync((char*)d_ws + WS_CTL, 0, CTL_ZERO_BYTES, stream);
    Args a{};
    for (int i = 0; i < 9; ++i) a.in[i] = (const float*)d_in[i];
    a.out = (float*)d_out; a.ws = (unsigned char*)d_ws;
    unsigned char* ws = (unsigned char*)d_ws;
#if STAGE == 4
    a.ph_lo = 0; a.ph_hi = 5;
    hipLaunchKernelGGL(mega, dim3(grid), dim3(NWAVES * 64), LDS_BYTES, stream, a);
#else
    const int nper = (STAGE == 3) ? 5 : 2;
    for (int p = 0; p < nper; ++p) { a.ph_lo = p; a.ph_hi = p + 1; hipLaunchKernelGGL(mega, dim3(grid), dim3(NWAVES * 64), LDS_BYTES, stream, a); }
#if STAGE <= 2
    naive::k_conv<<<M * 512 / 256, 256, 0, stream>>>((const bf16*)(ws + WS_T), (const bf16*)(ws + WS_G), (const float*)d_in[3], (const float*)d_in[4], (bf16*)(ws + WS_Y));
    naive::k_attn<<<M * 8, 64, 0, stream>>>((const bf16*)(ws + WS_Q), (const bf16*)(ws + WS_K), (const bf16*)(ws + WS_V), (const bf16*)(ws + WS_ZG), (const float*)(ws + WS_TBG), (bf16*)(ws + WS_Y));
#if STAGE == 1
    naive::k_gemm2<<<dim3(8, M / 128), 256, 0, stream>>>((const bf16*)(ws + WS_Y), (const float*)d_in[8], (const float*)d_in[0], (float*)d_out);
#else
    a.ph_lo = 4; a.ph_hi = 5; hipLaunchKernelGGL(mega, dim3(grid), dim3(NWAVES * 64), LDS_BYTES, stream, a);
#endif
#endif
#endif
}
```

```cpp
#include <hip/hip_runtime.h>
#include <cstdio>
#include <cstdint>

#ifndef STAGE
#define STAGE 4
#endif

namespace pg8 {
#define PG8_LAS __attribute__((address_space(3)))
typedef unsigned short bf16_t;
typedef short bf16x8 __attribute__((ext_vector_type(8)));
typedef float f32x4 __attribute__((ext_vector_type(4)));
typedef unsigned u32x4 __attribute__((ext_vector_type(4)));
typedef unsigned u32x2 __attribute__((ext_vector_type(2)));
constexpr int BM = 256, BK = 64, HALF = 128, HTB = HALF * BK * 2, STAGE_BYTES = 8 * HTB, NXCD = 8, WGM = 8;

__host__ __device__ __forceinline__ int lds_byte(int r, int c) { const int st = (r >> 4) * 2 + (c >> 5), rr = r & 15, cc = c & 31, ob = rr * 64 + cc * 2; return st * 1024 + (ob ^ (((ob >> 9) & 1) << 5)); }
__host__ __device__ __forceinline__ void stage_rc(int b, int& R, int& C) { const int st = b / 1024, sb = b % 1024, swz = sb ^ (((sb >> 9) & 1) << 5); R = (st >> 1) * 16 + swz / 64; C = (st & 1) * 32 + (swz % 64) / 2; }

struct Unit { int pm, pn; };
struct Gemm { const bf16_t* A; const bf16_t* Bt; int M, N, K; };

struct StaticOrder {
    int nM, nN, nwg, G, c;
    __host__ __device__ void init(int M, int N, int G_, int c_) { nM = M / BM; nN = N / BM; nwg = nM * nN; G = G_; c = c_; }
    __host__ __device__ bool next(int i, Unit& u) const {
        const long L = (long)i * G + c; if (L >= nwg) return false;
        int wgid = (int)L; { const int q = nwg / NXCD, r = nwg % NXCD, xcd = wgid % NXCD, off = wgid / NXCD; wgid = (xcd < r ? xcd * (q + 1) : r * (q + 1) + (xcd - r) * q) + off; }
        const int nig = WGM * nN, gid = wgid / nig, fm = gid * WGM, gsz = (nM - fm) < WGM ? (nM - fm) : WGM;
        u.pm = fm + ((wgid % nig) % gsz); u.pn = (wgid % nig) / gsz; return true;
    }
};

__device__ __forceinline__ unsigned cvt_pk_bf16(float lo, float hi) { unsigned r; asm volatile("v_cvt_pk_bf16_f32 %0, %1, %2" : "=v"(r) : "v"(lo), "v"(hi)); return r; }
__device__ __forceinline__ float silu_f(float z) { return z * __builtin_amdgcn_rcpf(1.f + __builtin_amdgcn_exp2f(-1.4426950408889634f * z)); }

struct EpiProj {
    static constexpr bool PERM = false, AFTER_DRAIN = false;
    bf16_t *T, *G, *QKVZ; const float *qw, *kw;
    __device__ __forceinline__ void operator()(const f32x4 (&acc)[2][2][4][2], const Unit& u, int wr, int wc, int fr, int fq) const {
        const int row0 = u.pm * BM + wr * 64 + fr;
        if (u.pn < 8) {
            const int ch0 = 64 * u.pn + 16 * wc + 4 * fq;
#pragma unroll
            for (int ai = 0; ai < 2; ++ai)
#pragma unroll
                for (int m = 0; m < 4; ++m) {
                    const size_t off = (size_t)(row0 + ai * HALF + m * 16) * 512 + ch0;
                    const f32x4 uu = acc[ai][0][m][0], gb = acc[ai][0][m][1], gc = acc[ai][1][m][0], z = acc[ai][1][m][1];
                    f32x4 t = gc * uu, g;
#pragma unroll
                    for (int i = 0; i < 4; ++i) g[i] = gb[i] * silu_f(z[i]);
                    u32x2 tw, gw; tw.x = cvt_pk_bf16(t[0], t[1]); tw.y = cvt_pk_bf16(t[2], t[3]); gw.x = cvt_pk_bf16(g[0], g[1]); gw.y = cvt_pk_bf16(g[2], g[3]);
                    *(u32x2*)(T + off) = tw; *(u32x2*)(G + off) = gw;
                }
        } else {
            const int grp = (u.pn - 8) >> 1, head = 4 * ((u.pn - 8) & 1) + wc;
            bf16_t* dst = QKVZ + (size_t)grp * (size_t)(16u << 20);
            const int col0 = head * 64 + 8 * fq;
            f32x4 wv[2][2];
            if (grp < 2) { const float* w = grp == 0 ? qw : kw;
#pragma unroll
                for (int bj = 0; bj < 2; ++bj)
#pragma unroll
                    for (int n = 0; n < 2; ++n) wv[bj][n] = *(const f32x4*)(w + 32 * bj + 8 * fq + 4 * n); }
            const float sc = grp == 0 ? 0.125f * 1.4426950408889634f : 1.f;
#pragma unroll
            for (int ai = 0; ai < 2; ++ai)
#pragma unroll
                for (int m = 0; m < 4; ++m) {
                    f32x4 v[2][2];
#pragma unroll
                    for (int bj = 0; bj < 2; ++bj)
#pragma unroll
                        for (int n = 0; n < 2; ++n) v[bj][n] = acc[ai][bj][m][n];
                    if (grp < 2) {
                        float ss = 0.f;
#pragma unroll
                        for (int bj = 0; bj < 2; ++bj)
#pragma unroll
                            for (int n = 0; n < 2; ++n) ss += (v[bj][n][0] * v[bj][n][0] + v[bj][n][1] * v[bj][n][1]) + (v[bj][n][2] * v[bj][n][2] + v[bj][n][3] * v[bj][n][3]);
                        ss += __shfl_xor(ss, 16); ss += __shfl_xor(ss, 32);
                        const float rs = __builtin_amdgcn_rsqf(ss * (1.f / 64.f) + 1e-6f) * sc;
#pragma unroll
                        for (int bj = 0; bj < 2; ++bj)
#pragma unroll
                            for (int n = 0; n < 2; ++n) v[bj][n] = v[bj][n] * rs * wv[bj][n];
                    } else if (grp == 3) {
#pragma unroll
                        for (int bj = 0; bj < 2; ++bj)
#pragma unroll
                            for (int n = 0; n < 2; ++n)
#pragma unroll
                                for (int i = 0; i < 4; ++i) v[bj][n][i] = silu_f(v[bj][n][i]);
                    }
                    bf16_t* rowp = dst + (size_t)(row0 + ai * HALF + m * 16) * 512 + col0;
#pragma unroll
                    for (int bj = 0; bj < 2; ++bj) { u32x4 w; w.x = cvt_pk_bf16(v[bj][0][0], v[bj][0][1]); w.y = cvt_pk_bf16(v[bj][0][2], v[bj][0][3]); w.z = cvt_pk_bf16(v[bj][1][0], v[bj][1][1]); w.w = cvt_pk_bf16(v[bj][1][2], v[bj][1][3]);
                        *(u32x4*)(rowp + 32 * bj) = w; }
                }
        }
    }
};
struct EpiRes {
    static constexpr bool PERM = false, AFTER_DRAIN = false;
    const float* X; float* O; int ldc;
    __device__ __forceinline__ void operator()(const f32x4 (&acc)[2][2][4][2], const Unit& u, int wr, int wc, int fr, int fq) const {
        const int row0 = u.pm * BM + wr * 64 + fr, col0 = u.pn * BM + wc * 32 + 4 * fq;
#pragma unroll
        for (int ai = 0; ai < 2; ++ai)
#pragma unroll
            for (int m = 0; m < 4; ++m) { const size_t off = (size_t)(row0 + ai * HALF + m * 16) * ldc + col0;
#pragma unroll
                for (int bj = 0; bj < 2; ++bj)
#pragma unroll
                    for (int n = 0; n < 2; ++n) *(f32x4*)(O + off + bj * HALF + n * 16) = acc[ai][bj][m][n] + *(const f32x4*)(X + off + bj * HALF + n * 16); }
    }
};

template <class Epi, class Sched, bool ALIGN_EPI = false, bool SP2 = false>
__device__ __forceinline__ void gemm_phase(PG8_LAS unsigned char* lds, const Gemm g, const Sched& S, const Epi& E) {
    const int tid = threadIdx.x, wid = __builtin_amdgcn_readfirstlane(tid >> 6), lane = tid & 63, wr = wid >> 2, wc = wid & 3, fr = lane & 15, fq = lane >> 4;
    const int K = g.K, nt = K / BK;
    unsigned voffA[2], voffB[2];
#pragma unroll
    for (int i = 0; i < 2; ++i) { int R, C; stage_rc(tid * 16 + i * 8192, R, C);
        voffA[i] = (unsigned)(R * K + C) * 2u; voffB[i] = (unsigned)(R * K + C) * 2u; }
    const size_t kstep = (size_t)(BK * 2);
    const size_t hstep = (size_t)HALF * K * 2;
    const size_t tstep = 2 * hstep;
    const unsigned ldsw = (unsigned)wid * 1024u;
    const int aoff = lds_byte(wr * 64 + fr, fq * 8), boff = lds_byte(wc * 32 + fr, fq * 8);
#define PG8_SA(b, h) (((b) * 2 + (h)) * HTB)
#define PG8_SB(b, h) ((4 + (b) * 2 + (h)) * HTB)
#define PG8_STAGE(bufoff, gbase, voff) do { _Pragma("unroll") for (int _i = 0; _i < 2; ++_i) \
        __builtin_amdgcn_global_load_lds((const unsigned*)((const char*)(gbase) + (voff)[_i]), (PG8_LAS unsigned*)(lds + (bufoff) + ldsw + _i * 8192), 16, 0, 0); } while (0)
#define PG8_LDA(dst, b, h) do { _Pragma("unroll") for (int m = 0; m < 4; ++m) _Pragma("unroll") for (int k = 0; k < 2; ++k) dst[m][k] = *(const PG8_LAS bf16x8*)(lds + PG8_SA(b, h) + aoff + m * 2048 + k * 1024); } while (0)
#define PG8_LDB(dst, b, h) do { _Pragma("unroll") for (int n = 0; n < 2; ++n) _Pragma("unroll") for (int k = 0; k < 2; ++k) dst[n][k] = *(const PG8_LAS bf16x8*)(lds + PG8_SB(b, h) + boff + n * 2048 + k * 1024); } while (0)
#define PG8_MMA(ai, bj, At, Bt) do { __builtin_amdgcn_s_setprio(1); _Pragma("unroll") for (int m = 0; m < 4; ++m) _Pragma("unroll") for (int n = 0; n < 2; ++n) _Pragma("unroll") for (int k = 0; k < 2; ++k) \
        acc[ai][bj][m][n] = __builtin_amdgcn_mfma_f32_16x16x32_bf16(Bt[n][k], At[m][k], acc[ai][bj][m][n], 0, 0, 0); __builtin_amdgcn_s_setprio(0); } while (0)
#define PG8_WAIT_V(n) asm volatile("s_waitcnt vmcnt(" #n ")" ::: "memory")
#define PG8_WAIT_L(n) asm volatile("s_waitcnt lgkmcnt(" #n ")" ::: "memory")
#define PG8_BAR __builtin_amdgcn_s_barrier()
#define PG8_SCHED __builtin_amdgcn_sched_barrier(0)
    Unit cur, nxt; int ui = 0;
    if (!S.next(0, cur)) return;
    f32x4 acc[2][2][4][2];
#pragma unroll
    for (int a = 0; a < 2; ++a)
#pragma unroll
        for (int b = 0; b < 2; ++b)
#pragma unroll
            for (int m = 0; m < 4; ++m)
#pragma unroll
                for (int n = 0; n < 2; ++n) acc[a][b][m][n] = (f32x4){0.f, 0.f, 0.f, 0.f};
    bf16x8 At[4][2], B0[2][2], B1[2][2];
    const char* cA = (const char*)g.A + (size_t)cur.pm * tstep; const char* cB = (const char*)g.Bt + (size_t)cur.pn * tstep;
    if constexpr (SP2) {
        PG8_STAGE(PG8_SB(0, 0), cB, voffB); PG8_STAGE(PG8_SB(0, 1), cB + hstep, voffB); PG8_STAGE(PG8_SA(0, 0), cA, voffA); PG8_STAGE(PG8_SA(0, 1), cA + hstep, voffA);
        if (wr == 1) PG8_BAR;
        PG8_WAIT_V(2); PG8_BAR;
        PG8_STAGE(PG8_SB(1, 0), cB + kstep, voffB); PG8_STAGE(PG8_SA(1, 0), cA + kstep, voffA); PG8_STAGE(PG8_SB(1, 1), cB + hstep + kstep, voffB);
        PG8_WAIT_V(6); PG8_BAR;
    } else {
        PG8_STAGE(PG8_SB(0, 0), cB, voffB); PG8_STAGE(PG8_SA(0, 0), cA, voffA); PG8_STAGE(PG8_SB(0, 1), cB + hstep, voffB); PG8_STAGE(PG8_SA(0, 1), cA + hstep, voffA);
        if (wr == 1) PG8_BAR;
        PG8_WAIT_V(4); PG8_BAR;
        PG8_STAGE(PG8_SB(1, 0), cB + kstep, voffB); PG8_STAGE(PG8_SA(1, 0), cA + kstep, voffA); PG8_STAGE(PG8_SB(1, 1), cB + hstep + kstep, voffB);
        PG8_WAIT_V(6); PG8_BAR;
    }
    for (;;) {
        const bool has_next = S.next(ui + 1, nxt);
        const char* nA = has_next ? (const char*)g.A + (size_t)nxt.pm * tstep : cA; const char* nB = has_next ? (const char*)g.Bt + (size_t)nxt.pn * tstep : cB;
        for (int t = 0; t < nt; t += 2) {
            const bool last = (t == nt - 2);
            const char* a1 = cA + (size_t)(t + 1) * kstep;
            const char* a2 = last ? nA : cA + (size_t)(t + 2) * kstep; const char* b2 = last ? nB : cB + (size_t)(t + 2) * kstep;
            const char* a3 = a2 + kstep; const char* b3 = b2 + kstep;
            if constexpr (SP2) {
            PG8_LDB(B0, 0, 0); PG8_LDB(B1, 0, 1); PG8_SCHED; PG8_LDA(At, 0, 0); PG8_STAGE(PG8_SA(1, 1), a1 + hstep, voffA);
            PG8_WAIT_V(8); PG8_WAIT_L(0); PG8_BAR; PG8_MMA(0, 0, At, B0); PG8_MMA(0, 1, At, B1); PG8_BAR; PG8_SCHED;
            PG8_LDA(At, 0, 1); PG8_STAGE(PG8_SB(0, 0), b2, voffB); PG8_STAGE(PG8_SB(0, 1), b2 + hstep, voffB); PG8_STAGE(PG8_SA(0, 0), a2, voffA);
            PG8_WAIT_V(8); PG8_WAIT_L(0); PG8_BAR; PG8_MMA(1, 0, At, B0); PG8_MMA(1, 1, At, B1); PG8_BAR; PG8_SCHED;
            PG8_LDB(B0, 1, 0); PG8_LDB(B1, 1, 1); PG8_SCHED; PG8_LDA(At, 1, 0); PG8_STAGE(PG8_SA(0, 1), a2 + hstep, voffA);
            PG8_WAIT_V(8); PG8_WAIT_L(0); PG8_BAR; PG8_MMA(0, 0, At, B0); PG8_MMA(0, 1, At, B1); PG8_BAR; PG8_SCHED;
            PG8_LDA(At, 1, 1); PG8_STAGE(PG8_SB(1, 0), b3, voffB); PG8_STAGE(PG8_SB(1, 1), b3 + hstep, voffB); PG8_STAGE(PG8_SA(1, 0), a3, voffA);
            PG8_WAIT_V(8); PG8_WAIT_L(0); PG8_BAR; PG8_MMA(1, 0, At, B0); PG8_MMA(1, 1, At, B1); PG8_BAR; PG8_SCHED;
            } else {
            PG8_LDB(B0, 0, 0); PG8_SCHED; PG8_LDA(At, 0, 0); PG8_STAGE(PG8_SA(1, 1), a1 + hstep, voffA);
            PG8_WAIT_L(8); PG8_BAR; PG8_WAIT_L(0); PG8_MMA(0, 0, At, B0); PG8_BAR; PG8_SCHED;
            PG8_LDB(B1, 0, 1); PG8_STAGE(PG8_SB(0, 0), b2, voffB);
            PG8_BAR; PG8_WAIT_L(0); PG8_MMA(0, 1, At, B1); PG8_BAR;
            PG8_LDA(At, 0, 1); PG8_STAGE(PG8_SA(0, 0), a2, voffA);
            PG8_BAR; PG8_WAIT_L(0); PG8_MMA(1, 0, At, B0); PG8_BAR; PG8_SCHED;
            PG8_STAGE(PG8_SB(0, 1), b2 + hstep, voffB);
            PG8_WAIT_V(6); PG8_BAR; PG8_MMA(1, 1, At, B1); PG8_BAR;
            PG8_LDB(B0, 1, 0); PG8_SCHED; PG8_LDA(At, 1, 0); PG8_STAGE(PG8_SA(0, 1), a2 + hstep, voffA);
            PG8_WAIT_L(8); PG8_BAR; PG8_WAIT_L(0); PG8_MMA(0, 0, At, B0); PG8_BAR; PG8_SCHED;
            PG8_LDB(B1, 1, 1); PG8_STAGE(PG8_SB(1, 0), b3, voffB);
            PG8_BAR; PG8_WAIT_L(0); PG8_MMA(0, 1, At, B1); PG8_BAR;
            PG8_LDA(At, 1, 1); PG8_STAGE(PG8_SA(1, 0), a3, voffA);
            PG8_BAR; PG8_WAIT_L(0); PG8_MMA(1, 0, At, B0); PG8_BAR; PG8_SCHED;
            PG8_STAGE(PG8_SB(1, 1), b3 + hstep, voffB);
            PG8_WAIT_V(6); PG8_BAR; PG8_MMA(1, 1, At, B1); PG8_BAR;
            }
        }
        if constexpr (ALIGN_EPI) { if (wr == 0) PG8_BAR; }
        E(acc, cur, wr, wc, fr, fq);
        if (!has_next) break;
#pragma unroll
        for (int a = 0; a < 2; ++a)
#pragma unroll
            for (int b = 0; b < 2; ++b)
#pragma unroll
                for (int m = 0; m < 4; ++m)
#pragma unroll
                    for (int n = 0; n < 2; ++n) acc[a][b][m][n] = (f32x4){0.f, 0.f, 0.f, 0.f};
        cur = nxt; cA = nA; cB = nB; ++ui;
        if constexpr (ALIGN_EPI) { if (wr == 1) PG8_BAR; }
    }
    PG8_WAIT_V(0);
    if constexpr (!ALIGN_EPI) { if (wr == 0) PG8_BAR; }
    PG8_BAR;
#undef PG8_SA
#undef PG8_SB
#undef PG8_STAGE
#undef PG8_LDA
#undef PG8_LDB
#undef PG8_MMA
#undef PG8_WAIT_V
#undef PG8_WAIT_L
#undef PG8_BAR
#undef PG8_SCHED
}
}

constexpr int D_MODEL = 1024, BATCH = 2, SEQ = 16384, M = BATCH * SEQ, NPROJ = 4096, AW = 512, NHEAD = 8;
constexpr int NWAVES = 8;
constexpr size_t MiB = 1u << 20;
constexpr size_t WS_CTL = 0, CTL_ZERO_BYTES = 1 * MiB;
constexpr size_t WS_TBG = 1 * MiB;
constexpr size_t WS_WIN = 2 * MiB;
constexpr size_t WS_WOUT = 10 * MiB;
constexpr size_t WS_LP4 = 12 * MiB, WS_LP16 = 13 * MiB;
constexpr size_t WS_XN = 16 * MiB;
constexpr size_t WS_T = 80 * MiB, WS_G = 112 * MiB, WS_Q = 144 * MiB, WS_K = 176 * MiB, WS_V = 208 * MiB, WS_ZG = 240 * MiB;
constexpr size_t WS_OP4 = 272 * MiB, WS_OP16 = 304 * MiB;
constexpr size_t WS_Y = 336 * MiB;
constexpr size_t WS_END = 400 * MiB;
constexpr int CW_BAR = 4096;

constexpr int RING_OFF = 0, RING_BYTES = 131072;
constexpr int LDSCTL_OFF = RING_BYTES, MISC_OFF = LDSCTL_OFF + 320;
constexpr int LDS_BYTES = 147456;

#define GAS __attribute__((address_space(1)))
#define LAS __attribute__((address_space(3)))
typedef unsigned short bf16;
typedef unsigned v4u __attribute__((ext_vector_type(4)));
typedef float f32x4 __attribute__((ext_vector_type(4)));
typedef float f32x16 __attribute__((ext_vector_type(16)));
typedef short bf16x8 __attribute__((ext_vector_type(8)));
typedef short s16x4 __attribute__((ext_vector_type(4)));
typedef GAS unsigned gu32;
#define RLX_AGENT __ATOMIC_RELAXED, __HIP_MEMORY_SCOPE_AGENT
#define LDS_WAIT() asm volatile("s_waitcnt lgkmcnt(0)" ::: "memory")
__device__ __forceinline__ unsigned f2bf(float f) { unsigned u = __builtin_bit_cast(unsigned, f); return (u + 0x7fffu + ((u >> 16) & 1u)) >> 16; }
__device__ __forceinline__ unsigned pk2(float lo, float hi) { return f2bf(lo) | (f2bf(hi) << 16); }
__device__ __forceinline__ float bf2f(unsigned short b) { return __builtin_bit_cast(float, (unsigned)b << 16); }
__device__ __forceinline__ float bflo(unsigned w) { return __builtin_bit_cast(float, w << 16); }
__device__ __forceinline__ float bfhi(unsigned w) { return __builtin_bit_cast(float, w & 0xffff0000u); }

#define XB_TMO      128
#define XB_XCNT(j)  (256  + 64 * (j))
#define XB_XSUB(j)  (1280 + 64 * (j))
#define XB_XGEN(j)  (2304 + 64 * (j))
#define XB_TOP      3328
#define XB_TOPGEN   3392
#define XCD_BAR_WORDS 3456
#define XB_SPIN_CAP (1u << 18)
__device__ __forceinline__ unsigned xb_ld(unsigned* p)              { return __hip_atomic_load(p, __ATOMIC_RELAXED, __HIP_MEMORY_SCOPE_AGENT); }
__device__ __forceinline__ unsigned xb_add(unsigned* p, unsigned v) { return __hip_atomic_fetch_add(p, v, __ATOMIC_RELAXED, __HIP_MEMORY_SCOPE_AGENT); }
__device__ __forceinline__ unsigned xb_xcc_id() { return (unsigned)__builtin_amdgcn_s_getreg((3 << 11) | 20) & 0xFu; }
#define XB_SPIN(cond, bar) do { unsigned _sp = 0; while (cond) { __builtin_amdgcn_s_sleep(1); \
    if ((++_sp & 255u) == 0u) { if (xb_ld(&(bar)[XB_TMO])) break; if (_sp > XB_SPIN_CAP) { atomicAdd(&(bar)[XB_TMO], 1u); break; } } } } while (0)
struct XcdBarrier { unsigned* bar; unsigned x; volatile LAS unsigned* st; };
__device__ __forceinline__ XcdBarrier xcd_barrier_post(unsigned* bar, volatile LAS unsigned* st) {
    XcdBarrier b; b.bar = bar; b.x = xb_xcc_id(); b.st = st;
    if (threadIdx.x == 0) (void)xb_add(&bar[XB_XCNT(b.x)], 1u);
    return b;
}
__device__ __forceinline__ void xcd_barrier_complete(unsigned* bar, unsigned x, unsigned& nloc, unsigned& nx) {
    const unsigned G = gridDim.x * gridDim.y * gridDim.z;
    unsigned sum, cnt, mine, sp = 0u;
    for (;;) {
        sum = 0u; cnt = 0u; mine = 0u;
#pragma unroll
        for (unsigned j = 0; j < 16; ++j) { const unsigned c = xb_ld(&bar[XB_XCNT(j)]); sum += c; cnt += (c > 0u) ? 1u : 0u; mine = (j == x) ? c : mine; }
        if (sum == G) break;
        __builtin_amdgcn_s_sleep(1);
        if ((++sp & 255u) == 0u) { if (xb_ld(&bar[XB_TMO])) break; if (sp > XB_SPIN_CAP) { atomicAdd(&bar[XB_TMO], 1u); break; } }
    }
    nloc = mine > 0u ? mine : 1u; nx = cnt > 0u ? cnt : 1u;
}
__device__ __forceinline__ void xcd_barrier(const XcdBarrier& b) {
    asm volatile("s_waitcnt vmcnt(0)" ::: "memory");
    __syncthreads();
    if (threadIdx.x == 0) {
        unsigned* bar = b.bar;
        __builtin_amdgcn_s_waitcnt(0);
        unsigned nloc = b.st[0], nx = b.st[1];
        if (nloc == 0u) { xcd_barrier_complete(bar, b.x, nloc, nx); b.st[0] = nloc; b.st[1] = nx; }
        const unsigned old = xb_add(&bar[XB_XSUB(b.x)], 1u);
        const unsigned gen = old / nloc;
        if (old + 1u == (gen + 1u) * nloc) {
            __builtin_amdgcn_fence(__ATOMIC_RELEASE, "agent");
            asm volatile("s_waitcnt vmcnt(0)" ::: "memory");
            const unsigned og = xb_add(&bar[XB_TOP], 1u);
            const unsigned tg = og / nx;
            if (og + 1u == (tg + 1u) * nx) xb_add(&bar[XB_TOPGEN], 1u);
            else XB_SPIN(xb_ld(&bar[XB_TOPGEN]) == tg, bar);
            __builtin_amdgcn_fence(__ATOMIC_ACQUIRE, "agent");
            xb_add(&bar[XB_XGEN(b.x)], 1u);
            asm volatile("s_waitcnt vmcnt(0)" ::: "memory");
        } else {
            XB_SPIN(xb_ld(&bar[XB_XGEN(b.x)]) == gen, bar);
            __builtin_amdgcn_fence(__ATOMIC_ACQUIRE, "agent");
            asm volatile("s_waitcnt vmcnt(0)" ::: "memory");
        }
    }
    __syncthreads();
}

struct Frame {
    LAS unsigned char* lds;
    volatile LAS unsigned* MISC;
    gu32* ctl;
    int tid, lane, wave, vcu, G;
    const float *x, *norm_w, *w_in, *conv_w, *conv_b, *qw, *kw, *rel_bias, *w_out; float* out;
    bf16 *WinT, *WoutT, *XN, *T, *Gt, *Q, *K, *V, *ZG, *OP4, *OP16, *Y;
    float *TBG, *LP4, *LP16;
};
__device__ __forceinline__ float wave_sum(float v) {
#pragma unroll
    for (int o = 1; o < 64; o <<= 1) v += __shfl_xor(v, o);
    return v;
}
__device__ __forceinline__ float wave_max(float v) {
#pragma unroll
    for (int o = 1; o < 64; o <<= 1) v = fmaxf(v, __shfl_xor(v, o));
    return v;
}
__device__ __forceinline__ int win_row(int L) {
    int pn, wc, bj, n, fq, reg;
    if (L < 2048) { const int which = L >> 9, ch = L & 511; pn = ch >> 6; wc = (ch >> 4) & 3; fq = (ch >> 2) & 3; reg = ch & 3; bj = which >> 1; n = which & 1; }
    else { const int Lp = L - 2048, grp = Lp >> 9, head = (Lp >> 6) & 7, e = Lp & 63; pn = 8 + 2 * grp + (head >> 2); wc = head & 3; bj = e >> 5; fq = (e >> 3) & 3; n = (e >> 2) & 1; reg = e & 3; }
    return pn * 256 + 128 * bj + 32 * wc + 16 * n + 4 * fq + reg;
}
template <bool PERMUTE>
__device__ __forceinline__ void p0_transpose_item(const float* W, int K, int N, bf16* WT, LAS float* scr, int item, int lane) {
    const int nblk = N / 32, kb = item / nblk, nb = item % nblk, k0 = 64 * kb, n0 = 32 * nb;
#pragma unroll 8
    for (int i = 0; i < 32; ++i) { const int kk = 2 * i + (lane >> 5); scr[kk * 33 + (lane & 31)] = W[(size_t)(k0 + kk) * N + n0 + (lane & 31)]; }
    LDS_WAIT(); asm volatile("" ::: "memory");
    const int c = lane & 7;
#pragma unroll
    for (int j = 0; j < 4; ++j) { const int n = (lane >> 3) + 8 * j; const LAS float* s = scr + (8 * c) * 33 + n;
        v4u o; o.x = pk2(s[0 * 33], s[1 * 33]); o.y = pk2(s[2 * 33], s[3 * 33]); o.z = pk2(s[4 * 33], s[5 * 33]); o.w = pk2(s[6 * 33], s[7 * 33]);
        const int dr = PERMUTE ? win_row(n0 + n) : (n0 + n);
        *(GAS v4u*)(WT + (size_t)dr * K + k0 + 8 * c) = o; }
    LDS_WAIT(); asm volatile("" ::: "memory");
}
__device__ __forceinline__ int t5_bucket(int rel) {
    const int n = rel < 0 ? -rel : rel; int b = rel > 0 ? 16 : 0;
    if (n < 8) return b + n;
    int large = 8 + (int)(logf((float)n / 8.f) / logf(128.f) * 8.f);
    if (large > 15) large = 15;
    return b + large;
}
__device__ __forceinline__ void p0_prologue(Frame& F) {
    LAS float* scr = (LAS float*)(F.lds + RING_OFF + F.wave * 16384);
    const int gw = F.vcu * NWAVES + F.wave, NGW = F.G * NWAVES;
    constexpr int I_IN = (D_MODEL / 64) * (NPROJ / 32), I_OUT = (D_MODEL / 64) * (D_MODEL / 32);
    for (int it = gw; it < I_IN + I_OUT; it += NGW) {
        if (it < I_IN) p0_transpose_item<true>(F.w_in, D_MODEL, NPROJ, F.WinT, scr, it, F.lane);
        else p0_transpose_item<false>(F.w_out, D_MODEL, D_MODEL, F.WoutT, scr, it - I_IN, F.lane);
    }
    f32x4 nw[4];
#pragma unroll
    for (int j = 0; j < 4; ++j) nw[j] = ((const f32x4*)F.norm_w)[F.lane + 64 * j];
    for (int m = gw; m < M; m += NGW) {
        const GAS f32x4* xr = (const GAS f32x4*)(F.x + (size_t)m * D_MODEL) + F.lane;
        f32x4 v[4]; float s = 0.f;
#pragma unroll
        for (int j = 0; j < 4; ++j) { v[j] = xr[64 * j]; s += (v[j].x * v[j].x + v[j].y * v[j].y) + (v[j].z * v[j].z + v[j].w * v[j].w); }
        const float rstd = 1.f / sqrtf(wave_sum(s) * (1.f / D_MODEL) + 1e-6f);
        GAS unsigned long long* o8 = (GAS unsigned long long*)(F.XN + (size_t)m * D_MODEL) + F.lane;
#pragma unroll
        for (int j = 0; j < 4; ++j) { const f32x4 y = v[j] * rstd * nw[j]; o8[64 * j] = (unsigned long long)pk2(y.x, y.y) | ((unsigned long long)pk2(y.z, y.w) << 32); }
    }
    if (blockIdx.x == 0) {
        const float mq = wave_max(fabsf(F.qw[F.lane])), mk = wave_max(fabsf(F.kw[F.lane]));
        float mb = 0.f;
#pragma unroll
        for (int j = 0; j < 4; ++j) mb = fmaxf(mb, fabsf(F.rel_bias[F.lane + 64 * j]));
        mb = wave_max(mb);
        const float M2 = (8.f * mq * mk + mb) * 1.4426950408889634f;
        for (int i = F.tid; i < 3 * 8 * 192; i += NWAVES * 64) {
            const int jp = i % 192, h = (i / 192) & 7, c = i / (192 * 8), j = jp - 32;
            const int dil = c == 0 ? 1 : (c == 1 ? 4 : 16);
            float v = -1e30f;
            if (j >= 0 && j <= 128) v = F.rel_bias[t5_bucket((j - 64) * dil) * 8 + h] * 1.4426950408889634f - M2;
            F.TBG[i] = v;
        }
    }
}

__device__ __forceinline__ int crow(int r, int hi) { return (r & 3) + 8 * (r >> 2) + 4 * hi; }
__device__ __forceinline__ unsigned cvtpk_s(float lo, float hi) { typedef float f2 __attribute__((ext_vector_type(2))); typedef __bf16 b2 __attribute__((ext_vector_type(2))); f2 v = {lo, hi}; b2 b = __builtin_convertvector(v, b2); return __builtin_bit_cast(unsigned, b); }
typedef short v4i16_t __attribute__((ext_vector_type(4)));
__device__ __forceinline__ s16x4 vtr(LAS const unsigned char* p) { return __builtin_bit_cast(s16x4, __builtin_amdgcn_ds_read_tr16_b64_v4i16((LAS v4i16_t*)p)); }

struct TaskD { int dil, L, i0, hq, c, h, tok0; };
template <bool FINAL>
__device__ __forceinline__ TaskD task_decode(int t) {
    TaskD D;
    if (FINAL) { D.c = 0; D.dil = 1; D.L = SEQ; D.i0 = (t & 511) * 32; D.h = (t >> 9) & 7; D.tok0 = (t >> 12) * SEQ; }
    else { const int c = 1 + (t >> 13), u = t & 8191; D.c = c; D.h = (u >> 9) & 7; const int b = u >> 12; int sb, r;
        if (c == 1) { sb = u & 127; r = (u >> 7) & 3; D.dil = 4; D.L = SEQ / 4; } else { sb = u & 31; r = (u >> 5) & 15; D.dil = 16; D.L = SEQ / 16; }
        D.i0 = sb * 32; D.tok0 = b * SEQ + r; }
    D.hq = D.h * 64;
    return D;
}
template <bool FINAL>
__device__ __forceinline__ void attn_tasks(Frame& F, int t0, int t1, LAS unsigned char* wl, int lane) {
    if (t0 >= t1) return;
    const int r32 = lane & 31, hi = lane >> 5;
    LAS float* tbl = (LAS float*)(wl + 8192);
    LAS float* lw = (LAS float*)(wl + 9216);
    LAS float* stg = (LAS float*)wl;
    const int vaddr = ((lane >> 4) & 1) * 32 + (lane & 3) * 8 + (4 * hi + ((lane & 15) >> 2)) * 64;
    bf16x8 qr[4], kf0[4], kf1[4], kf2[4], kf3[4], kf4[4], vrA[4], vrB[4];
#define LOADQ(D_) do { const unsigned qo_ = (unsigned)(((D_).tok0 + (D_).dil * ((D_).i0 + r32)) * AW + (D_).hq + hi * 8); \
        _Pragma("unroll") for (int d0 = 0; d0 < 4; ++d0) qr[d0] = *(const bf16x8*)(F.Q + qo_ + d0 * 16); } while (0)
#define LOADK(D_, kc, KF) do { int kk_ = (D_).i0 - 64 + 32 * (kc) + r32; kk_ = kk_ < 0 ? 0 : (kk_ > (D_).L - 1 ? (D_).L - 1 : kk_); \
        const unsigned ko_ = (unsigned)(((D_).tok0 + (D_).dil * kk_) * AW + (D_).hq + hi * 8); \
        _Pragma("unroll") for (int d0 = 0; d0 < 4; ++d0) KF[d0] = *(const bf16x8*)(F.K + ko_ + d0 * 16); } while (0)
#define LOADV(D_, kc, VR) do { _Pragma("unroll") for (int kg = 0; kg < 2; ++kg) { int vk_ = (D_).i0 - 64 + 32 * (kc) + 16 * kg + (lane >> 2); vk_ = vk_ < 0 ? 0 : (vk_ > (D_).L - 1 ? (D_).L - 1 : vk_); \
            const unsigned vo_ = (unsigned)(((D_).tok0 + (D_).dil * vk_) * AW + (D_).hq + 8 * (lane & 3)); \
            VR[kg] = *(const bf16x8*)(F.V + vo_); VR[2 + kg] = *(const bf16x8*)(F.V + vo_ + 32); } } while (0)
#define CHUNK(kc, KF, VR, PRE) do { const int buf_ = ((kc) & 1) * 4096; const int k0_ = D.i0 - 64 + 32 * (kc); \
        _Pragma("unroll") for (int pc = 0; pc < 4; ++pc) *(LAS bf16x8*)(wl + buf_ + pc * 1024 + lane * 16) = VR[pc]; \
        f32x16 a_; { const LAS float* tp_ = tbl + (32 + 32 * (kc) + 4 * hi - r32); \
            _Pragma("unroll") for (int rr = 0; rr < 16; ++rr) a_[rr] = tp_[(rr & 3) + 8 * (rr >> 2)]; } \
        if (k0_ < 0 || k0_ + 32 > D.L) { _Pragma("unroll") for (int rr = 0; rr < 16; ++rr) { const int key_ = k0_ + crow(rr, hi); if (key_ < 0 || key_ >= D.L) a_[rr] = -1e30f; } } \
        _Pragma("unroll") for (int d0 = 0; d0 < 4; ++d0) a_ = __builtin_amdgcn_mfma_f32_32x32x16_bf16(KF[d0], qr[d0], a_, 0, 0, 0); \
        PRE; \
        _Pragma("unroll") for (int rr = 0; rr < 16; ++rr) { a_[rr] = __builtin_amdgcn_exp2f(a_[rr]); lsum += a_[rr]; } \
        v4u pw0_, pw1_; pw0_.x = cvtpk_s(a_[0], a_[1]); pw0_.y = cvtpk_s(a_[2], a_[3]); pw0_.z = cvtpk_s(a_[4], a_[5]); pw0_.w = cvtpk_s(a_[6], a_[7]); \
        pw1_.x = cvtpk_s(a_[8], a_[9]); pw1_.y = cvtpk_s(a_[10], a_[11]); pw1_.z = cvtpk_s(a_[12], a_[13]); pw1_.w = cvtpk_s(a_[14], a_[15]); \
        const LAS unsigned char* vb_ = wl + buf_ + vaddr; \
        { s16x4 l0 = vtr(vb_), h0 = vtr(vb_ + 512), l1 = vtr(vb_ + 1024), h1 = vtr(vb_ + 1536); \
          o0 = __builtin_amdgcn_mfma_f32_32x32x16_bf16(__builtin_bit_cast(bf16x8, pw0_), (bf16x8){l0[0], l0[1], l0[2], l0[3], h0[0], h0[1], h0[2], h0[3]}, o0, 0, 0, 0); \
          o0 = __builtin_amdgcn_mfma_f32_32x32x16_bf16(__builtin_bit_cast(bf16x8, pw1_), (bf16x8){l1[0], l1[1], l1[2], l1[3], h1[0], h1[1], h1[2], h1[3]}, o0, 0, 0, 0); } \
        { s16x4 l2 = vtr(vb_ + 2048), h2 = vtr(vb_ + 2560), l3 = vtr(vb_ + 3072), h3 = vtr(vb_ + 3584); \
          o1 = __builtin_amdgcn_mfma_f32_32x32x16_bf16(__builtin_bit_cast(bf16x8, pw0_), (bf16x8){l2[0], l2[1], l2[2], l2[3], h2[0], h2[1], h2[2], h2[3]}, o1, 0, 0, 0); \
          o1 = __builtin_amdgcn_mfma_f32_32x32x16_bf16(__builtin_bit_cast(bf16x8, pw1_), (bf16x8){l3[0], l3[1], l3[2], l3[3], h3[0], h3[1], h3[2], h3[3]}, o1, 0, 0, 0); } } while (0)
    TaskD D = task_decode<FINAL>(t0);
    LOADQ(D); LOADK(D, 0, kf0); LOADV(D, 0, vrA); LOADK(D, 1, kf1); LOADV(D, 1, vrB); LOADK(D, 2, kf2); LOADK(D, 3, kf3); LOADK(D, 4, kf4);
    int tb_ch = -1;
    for (int t = t0; t < t1; ++t) {
        const TaskD Dn = task_decode<FINAL>(t + 1 < t1 ? t + 1 : t);
        if (tb_ch != D.c * 8 + D.h) { tb_ch = D.c * 8 + D.h; const float* tg = F.TBG + tb_ch * 192; tbl[lane] = tg[lane]; tbl[lane + 64] = tg[lane + 64]; tbl[lane + 128] = tg[lane + 128]; }
        f32x16 o0 = {}, o1 = {}; float lsum = 0.f;
        CHUNK(0, kf0, vrA, LOADV(D, 2, vrA));
        CHUNK(1, kf1, vrB, LOADV(D, 3, vrB));
        CHUNK(2, kf2, vrA, LOADV(D, 4, vrA));
        CHUNK(3, kf3, vrB, (void)0);
        CHUNK(4, kf4, vrA, (void)0);
        LOADQ(Dn); LOADK(Dn, 0, kf0); LOADK(Dn, 1, kf1); LOADK(Dn, 2, kf2); LOADK(Dn, 3, kf3); LOADK(Dn, 4, kf4);
        if (!FINAL) { LOADV(Dn, 0, vrA); LOADV(Dn, 1, vrB); }
        lsum += __shfl_xor(lsum, 32);
        v4u p4[4], p16[4], zg[4]; float l4[4], l16[4];
        if (FINAL) {
#pragma unroll
            for (int i = 0; i < 4; ++i) { const int row = i * 8 + (lane >> 3), ch = lane & 7; const unsigned tok = (unsigned)(D.tok0 + D.i0 + row); const unsigned eo = tok * AW + D.hq + ch * 8;
                p4[i] = *(const v4u*)(F.OP4 + eo); p16[i] = *(const v4u*)(F.OP16 + eo); zg[i] = *(const v4u*)(F.ZG + eo);
                l4[i] = F.LP4[tok * 8 + D.h]; l16[i] = F.LP16[tok * 8 + D.h]; }
        }
#pragma unroll
        for (int rr = 0; rr < 16; ++rr) { const int q = crow(rr, hi); stg[q * 64 + r32] = o0[rr]; stg[q * 64 + 32 + r32] = o1[rr]; }
        if (FINAL) { if (hi == 0) lw[r32] = lsum; }
        else { if (hi == 0) { float* lp = F.LP4 + (size_t)(D.c - 1) * (size_t)(256u << 10) + (unsigned)((D.tok0 + D.dil * (D.i0 + r32)) * 8 + D.h); *lp = lsum; } }
#pragma unroll
        for (int i = 0; i < 4; ++i) {
            const int row = i * 8 + (lane >> 3), ch = lane & 7;
            const unsigned tok = (unsigned)(D.tok0 + D.dil * (D.i0 + row));
            const f32x4 a = *(const LAS f32x4*)(stg + row * 64 + ch * 8), bq = *(const LAS f32x4*)(stg + row * 64 + ch * 8 + 4);
            if (!FINAL) {
                v4u w; w.x = cvtpk_s(a[0], a[1]); w.y = cvtpk_s(a[2], a[3]); w.z = cvtpk_s(bq[0], bq[1]); w.w = cvtpk_s(bq[2], bq[3]);
                *(v4u*)(F.OP4 + (size_t)(D.c - 1) * (size_t)(16u << 20) + (tok * AW + D.hq + ch * 8)) = w;
            } else {
                const float inv = 1.f / (lw[row] + l4[i] + l16[i]);
                float y[8];
                y[0] = (a[0] + bflo(p4[i].x) + bflo(p16[i].x)) * inv * bflo(zg[i].x); y[1] = (a[1] + bfhi(p4[i].x) + bfhi(p16[i].x)) * inv * bfhi(zg[i].x);
                y[2] = (a[2] + bflo(p4[i].y) + bflo(p16[i].y)) * inv * bflo(zg[i].y); y[3] = (a[3] + bfhi(p4[i].y) + bfhi(p16[i].y)) * inv * bfhi(zg[i].y);
                y[4] = (bq[0] + bflo(p4[i].z) + bflo(p16[i].z)) * inv * bflo(zg[i].z); y[5] = (bq[1] + bfhi(p4[i].z) + bfhi(p16[i].z)) * inv * bfhi(zg[i].z);
                y[6] = (bq[2] + bflo(p4[i].w) + bflo(p16[i].w)) * inv * bflo(zg[i].w); y[7] = (bq[3] + bfhi(p4[i].w) + bfhi(p16[i].w)) * inv * bfhi(zg[i].w);
                v4u w; w.x = cvtpk_s(y[0], y[1]); w.y = cvtpk_s(y[2], y[3]); w.z = cvtpk_s(y[4], y[5]); w.w = cvtpk_s(y[6], y[7]);
                *(v4u*)(F.Y + (tok * D_MODEL + 512 + D.hq + ch * 8)) = w;
            }
        }
        if (FINAL) { LOADV(Dn, 0, vrA); LOADV(Dn, 1, vrB); }
        D = Dn;
    }
#undef LOADQ
#undef LOADK
#undef LOADV
#undef CHUNK
}
template <int NB>
__device__ __forceinline__ void conv_batch(Frame& F, int s0, int lane, const float (&w0)[8], const float (&w1)[8], const float (&w2)[8], const float (&cb)[8]) {
    const v4u zero = {0u, 0u, 0u, 0u};
    v4u tr[NB + 2], g[NB];
#pragma unroll
    for (int j = 0; j < NB + 2; ++j) { const int s = s0 - 1 + j; const bool ok = (j == 0) ? (s0 % SEQ != 0) : ((j == NB + 1) ? ((s0 + NB) % SEQ != 0) : true);
        tr[j] = zero; if (ok) tr[j] = *(const v4u*)(F.T + (size_t)s * AW + 8 * lane); }
#pragma unroll
    for (int j = 0; j < NB; ++j) g[j] = *(const v4u*)(F.Gt + (size_t)(s0 + j) * AW + 8 * lane);
#pragma unroll
    for (int j = 0; j < NB; ++j) {
        const v4u tp = tr[j], tc = tr[j + 1], tn = tr[j + 2], gg = g[j];
        float y[8];
#define CV(i, P, C, N, GG, sel) y[i] = sel(GG) * (w0[i] * sel(P) + w1[i] * sel(C) + w2[i] * sel(N) + cb[i])
        CV(0, tp.x, tc.x, tn.x, gg.x, bflo); CV(1, tp.x, tc.x, tn.x, gg.x, bfhi); CV(2, tp.y, tc.y, tn.y, gg.y, bflo); CV(3, tp.y, tc.y, tn.y, gg.y, bfhi);
        CV(4, tp.z, tc.z, tn.z, gg.z, bflo); CV(5, tp.z, tc.z, tn.z, gg.z, bfhi); CV(6, tp.w, tc.w, tn.w, gg.w, bflo); CV(7, tp.w, tc.w, tn.w, gg.w, bfhi);
#undef CV
        v4u w; w.x = cvtpk_s(y[0], y[1]); w.y = cvtpk_s(y[2], y[3]); w.z = cvtpk_s(y[4], y[5]); w.w = cvtpk_s(y[6], y[7]);
        *(v4u*)(F.Y + (size_t)(s0 + j) * D_MODEL + 8 * lane) = w;
    }
}
__device__ __forceinline__ void conv_rows(Frame& F, int s0, int s1, int lane) {
    float w0[8], w1[8], w2[8], cb[8];
#pragma unroll
    for (int i = 0; i < 8; ++i) { w0[i] = F.conv_w[8 * lane + i]; w1[i] = F.conv_w[512 + 8 * lane + i]; w2[i] = F.conv_w[1024 + 8 * lane + i]; cb[i] = F.conv_b[8 * lane + i]; }
    int s = s0;
    for (; s + 8 <= s1; s += 8) conv_batch<8>(F, s, lane, w0, w1, w2, cb);
    for (; s < s1; ++s) conv_batch<1>(F, s, lane, w0, w1, w2, cb);
}
__device__ __forceinline__ void attn_pass_a(Frame& F) {
    LAS unsigned char* wl = F.lds + RING_OFF + F.wave * 16384;
    const int gw = F.vcu * NWAVES + F.wave, NGW = F.G * NWAVES;
    constexpr int NT = 16384;
    const int per = (NT + NGW - 1) / NGW;
    const int t0 = gw * per, t1 = (t0 + per < NT) ? t0 + per : NT;
    attn_tasks<false>(F, t0, t1, wl, F.lane);
    const int rper = (M + NGW - 1) / NGW;
    const int s0 = gw * rper, s1 = (s0 + rper < M) ? s0 + rper : M;
    if (s0 < M) conv_rows(F, s0, s1, F.lane);
}
__device__ __forceinline__ void attn_pass_b(Frame& F) {
    LAS unsigned char* wl = F.lds + RING_OFF + F.wave * 16384;
    const int gw = F.vcu * NWAVES + F.wave, NGW = F.G * NWAVES;
    constexpr int NT = 8192;
    const int per = (NT + NGW - 1) / NGW;
    const int t0 = gw * per, t1 = (t0 + per < NT) ? t0 + per : NT;
    attn_tasks<true>(F, t0, t1, wl, F.lane);
}

struct Args { const float* in[9]; float* out; unsigned char* ws; int ph_lo, ph_hi; };
__global__ void __launch_bounds__(NWAVES * 64, 2) mega(Args args) {
    extern __shared__ __attribute__((aligned(16))) unsigned char lds[];
    Frame F;
    F.lds = (LAS unsigned char*)lds;
    F.MISC = (volatile LAS unsigned*)(F.lds + MISC_OFF);
    F.tid = threadIdx.x; F.lane = F.tid & 63; F.wave = __builtin_amdgcn_readfirstlane(F.tid >> 6);
    F.G = gridDim.x; { const int bx = blockIdx.x; F.vcu = (F.G % 8 == 0) ? (bx % 8) * (F.G / 8) + bx / 8 : bx; }
    unsigned char* ws = args.ws;
    F.ctl = (gu32*)(ws + WS_CTL);
    F.x = args.in[0]; F.norm_w = args.in[1]; F.w_in = args.in[2]; F.conv_w = args.in[3]; F.conv_b = args.in[4]; F.qw = args.in[5]; F.kw = args.in[6]; F.rel_bias = args.in[7]; F.w_out = args.in[8];
    F.out = args.out;
    F.WinT = (bf16*)(ws + WS_WIN); F.WoutT = (bf16*)(ws + WS_WOUT); F.XN = (bf16*)(ws + WS_XN);
    F.T = (bf16*)(ws + WS_T); F.Gt = (bf16*)(ws + WS_G); F.Q = (bf16*)(ws + WS_Q); F.K = (bf16*)(ws + WS_K); F.V = (bf16*)(ws + WS_V); F.ZG = (bf16*)(ws + WS_ZG);
    F.OP4 = (bf16*)(ws + WS_OP4); F.OP16 = (bf16*)(ws + WS_OP16); F.Y = (bf16*)(ws + WS_Y);
    F.TBG = (float*)(ws + WS_TBG); F.LP4 = (float*)(ws + WS_LP4); F.LP16 = (float*)(ws + WS_LP16);
    for (int u = F.tid; u < (LDS_BYTES - LDSCTL_OFF) / 4; u += NWAVES * 64) ((LAS unsigned*)(F.lds + LDSCTL_OFF))[u] = 0u;
    __syncthreads();
    const int lo = args.ph_lo, hi = args.ph_hi;
    const bool multi = (hi - lo) > 1;
    XcdBarrier bar; bar.bar = (unsigned*)(F.ctl + CW_BAR); bar.x = 0; bar.st = nullptr;
    if (multi) bar = xcd_barrier_post((unsigned*)(F.ctl + CW_BAR), F.MISC + 8);
#define IN(k) (lo <= (k) && (k) < hi)
#define BOTH(k) (IN(k) && IN((k) + 1))
    if (IN(0)) { p0_prologue(F); if (BOTH(0)) xcd_barrier(bar); }
    if (IN(1)) {
        pg8::Gemm g{F.XN, F.WinT, M, NPROJ, D_MODEL}; pg8::StaticOrder S; S.init(M, NPROJ, F.G, (int)blockIdx.x);
        pg8::EpiProj E{F.T, F.Gt, F.Q, F.qw, F.kw};
        pg8::gemm_phase<pg8::EpiProj, pg8::StaticOrder, true, true>(F.lds + RING_OFF, g, S, E);
        if (BOTH(1)) xcd_barrier(bar);
    }
    if (IN(2)) { attn_pass_a(F); if (BOTH(2)) xcd_barrier(bar); }
    if (IN(3)) { attn_pass_b(F); if (BOTH(3)) xcd_barrier(bar); }
    if (IN(4)) {
        pg8::Gemm g{F.Y, F.WoutT, M, D_MODEL, D_MODEL}; pg8::StaticOrder S; S.init(M, D_MODEL, F.G, (int)blockIdx.x);
        pg8::EpiRes E{F.x, F.out, D_MODEL};
        pg8::gemm_phase<pg8::EpiRes, pg8::StaticOrder, true, true>(F.lds + RING_OFF, g, S, E);
    }
#undef IN
#undef BOTH
}

namespace naive {
__global__ void __launch_bounds__(256) k_conv(const bf16* T, const bf16* G, const float* conv_w, const float* conv_b, bf16* Y) {
    const int i = blockIdx.x * 256 + threadIdx.x;
    const int s = i >> 9, c = i & 511;
    if (s >= M) return;
    const float t1 = bf2f(T[(size_t)s * AW + c]);
    const float t0 = (s % SEQ == 0) ? 0.f : bf2f(T[(size_t)(s - 1) * AW + c]);
    const float t2 = (s % SEQ == SEQ - 1) ? 0.f : bf2f(T[(size_t)(s + 1) * AW + c]);
    const float z = conv_w[c] * t0 + conv_w[512 + c] * t1 + conv_w[1024 + c] * t2 + conv_b[c];
    Y[(size_t)s * D_MODEL + c] = (bf16)f2bf(bf2f(G[(size_t)s * AW + c]) * z);
}
__global__ void __launch_bounds__(64) k_attn(const bf16* Q, const bf16* K, const bf16* V, const bf16* ZG, const float* TBG, bf16* Y) {
    __shared__ float qs[64];
    __shared__ float ps[3 * 129];
    __shared__ int toks[3 * 129];
    const int lane = threadIdx.x, h = blockIdx.x & 7, tok = blockIdx.x >> 3, b = tok / SEQ, s = tok % SEQ;
    qs[lane] = bf2f(Q[(size_t)tok * AW + h * 64 + lane]);
    __syncthreads();
    for (int c = 0; c < 3; ++c) {
        const int d = c == 0 ? 1 : (c == 1 ? 4 : 16);
        for (int j = lane; j < 129; j += 64) {
            const int tk = s + (j - 64) * d;
            float lg = -1e30f; int tkv = -1;
            if (tk >= 0 && tk < SEQ) {
                const bf16* kr = K + ((size_t)b * SEQ + tk) * AW + h * 64;
                float dot = 0.f;
                for (int e = 0; e < 64; ++e) dot = fmaf(qs[e], bf2f(kr[e]), dot);
                lg = dot + TBG[(c * 8 + h) * 192 + 32 + j];
                tkv = b * SEQ + tk;
            }
            ps[c * 129 + j] = lg; toks[c * 129 + j] = tkv;
        }
    }
    __syncthreads();
    float lsum = 0.f;
    for (int j = lane; j < 387; j += 64) { const float p = toks[j] >= 0 ? exp2f(ps[j]) : 0.f; ps[j] = p; lsum += p; }
    lsum = wave_sum(lsum);
    __syncthreads();
    float o = 0.f;
    for (int j = 0; j < 387; ++j) { const int tk = toks[j]; if (tk >= 0) o = fmaf(ps[j], bf2f(V[(size_t)tk * AW + h * 64 + lane]), o); }
    Y[(size_t)tok * D_MODEL + 512 + h * 64 + lane] = (bf16)f2bf((o / lsum) * bf2f(ZG[(size_t)tok * AW + h * 64 + lane]));
}
__global__ void __launch_bounds__(256) k_gemm2(const bf16* A, const float* B, const float* X, float* C) {
    __shared__ float As[16][132];
    __shared__ float Bs[16][132];
    const int t = threadIdx.x, m0 = blockIdx.y * 128, n0 = blockIdx.x * 128;
    const int ar = t >> 1, ak = (t & 1) * 8, bk = t >> 4, bn = (t & 15) * 8, ty = t >> 4, tx = t & 15;
    float acc[8][8];
#pragma unroll
    for (int i = 0; i < 8; ++i)
#pragma unroll
        for (int j = 0; j < 8; ++j) acc[i][j] = 0.f;
    for (int k0 = 0; k0 < 1024; k0 += 16) {
        const v4u a = *(const v4u*)(A + (size_t)(m0 + ar) * 1024 + k0 + ak);
        const float av[8] = {bflo(a.x), bfhi(a.x), bflo(a.y), bfhi(a.y), bflo(a.z), bfhi(a.z), bflo(a.w), bfhi(a.w)};
        const float4 b0 = *(const float4*)(B + (size_t)(k0 + bk) * 1024 + n0 + bn);
        const float4 b1 = *(const float4*)(B + (size_t)(k0 + bk) * 1024 + n0 + bn + 4);
        __syncthreads();
#pragma unroll
        for (int i = 0; i < 8; ++i) As[ak + i][ar] = av[i];
        *(float4*)&Bs[bk][bn] = b0; *(float4*)&Bs[bk][bn + 4] = b1;
        __syncthreads();
#pragma unroll
        for (int k = 0; k < 16; ++k) {
            float a8[8], b8[8];
#pragma unroll
            for (int i = 0; i < 8; ++i) a8[i] = As[k][ty * 8 + i];
#pragma unroll
            for (int j = 0; j < 8; ++j) b8[j] = Bs[k][tx * 8 + j];
#pragma unroll
            for (int i = 0; i < 8; ++i)
#pragma unroll
                for (int j = 0; j < 8; ++j) acc[i][j] = fmaf(a8[i], b8[j], acc[i][j]);
        }
    }
#pragma unroll
    for (int i = 0; i < 8; ++i) { const size_t row = (size_t)(m0 + ty * 8 + i);
#pragma unroll
        for (int j = 0; j < 8; ++j) C[row * 1024 + n0 + tx * 8 + j] = acc[i][j] + X[row * 1024 + n0 + tx * 8 + j]; }
}
}

extern "C" void kernel_launch(void* const* d_in, const int* in_sizes, int n_in, void* d_out, int out_size, void* d_ws, size_t ws_size, hipStream_t stream) {
    static int grid = 0;
    if (grid == 0) {
        if (n_in != 9 || in_sizes[0] != M * D_MODEL || out_size != M * D_MODEL || ws_size < WS_END) { fprintf(stderr, "kernel_launch: unexpected shapes (n_in %d, in0 %d, out %d, ws %zu)\n", n_in, n_in > 0 ? in_sizes[0] : -1, out_size, ws_size); grid = -1; return; }
        int dev = 0, cus = 0, per_cu = 0;
        if (hipGetDevice(&dev) != hipSuccess || hipDeviceGetAttribute(&cus, hipDeviceAttributeMultiprocessorCount, dev) != hipSuccess) { grid = -1; return; }
        if (hipFuncSetAttribute((const void*)mega, hipFuncAttributeMaxDynamicSharedMemorySize, LDS_BYTES) != hipSuccess) { fprintf(stderr, "kernel_launch: hipFuncSetAttribute failed\n"); grid = -1; return; }
        if (hipOccupancyMaxActiveBlocksPerMultiprocessor(&per_cu, (const void*)mega, NWAVES * 64, LDS_BYTES) != hipSuccess || per_cu < 1) { fprintf(stderr, "kernel_launch: occupancy query says %d blocks per CU\n", per_cu); (void)hipGetLastError(); grid = -1; return; }
        grid = cus;
    }
    if (grid < 0) return;
    (void)hipMemsetAsync((char*)d_ws + WS_CTL, 0, CTL_ZERO_BYTES, stream);
    Args a{};
    for (int i = 0; i < 9; ++i) a.in[i] = (const float*)d_in[i];
    a.out = (float*)d_out; a.ws = (unsigned char*)d_ws;
    unsigned char* ws = (unsigned char*)d_ws;
#if STAGE == 4
    a.ph_lo = 0; a.ph_hi = 5;
    hipLaunchKernelGGL(mega, dim3(grid), dim3(NWAVES * 64), LDS_BYTES, stream, a);
#else
    const int nper = (STAGE == 3) ? 5 : 2;
    for (int p = 0; p < nper; ++p) { a.ph_lo = p; a.ph_hi = p + 1; hipLaunchKernelGGL(mega, dim3(grid), dim3(NWAVES * 64), LDS_BYTES, stream, a); }
#if STAGE <= 2
    naive::k_conv<<<M * 512 / 256, 256, 0, stream>>>((const bf16*)(ws + WS_T), (const bf16*)(ws + WS_G), (const float*)d_in[3], (const float*)d_in[4], (bf16*)(ws + WS_Y));
    naive::k_attn<<<M * 8, 64, 0, stream>>>((const bf16*)(ws + WS_Q), (const bf16*)(ws + WS_K), (const bf16*)(ws + WS_V), (const bf16*)(ws + WS_ZG), (const float*)(ws + WS_TBG), (bf16*)(ws + WS_Y));
#if STAGE == 1
    naive::k_gemm2<<<dim3(8, M / 128), 256, 0, stream>>>((const bf16*)(ws + WS_Y), (const float*)d_in[8], (const float*)d_in[0], (float*)d_out);
#else
    a.ph_lo = 4; a.ph_hi = 5; hipLaunchKernelGGL(mega, dim3(grid), dim3(NWAVES * 64), LDS_BYTES, stream, a);
#endif
#endif
#endif
}
```

```cpp
#include <hip/hip_runtime.h>
#include <cstdio>
#include <cstdint>

#ifndef STAGE
#define STAGE 4
#endif

namespace pg8 {
#define PG8_LAS __attribute__((address_space(3)))
typedef unsigned short bf16_t;
typedef short bf16x8 __attribute__((ext_vector_type(8)));
typedef float f32x4 __attribute__((ext_vector_type(4)));
typedef unsigned u32x4 __attribute__((ext_vector_type(4)));
typedef unsigned u32x2 __attribute__((ext_vector_type(2)));
constexpr int BM = 256, BK = 64, HALF = 128, HTB = HALF * BK * 2, STAGE_BYTES = 8 * HTB, NXCD = 8, WGM = 8;

__host__ __device__ __forceinline__ int lds_byte(int r, int c) { const int st = (r >> 4) * 2 + (c >> 5), rr = r & 15, cc = c & 31, ob = rr * 64 + cc * 2; return st * 1024 + (ob ^ (((ob >> 9) & 1) << 5)); }
__host__ __device__ __forceinline__ void stage_rc(int b, int& R, int& C) { const int st = b / 1024, sb = b % 1024, swz = sb ^ (((sb >> 9) & 1) << 5); R = (st >> 1) * 16 + swz / 64; C = (st & 1) * 32 + (swz % 64) / 2; }

struct Unit { int pm, pn; };
struct Gemm { const bf16_t* A; const bf16_t* Bt; int M, N, K; };

struct StaticOrder {
    int nM, nN, nwg, G, c;
    __host__ __device__ void init(int M, int N, int G_, int c_) { nM = M / BM; nN = N / BM; nwg = nM * nN; G = G_; c = c_; }
    __host__ __device__ bool next(int i, Unit& u) const {
        const long L = (long)i * G + c; if (L >= nwg) return false;
        int wgid = (int)L; { const int q = nwg / NXCD, r = nwg % NXCD, xcd = wgid % NXCD, off = wgid / NXCD; wgid = (xcd < r ? xcd * (q + 1) : r * (q + 1) + (xcd - r) * q) + off; }
        const int nig = WGM * nN, gid = wgid / nig, fm = gid * WGM, gsz = (nM - fm) < WGM ? (nM - fm) : WGM;
        u.pm = fm + ((wgid % nig) % gsz); u.pn = (wgid % nig) / gsz; return true;
    }
};

__device__ __forceinline__ unsigned cvt_pk_bf16(float lo, float hi) { unsigned r; asm volatile("v_cvt_pk_bf16_f32 %0, %1, %2" : "=v"(r) : "v"(lo), "v"(hi)); return r; }
__device__ __forceinline__ float silu_f(float z) { return z * __builtin_amdgcn_rcpf(1.f + __builtin_amdgcn_exp2f(-1.4426950408889634f * z)); }

struct EpiProj {
    static constexpr bool PERM = false, AFTER_DRAIN = false;
    bf16_t *T, *G, *QKVZ; const float *qw, *kw;
    __device__ __forceinline__ void operator()(const f32x4 (&acc)[2][2][4][2], const Unit& u, int wr, int wc, int fr, int fq) const {
        const int row0 = u.pm * BM + wr * 64 + fr;
        if (u.pn < 8) {
            const int ch0 = 64 * u.pn + 16 * wc + 4 * fq;
#pragma unroll
            for (int ai = 0; ai < 2; ++ai)
#pragma unroll
                for (int m = 0; m < 4; ++m) {
                    const size_t off = (size_t)(row0 + ai * HALF + m * 16) * 512 + ch0;
                    const f32x4 uu = acc[ai][0][m][0], gb = acc[ai][0][m][1], gc = acc[ai][1][m][0], z = acc[ai][1][m][1];
                    f32x4 t = gc * uu, g;
#pragma unroll
                    for (int i = 0; i < 4; ++i) g[i] = gb[i] * silu_f(z[i]);
                    u32x2 tw, gw; tw.x = cvt_pk_bf16(t[0], t[1]); tw.y = cvt_pk_bf16(t[2], t[3]); gw.x = cvt_pk_bf16(g[0], g[1]); gw.y = cvt_pk_bf16(g[2], g[3]);
                    *(u32x2*)(T + off) = tw; *(u32x2*)(G + off) = gw;
                }
        } else {
            const int grp = (u.pn - 8) >> 1, head = 4 * ((u.pn - 8) & 1) + wc;
            bf16_t* dst = QKVZ + (size_t)grp * (size_t)(16u << 20);
            const int col0 = head * 64 + 8 * fq;
            f32x4 wv[2][2];
            if (grp < 2) { const float* w = grp == 0 ? qw : kw;
#pragma unroll
                for (int bj = 0; bj < 2; ++bj)
#pragma unroll
                    for (int n = 0; n < 2; ++n) wv[bj][n] = *(const f32x4*)(w + 32 * bj + 8 * fq + 4 * n); }
            const float sc = grp == 0 ? 0.125f * 1.4426950408889634f : 1.f;
#pragma unroll
            for (int ai = 0; ai < 2; ++ai)
#pragma unroll
                for (int m = 0; m < 4; ++m) {
                    f32x4 v[2][2];
#pragma unroll
                    for (int bj = 0; bj < 2; ++bj)
#pragma unroll
                        for (int n = 0; n < 2; ++n) v[bj][n] = acc[ai][bj][m][n];
                    if (grp < 2) {
                        float ss = 0.f;
#pragma unroll
                        for (int bj = 0; bj < 2; ++bj)
#pragma unroll
                            for (int n = 0; n < 2; ++n) ss += (v[bj][n][0] * v[bj][n][0] + v[bj][n][1] * v[bj][n][1]) + (v[bj][n][2] * v[bj][n][2] + v[bj][n][3] * v[bj][n][3]);
                        ss += __shfl_xor(ss, 16); ss += __shfl_xor(ss, 32);
                        const float rs = __builtin_amdgcn_rsqf(ss * (1.f / 64.f) + 1e-6f) * sc;
#pragma unroll
                        for (int bj = 0; bj < 2; ++bj)
#pragma unroll
                            for (int n = 0; n < 2; ++n) v[bj][n] = v[bj][n] * rs * wv[bj][n];
                    } else if (grp == 3) {
#pragma unroll
                        for (int bj = 0; bj < 2; ++bj)
#pragma unroll
                            for (int n = 0; n < 2; ++n)
#pragma unroll
                                for (int i = 0; i < 4; ++i) v[bj][n][i] = silu_f(v[bj][n][i]);
                    }
                    bf16_t* rowp = dst + (size_t)(row0 + ai * HALF + m * 16) * 512 + col0;
#pragma unroll
                    for (int bj = 0; bj < 2; ++bj) { u32x4 w; w.x = cvt_pk_bf16(v[bj][0][0], v[bj][0][1]); w.y = cvt_pk_bf16(v[bj][0][2], v[bj][0][3]); w.z = cvt_pk_bf16(v[bj][1][0], v[bj][1][1]); w.w = cvt_pk_bf16(v[bj][1][2], v[bj][1][3]);
                        *(u32x4*)(rowp + 32 * bj) = w; }
                }
        }
    }
};
struct EpiRes {
    static constexpr bool PERM = false, AFTER_DRAIN = false;
    const float* X; float* O; int ldc;
    __device__ __forceinline__ void operator()(const f32x4 (&acc)[2][2][4][2], const Unit& u, int wr, int wc, int fr, int fq) const {
        const int row0 = u.pm * BM + wr * 64 + fr, col0 = u.pn * BM + wc * 32 + 4 * fq;
#pragma unroll
        for (int ai = 0; ai < 2; ++ai)
#pragma unroll
            for (int m = 0; m < 4; ++m) { const size_t off = (size_t)(row0 + ai * HALF + m * 16) * ldc + col0;
#pragma unroll
                for (int bj = 0; bj < 2; ++bj)
#pragma unroll
                    for (int n = 0; n < 2; ++n) *(f32x4*)(O + off + bj * HALF + n * 16) = acc[ai][bj][m][n] + *(const f32x4*)(X + off + bj * HALF + n * 16); }
    }
};

template <class Epi, class Sched, bool ALIGN_EPI = false, bool SP2 = false>
__device__ __forceinline__ void gemm_phase(PG8_LAS unsigned char* lds, const Gemm g, const Sched& S, const Epi& E) {
    const int tid = threadIdx.x, wid = __builtin_amdgcn_readfirstlane(tid >> 6), lane = tid & 63, wr = wid >> 2, wc = wid & 3, fr = lane & 15, fq = lane >> 4;
    const int K = g.K, nt = K / BK;
    unsigned voffA[2], voffB[2];
#pragma unroll
    for (int i = 0; i < 2; ++i) { int R, C; stage_rc(tid * 16 + i * 8192, R, C);
        voffA[i] = (unsigned)(R * K + C) * 2u; voffB[i] = (unsigned)(R * K + C) * 2u; }
    const size_t kstep = (size_t)(BK * 2);
    const size_t hstep = (size_t)HALF * K * 2;
    const size_t tstep = 2 * hstep;
    const unsigned ldsw = (unsigned)wid * 1024u;
    const int aoff = lds_byte(wr * 64 + fr, fq * 8), boff = lds_byte(wc * 32 + fr, fq * 8);
#define PG8_SA(b, h) (((b) * 2 + (h)) * HTB)
#define PG8_SB(b, h) ((4 + (b) * 2 + (h)) * HTB)
#define PG8_STAGE(bufoff, gbase, voff) do { _Pragma("unroll") for (int _i = 0; _i < 2; ++_i) \
        __builtin_amdgcn_global_load_lds((const unsigned*)((const char*)(gbase) + (voff)[_i]), (PG8_LAS unsigned*)(lds + (bufoff) + ldsw + _i * 8192), 16, 0, 0); } while (0)
#define PG8_LDA(dst, b, h) do { _Pragma("unroll") for (int m = 0; m < 4; ++m) _Pragma("unroll") for (int k = 0; k < 2; ++k) dst[m][k] = *(const PG8_LAS bf16x8*)(lds + PG8_SA(b, h) + aoff + m * 2048 + k * 1024); } while (0)
#define PG8_LDB(dst, b, h) do { _Pragma("unroll") for (int n = 0; n < 2; ++n) _Pragma("unroll") for (int k = 0; k < 2; ++k) dst[n][k] = *(const PG8_LAS bf16x8*)(lds + PG8_SB(b, h) + boff + n * 2048 + k * 1024); } while (0)
#define PG8_MMA(ai, bj, At, Bt) do { __builtin_amdgcn_s_setprio(1); _Pragma("unroll") for (int m = 0; m < 4; ++m) _Pragma("unroll") for (int n = 0; n < 2; ++n) _Pragma("unroll") for (int k = 0; k < 2; ++k) \
        acc[ai][bj][m][n] = __builtin_amdgcn_mfma_f32_16x16x32_bf16(Bt[n][k], At[m][k], acc[ai][bj][m][n], 0, 0, 0); __builtin_amdgcn_s_setprio(0); } while (0)
#define PG8_WAIT_V(n) asm volatile("s_waitcnt vmcnt(" #n ")" ::: "memory")
#define PG8_WAIT_L(n) asm volatile("s_waitcnt lgkmcnt(" #n ")" ::: "memory")
#define PG8_BAR __builtin_amdgcn_s_barrier()
#define PG8_SCHED __builtin_amdgcn_sched_barrier(0)
    Unit cur, nxt; int ui = 0;
    if (!S.next(0, cur)) return;
    f32x4 acc[2][2][4][2];
#pragma unroll
    for (int a = 0; a < 2; ++a)
#pragma unroll
        for (int b = 0; b < 2; ++b)
#pragma unroll
            for (int m = 0; m < 4; ++m)
#pragma unroll
                for (int n = 0; n < 2; ++n) acc[a][b][m][n] = (f32x4){0.f, 0.f, 0.f, 0.f};
    bf16x8 At[4][2], B0[2][2], B1[2][2];
    const char* cA = (const char*)g.A + (size_t)cur.pm * tstep; const char* cB = (const char*)g.Bt + (size_t)cur.pn * tstep;
    if constexpr (SP2) {
        PG8_STAGE(PG8_SB(0, 0), cB, voffB); PG8_STAGE(PG8_SB(0, 1), cB + hstep, voffB); PG8_STAGE(PG8_SA(0, 0), cA, voffA); PG8_STAGE(PG8_SA(0, 1), cA + hstep, voffA);
        if (wr == 1) PG8_BAR;
        PG8_WAIT_V(2); PG8_BAR;
        PG8_STAGE(PG8_SB(1, 0), cB + kstep, voffB); PG8_STAGE(PG8_SA(1, 0), cA + kstep, voffA); PG8_STAGE(PG8_SB(1, 1), cB + hstep + kstep, voffB);
        PG8_WAIT_V(6); PG8_BAR;
    } else {
        PG8_STAGE(PG8_SB(0, 0), cB, voffB); PG8_STAGE(PG8_SA(0, 0), cA, voffA); PG8_STAGE(PG8_SB(0, 1), cB + hstep, voffB); PG8_STAGE(PG8_SA(0, 1), cA + hstep, voffA);
        if (wr == 1) PG8_BAR;
        PG8_WAIT_V(4); PG8_BAR;
        PG8_STAGE(PG8_SB(1, 0), cB + kstep, voffB); PG8_STAGE(PG8_SA(1, 0), cA + kstep, voffA); PG8_STAGE(PG8_SB(1, 1), cB + hstep + kstep, voffB);
        PG8_WAIT_V(6); PG8_BAR;
    }
    for (;;) {
        const bool has_next = S.next(ui + 1, nxt);
        const char* nA = has_next ? (const char*)g.A + (size_t)nxt.pm * tstep : cA; const char* nB = has_next ? (const char*)g.Bt + (size_t)nxt.pn * tstep : cB;
        for (int t = 0; t < nt; t += 2) {
            const bool last = (t == nt - 2);
            const char* a1 = cA + (size_t)(t + 1) * kstep;
            const char* a2 = last ? nA : cA + (size_t)(t + 2) * kstep; const char* b2 = last ? nB : cB + (size_t)(t + 2) * kstep;
            const char* a3 = a2 + kstep; const char* b3 = b2 + kstep;
            if constexpr (SP2) {
            PG8_LDB(B0, 0, 0); PG8_LDB(B1, 0, 1); PG8_SCHED; PG8_LDA(At, 0, 0); PG8_STAGE(PG8_SA(1, 1), a1 + hstep, voffA);
            PG8_WAIT_V(8); PG8_WAIT_L(0); PG8_BAR; PG8_MMA(0, 0, At, B0); PG8_MMA(0, 1, At, B1); PG8_BAR; PG8_SCHED;
            PG8_LDA(At, 0, 1); PG8_STAGE(PG8_SB(0, 0), b2, voffB); PG8_STAGE(PG8_SB(0, 1), b2 + hstep, voffB); PG8_STAGE(PG8_SA(0, 0), a2, voffA);
            PG8_WAIT_V(8); PG8_WAIT_L(0); PG8_BAR; PG8_MMA(1, 0, At, B0); PG8_MMA(1, 1, At, B1); PG8_BAR; PG8_SCHED;
            PG8_LDB(B0, 1, 0); PG8_LDB(B1, 1, 1); PG8_SCHED; PG8_LDA(At, 1, 0); PG8_STAGE(PG8_SA(0, 1), a2 + hstep, voffA);
            PG8_WAIT_V(8); PG8_WAIT_L(0); PG8_BAR; PG8_MMA(0, 0, At, B0); PG8_MMA(0, 1, At, B1); PG8_BAR; PG8_SCHED;
            PG8_LDA(At, 1, 1); PG8_STAGE(PG8_SB(1, 0), b3, voffB); PG8_STAGE(PG8_SB(1, 1), b3 + hstep, voffB); PG8_STAGE(PG8_SA(1, 0), a3, voffA);
            PG8_WAIT_V(8); PG8_WAIT_L(0); PG8_BAR; PG8_MMA(1, 0, At, B0); PG8_MMA(1, 1, At, B1); PG8_BAR; PG8_SCHED;
            } else {
            PG8_LDB(B0, 0, 0); PG8_SCHED; PG8_LDA(At, 0, 0); PG8_STAGE(PG8_SA(1, 1), a1 + hstep, voffA);
            PG8_WAIT_L(8); PG8_BAR; PG8_WAIT_L(0); PG8_MMA(0, 0, At, B0); PG8_BAR; PG8_SCHED;
            PG8_LDB(B1, 0, 1); PG8_STAGE(PG8_SB(0, 0), b2, voffB);
            PG8_BAR; PG8_WAIT_L(0); PG8_MMA(0, 1, At, B1); PG8_BAR;
            PG8_LDA(At, 0, 1); PG8_STAGE(PG8_SA(0, 0), a2, voffA);
            PG8_BAR; PG8_WAIT_L(0); PG8_MMA(1, 0, At, B0); PG8_BAR; PG8_SCHED;
            PG8_STAGE(PG8_SB(0, 1), b2 + hstep, voffB);
            PG8_WAIT_V(6); PG8_BAR; PG8_MMA(1, 1, At, B1); PG8_BAR;
            PG8_LDB(B0, 1, 0); PG8_SCHED; PG8_LDA(At, 1, 0); PG8_STAGE(PG8_SA(0, 1), a2 + hstep, voffA);
            PG8_WAIT_L(8); PG8_BAR; PG8_WAIT_L(0); PG8_MMA(0, 0, At, B0); PG8_BAR; PG8_SCHED;
            PG8_LDB(B1, 1, 1); PG8_STAGE(PG8_SB(1, 0), b3, voffB);
            PG8_BAR; PG8_WAIT_L(0); PG8_MMA(0, 1, At, B1); PG8_BAR;
            PG8_LDA(At, 1, 1); PG8_STAGE(PG8_SA(1, 0), a3, voffA);
            PG8_BAR; PG8_WAIT_L(0); PG8_MMA(1, 0, At, B0); PG8_BAR; PG8_SCHED;
            PG8_STAGE(PG8_SB(1, 1), b3 + hstep, voffB);
            PG8_WAIT_V(6); PG8_BAR; PG8_MMA(1, 1, At, B1); PG8_BAR;
            }
        }
        if constexpr (ALIGN_EPI) { if (wr == 0) PG8_BAR; }
        E(acc, cur, wr, wc, fr, fq);
        if (!has_next) break;
#pragma unroll
        for (int a = 0; a < 2; ++a)
#pragma unroll
            for (int b = 0; b < 2; ++b)
#pragma unroll
                for (int m = 0; m < 4; ++m)
#pragma unroll
                    for (int n = 0; n < 2; ++n) acc[a][b][m][n] = (f32x4){0.f, 0.f, 0.f, 0.f};
        cur = nxt; cA = nA; cB = nB; ++ui;
        if constexpr (ALIGN_EPI) { if (wr == 1) PG8_BAR; }
    }
    PG8_WAIT_V(0);
    if constexpr (!ALIGN_EPI) { if (wr == 0) PG8_BAR; }
    PG8_BAR;
#undef PG8_SA
#undef PG8_SB
#undef PG8_STAGE
#undef PG8_LDA
#undef PG8_LDB
#undef PG8_MMA
#undef PG8_WAIT_V
#undef PG8_WAIT_L
#undef PG8_BAR
#undef PG8_SCHED
}
}

constexpr int D_MODEL = 1024, BATCH = 2, SEQ = 16384, M = BATCH * SEQ, NPROJ = 4096, AW = 512, NHEAD = 8;
constexpr int NWAVES = 8;
constexpr size_t MiB = 1u << 20;
constexpr size_t WS_CTL = 0, CTL_ZERO_BYTES = 1 * MiB;
constexpr size_t WS_TBG = 1 * MiB;
constexpr size_t WS_WIN = 2 * MiB;
constexpr size_t WS_WOUT = 10 * MiB;
constexpr size_t WS_LP4 = 12 * MiB, WS_LP16 = 13 * MiB;
constexpr size_t WS_XN = 16 * MiB;
constexpr size_t WS_T = 80 * MiB, WS_G = 112 * MiB, WS_Q = 144 * MiB, WS_K = 176 * MiB, WS_V = 208 * MiB, WS_ZG = 240 * MiB;
constexpr size_t WS_OP4 = 272 * MiB, WS_OP16 = 304 * MiB;
constexpr size_t WS_Y = 336 * MiB;
constexpr size_t WS_END = 400 * MiB;
constexpr int CW_BAR = 4096;

constexpr int RING_OFF = 0, RING_BYTES = 131072;
constexpr int LDSCTL_OFF = 146432, MISC_OFF = LDSCTL_OFF + 320;
constexpr int LDS_BYTES = 147456;

#define GAS __attribute__((address_space(1)))
#define LAS __attribute__((address_space(3)))
typedef unsigned short bf16;
typedef unsigned v4u __attribute__((ext_vector_type(4)));
typedef float f32x4 __attribute__((ext_vector_type(4)));
typedef float f32x16 __attribute__((ext_vector_type(16)));
typedef short bf16x8 __attribute__((ext_vector_type(8)));
typedef short s16x4 __attribute__((ext_vector_type(4)));
typedef GAS unsigned gu32;
#define RLX_AGENT __ATOMIC_RELAXED, __HIP_MEMORY_SCOPE_AGENT
#define LDS_WAIT() asm volatile("s_waitcnt lgkmcnt(0)" ::: "memory")
__device__ __forceinline__ unsigned f2bf(float f) { unsigned u = __builtin_bit_cast(unsigned, f); return (u + 0x7fffu + ((u >> 16) & 1u)) >> 16; }
__device__ __forceinline__ unsigned pk2(float lo, float hi) { return f2bf(lo) | (f2bf(hi) << 16); }
__device__ __forceinline__ float bf2f(unsigned short b) { return __builtin_bit_cast(float, (unsigned)b << 16); }
__device__ __forceinline__ float bflo(unsigned w) { return __builtin_bit_cast(float, w << 16); }
__device__ __forceinline__ float bfhi(unsigned w) { return __builtin_bit_cast(float, w & 0xffff0000u); }

#define XB_TMO      128
#define XB_XCNT(j)  (256  + 64 * (j))
#define XB_XSUB(j)  (1280 + 64 * (j))
#define XB_XGEN(j)  (2304 + 64 * (j))
#define XB_TOP      3328
#define XB_TOPGEN   3392
#define XCD_BAR_WORDS 3456
#define XB_SPIN_CAP (1u << 18)
__device__ __forceinline__ unsigned xb_ld(unsigned* p)              { return __hip_atomic_load(p, __ATOMIC_RELAXED, __HIP_MEMORY_SCOPE_AGENT); }
__device__ __forceinline__ unsigned xb_add(unsigned* p, unsigned v) { return __hip_atomic_fetch_add(p, v, __ATOMIC_RELAXED, __HIP_MEMORY_SCOPE_AGENT); }
__device__ __forceinline__ unsigned xb_xcc_id() { return (unsigned)__builtin_amdgcn_s_getreg((3 << 11) | 20) & 0xFu; }
#define XB_SPIN(cond, bar) do { unsigned _sp = 0; while (cond) { __builtin_amdgcn_s_sleep(1); \
    if ((++_sp & 255u) == 0u) { if (xb_ld(&(bar)[XB_TMO])) break; if (_sp > XB_SPIN_CAP) { atomicAdd(&(bar)[XB_TMO], 1u); break; } } } } while (0)
struct XcdBarrier { unsigned* bar; unsigned x; volatile LAS unsigned* st; };
__device__ __forceinline__ XcdBarrier xcd_barrier_post(unsigned* bar, volatile LAS unsigned* st) {
    XcdBarrier b; b.bar = bar; b.x = xb_xcc_id(); b.st = st;
    if (threadIdx.x == 0) (void)xb_add(&bar[XB_XCNT(b.x)], 1u);
    return b;
}
__device__ __forceinline__ void xcd_barrier_complete(unsigned* bar, unsigned x, unsigned& nloc, unsigned& nx) {
    const unsigned G = gridDim.x * gridDim.y * gridDim.z;
    unsigned sum, cnt, mine, sp = 0u;
    for (;;) {
        sum = 0u; cnt = 0u; mine = 0u;
#pragma unroll
        for (unsigned j = 0; j < 16; ++j) { const unsigned c = xb_ld(&bar[XB_XCNT(j)]); sum += c; cnt += (c > 0u) ? 1u : 0u; mine = (j == x) ? c : mine; }
        if (sum == G) break;
        __builtin_amdgcn_s_sleep(1);
        if ((++sp & 255u) == 0u) { if (xb_ld(&bar[XB_TMO])) break; if (sp > XB_SPIN_CAP) { atomicAdd(&bar[XB_TMO], 1u); break; } }
    }
    nloc = mine > 0u ? mine : 1u; nx = cnt > 0u ? cnt : 1u;
}
__device__ __forceinline__ void xcd_barrier(const XcdBarrier& b) {
    asm volatile("s_waitcnt vmcnt(0)" ::: "memory");
    __syncthreads();
    if (threadIdx.x == 0) {
        unsigned* bar = b.bar;
        __builtin_amdgcn_s_waitcnt(0);
        unsigned nloc = b.st[0], nx = b.st[1];
        if (nloc == 0u) { xcd_barrier_complete(bar, b.x, nloc, nx); b.st[0] = nloc; b.st[1] = nx; }
        const unsigned old = xb_add(&bar[XB_XSUB(b.x)], 1u);
        const unsigned gen = old / nloc;
        if (old + 1u == (gen + 1u) * nloc) {
            __builtin_amdgcn_fence(__ATOMIC_RELEASE, "agent");
            asm volatile("s_waitcnt vmcnt(0)" ::: "memory");
            const unsigned og = xb_add(&bar[XB_TOP], 1u);
            const unsigned tg = og / nx;
            if (og + 1u == (tg + 1u) * nx) xb_add(&bar[XB_TOPGEN], 1u);
            else XB_SPIN(xb_ld(&bar[XB_TOPGEN]) == tg, bar);
            __builtin_amdgcn_fence(__ATOMIC_ACQUIRE, "agent");
            xb_add(&bar[XB_XGEN(b.x)], 1u);
            asm volatile("s_waitcnt vmcnt(0)" ::: "memory");
        } else {
            XB_SPIN(xb_ld(&bar[XB_XGEN(b.x)]) == gen, bar);
            __builtin_amdgcn_fence(__ATOMIC_ACQUIRE, "agent");
            asm volatile("s_waitcnt vmcnt(0)" ::: "memory");
        }
    }
    __syncthreads();
}

struct Frame {
    LAS unsigned char* lds;
    volatile LAS unsigned* MISC;
    gu32* ctl;
    int tid, lane, wave, vcu, G;
    const float *x, *norm_w, *w_in, *conv_w, *conv_b, *qw, *kw, *rel_bias, *w_out; float* out;
    bf16 *WinT, *WoutT, *XN, *T, *Gt, *Q, *K, *V, *ZG, *OP4, *OP16, *Y;
    float *TBG, *LP4, *LP16;
};
__device__ __forceinline__ float wave_sum(float v) {
#pragma unroll
    for (int o = 1; o < 64; o <<= 1) v += __shfl_xor(v, o);
    return v;
}
__device__ __forceinline__ float wave_max(float v) {
#pragma unroll
    for (int o = 1; o < 64; o <<= 1) v = fmaxf(v, __shfl_xor(v, o));
    return v;
}
__device__ __forceinline__ int win_row(int L) {
    int pn, wc, bj, n, fq, reg;
    if (L < 2048) { const int which = L >> 9, ch = L & 511; pn = ch >> 6; wc = (ch >> 4) & 3; fq = (ch >> 2) & 3; reg = ch & 3; bj = which >> 1; n = which & 1; }
    else { const int Lp = L - 2048, grp = Lp >> 9, head = (Lp >> 6) & 7, e = Lp & 63; pn = 8 + 2 * grp + (head >> 2); wc = head & 3; bj = e >> 5; fq = (e >> 3) & 3; n = (e >> 2) & 1; reg = e & 3; }
    return pn * 256 + 128 * bj + 32 * wc + 16 * n + 4 * fq + reg;
}
template <bool PERMUTE>
__device__ __forceinline__ void p0_transpose_item(const float* W, int K, int N, bf16* WT, LAS float* scr, int item, int lane) {
    const int nblk = N / 32, kb = item / nblk, nb = item % nblk, k0 = 64 * kb, n0 = 32 * nb;
#pragma unroll 8
    for (int i = 0; i < 32; ++i) { const int kk = 2 * i + (lane >> 5); scr[kk * 33 + (lane & 31)] = W[(size_t)(k0 + kk) * N + n0 + (lane & 31)]; }
    LDS_WAIT(); asm volatile("" ::: "memory");
    const int c = lane & 7;
#pragma unroll
    for (int j = 0; j < 4; ++j) { const int n = (lane >> 3) + 8 * j; const LAS float* s = scr + (8 * c) * 33 + n;
        v4u o; o.x = pk2(s[0 * 33], s[1 * 33]); o.y = pk2(s[2 * 33], s[3 * 33]); o.z = pk2(s[4 * 33], s[5 * 33]); o.w = pk2(s[6 * 33], s[7 * 33]);
        const int dr = PERMUTE ? win_row(n0 + n) : (n0 + n);
        *(GAS v4u*)(WT + (size_t)dr * K + k0 + 8 * c) = o; }
    LDS_WAIT(); asm volatile("" ::: "memory");
}
__device__ __forceinline__ int t5_bucket(int rel) {
    const int n = rel < 0 ? -rel : rel; int b = rel > 0 ? 16 : 0;
    if (n < 8) return b + n;
    int large = 8 + (int)(logf((float)n / 8.f) / logf(128.f) * 8.f);
    if (large > 15) large = 15;
    return b + large;
}
__device__ __forceinline__ void p0_prologue(Frame& F) {
    LAS float* scr = (LAS float*)(F.lds + RING_OFF + F.wave * 16384);
    const int gw = F.vcu * NWAVES + F.wave, NGW = F.G * NWAVES;
    constexpr int I_IN = (D_MODEL / 64) * (NPROJ / 32), I_OUT = (D_MODEL / 64) * (D_MODEL / 32);
    for (int it = gw; it < I_IN + I_OUT; it += NGW) {
        if (it < I_IN) p0_transpose_item<true>(F.w_in, D_MODEL, NPROJ, F.WinT, scr, it, F.lane);
        else p0_transpose_item<false>(F.w_out, D_MODEL, D_MODEL, F.WoutT, scr, it - I_IN, F.lane);
    }
    f32x4 nw[4];
#pragma unroll
    for (int j = 0; j < 4; ++j) nw[j] = ((const f32x4*)F.norm_w)[F.lane + 64 * j];
    for (int m = gw; m < M; m += NGW) {
        const GAS f32x4* xr = (const GAS f32x4*)(F.x + (size_t)m * D_MODEL) + F.lane;
        f32x4 v[4]; float s = 0.f;
#pragma unroll
        for (int j = 0; j < 4; ++j) { v[j] = xr[64 * j]; s += (v[j].x * v[j].x + v[j].y * v[j].y) + (v[j].z * v[j].z + v[j].w * v[j].w); }
        const float rstd = 1.f / sqrtf(wave_sum(s) * (1.f / D_MODEL) + 1e-6f);
        GAS unsigned long long* o8 = (GAS unsigned long long*)(F.XN + (size_t)m * D_MODEL) + F.lane;
#pragma unroll
        for (int j = 0; j < 4; ++j) { const f32x4 y = v[j] * rstd * nw[j]; o8[64 * j] = (unsigned long long)pk2(y.x, y.y) | ((unsigned long long)pk2(y.z, y.w) << 32); }
    }
    if (blockIdx.x == 0) {
        const float mq = wave_max(fabsf(F.qw[F.lane])), mk = wave_max(fabsf(F.kw[F.lane]));
        float mb = 0.f;
#pragma unroll
        for (int j = 0; j < 4; ++j) mb = fmaxf(mb, fabsf(F.rel_bias[F.lane + 64 * j]));
        mb = wave_max(mb);
        const float M2 = (8.f * mq * mk + mb) * 1.4426950408889634f;
        for (int i = F.tid; i < 3 * 8 * 192; i += NWAVES * 64) {
            const int jp = i % 192, h = (i / 192) & 7, c = i / (192 * 8), j = jp - 32;
            const int dil = c == 0 ? 1 : (c == 1 ? 4 : 16);
            float v = -1e30f;
            if (j >= 0 && j <= 128) v = F.rel_bias[t5_bucket((j - 64) * dil) * 8 + h] * 1.4426950408889634f - M2;
            F.TBG[i] = v;
        }
    }
}

__device__ __forceinline__ int crow(int r, int hi) { return (r & 3) + 8 * (r >> 2) + 4 * hi; }
__device__ __forceinline__ unsigned cvtpk_s(float lo, float hi) { typedef float f2 __attribute__((ext_vector_type(2))); typedef __bf16 b2 __attribute__((ext_vector_type(2))); f2 v = {lo, hi}; b2 b = __builtin_convertvector(v, b2); return __builtin_bit_cast(unsigned, b); }
typedef short v4i16_t __attribute__((ext_vector_type(4)));
__device__ __forceinline__ s16x4 vtr(LAS const unsigned char* p) { return __builtin_bit_cast(s16x4, __builtin_amdgcn_ds_read_tr16_b64_v4i16((LAS v4i16_t*)p)); }

constexpr int AT_TILE = 8448, AT_KCH = 528, AT_VOFF = 4224, AT_VPC = 1056, AT_NT = 12;
constexpr int AT_OST = AT_NT * AT_TILE;
constexpr int AT_TBL = AT_OST + NWAVES * 4096;
constexpr int AT_LW = AT_TBL + 768;
static_assert(AT_LW + NWAVES * 128 <= LDSCTL_OFF, "attention LDS map");
struct TaskD { int dil, L, i0, hq, c, h, tok0; };
template <bool FINAL>
__device__ __forceinline__ TaskD task_decode(int t) {
    TaskD D;
    if (FINAL) { D.c = 0; D.dil = 1; D.L = SEQ; D.i0 = (t & 511) * 32; D.h = (t >> 9) & 7; D.tok0 = (t >> 12) * SEQ; }
    else { const int c = 1 + (t >> 13), u = t & 8191; D.c = c; D.h = (u >> 9) & 7; const int b = u >> 12; int sb, r;
        if (c == 1) { sb = u & 127; r = (u >> 7) & 3; D.dil = 4; D.L = SEQ / 4; } else { sb = u & 31; r = (u >> 5) & 15; D.dil = 16; D.L = SEQ / 16; }
        D.i0 = sb * 32; D.tok0 = b * SEQ + r; }
    D.hq = D.h * 64;
    return D;
}
#define AT_BAR() do { asm volatile("s_waitcnt lgkmcnt(0)" ::: "memory"); __builtin_amdgcn_s_barrier(); asm volatile("" ::: "memory"); } while (0)
template <bool FINAL>
__device__ __forceinline__ void attn_units(Frame& F, int u0, int u1) {
    if (u0 >= u1) return;
    const int lane = F.lane, w = F.wave, r32 = lane & 31, hi = lane >> 5;
    LAS unsigned char* L0 = F.lds;
    LAS unsigned short* stgb = (LAS unsigned short*)(F.lds + AT_OST + w * 4096);
    LAS float* tbl = (LAS float*)(F.lds + AT_TBL);
    LAS float* lw = (LAS float*)(F.lds + AT_LW) + w * 32;
    const int vaddr = AT_VOFF + ((lane >> 4) & 1) * 32 + (lane & 3) * 8 + (4 * hi + ((lane & 15) >> 2)) * 64;
    const bool isV = w >= 4; const int srow = 8 * (w & 3) + (lane >> 3), sch = lane & 7;
    const int sdst = isV ? (AT_VOFF + (sch >> 2) * (2 * AT_VPC) + (srow >> 4) * AT_VPC + (srow & 15) * 64 + (sch & 3) * 16) : (sch * AT_KCH + srow * 16);
    const bf16* ssrc = isV ? F.V : F.K;
    bf16x8 st[AT_NT], qn[4], qr[4];
#define STAGE_LOAD(D_) do { _Pragma("unroll") for (int t_ = 0; t_ < AT_NT; ++t_) { int key_ = (D_).i0 - 64 + 32 * t_ + srow; key_ = key_ < 0 ? 0 : (key_ > (D_).L - 1 ? (D_).L - 1 : key_); \
        st[t_] = *(const bf16x8*)(ssrc + (unsigned)(((D_).tok0 + (D_).dil * key_) * AW + (D_).hq + sch * 8)); } } while (0)
#define LOADQN(D_) do { const unsigned qo_ = (unsigned)(((D_).tok0 + (D_).dil * ((D_).i0 + 32 * w + r32)) * AW + (D_).hq + hi * 8); \
        _Pragma("unroll") for (int d0 = 0; d0 < 4; ++d0) qn[d0] = *(const bf16x8*)(F.Q + qo_ + d0 * 16); } while (0)
#define CHUNK(kc) do { const LAS unsigned char* tb_ = L0 + (w + (kc)) * AT_TILE; const int k0_ = i0w - 64 + 32 * (kc); \
        f32x16 a_; { const LAS float* tp_ = tbl + (32 + 32 * (kc) + 4 * hi - r32); \
            _Pragma("unroll") for (int rr = 0; rr < 16; ++rr) a_[rr] = tp_[(rr & 3) + 8 * (rr >> 2)]; } \
        if (k0_ < 0 || k0_ + 32 > D.L) { _Pragma("unroll") for (int rr = 0; rr < 16; ++rr) { const int key_ = k0_ + crow(rr, hi); if (key_ < 0 || key_ >= D.L) a_[rr] = -1e30f; } } \
        _Pragma("unroll") for (int d0 = 0; d0 < 4; ++d0) { const bf16x8 kf_ = *(const LAS bf16x8*)(tb_ + (2 * d0 + hi) * AT_KCH + r32 * 16); \
            a_ = __builtin_amdgcn_mfma_f32_32x32x16_bf16(kf_, qr[d0], a_, 0, 0, 0); } \
        _Pragma("unroll") for (int rr = 0; rr < 16; ++rr) { a_[rr] = __builtin_amdgcn_exp2f(a_[rr]); lsum += a_[rr]; } \
        v4u pw0_, pw1_; pw0_.x = cvtpk_s(a_[0], a_[1]); pw0_.y = cvtpk_s(a_[2], a_[3]); pw0_.z = cvtpk_s(a_[4], a_[5]); pw0_.w = cvtpk_s(a_[6], a_[7]); \
        pw1_.x = cvtpk_s(a_[8], a_[9]); pw1_.y = cvtpk_s(a_[10], a_[11]); pw1_.z = cvtpk_s(a_[12], a_[13]); pw1_.w = cvtpk_s(a_[14], a_[15]); \
        const LAS unsigned char* vb_ = tb_ + vaddr; \
        { s16x4 l0 = vtr(vb_), h0 = vtr(vb_ + 512), l1 = vtr(vb_ + AT_VPC), h1 = vtr(vb_ + AT_VPC + 512); \
          o0 = __builtin_amdgcn_mfma_f32_32x32x16_bf16(__builtin_bit_cast(bf16x8, pw0_), (bf16x8){l0[0], l0[1], l0[2], l0[3], h0[0], h0[1], h0[2], h0[3]}, o0, 0, 0, 0); \
          o0 = __builtin_amdgcn_mfma_f32_32x32x16_bf16(__builtin_bit_cast(bf16x8, pw1_), (bf16x8){l1[0], l1[1], l1[2], l1[3], h1[0], h1[1], h1[2], h1[3]}, o0, 0, 0, 0); } \
        { s16x4 l2 = vtr(vb_ + 2 * AT_VPC), h2 = vtr(vb_ + 2 * AT_VPC + 512), l3 = vtr(vb_ + 3 * AT_VPC), h3 = vtr(vb_ + 3 * AT_VPC + 512); \
          o1 = __builtin_amdgcn_mfma_f32_32x32x16_bf16(__builtin_bit_cast(bf16x8, pw0_), (bf16x8){l2[0], l2[1], l2[2], l2[3], h2[0], h2[1], h2[2], h2[3]}, o1, 0, 0, 0); \
          o1 = __builtin_amdgcn_mfma_f32_32x32x16_bf16(__builtin_bit_cast(bf16x8, pw1_), (bf16x8){l3[0], l3[1], l3[2], l3[3], h3[0], h3[1], h3[2], h3[3]}, o1, 0, 0, 0); } } while (0)
    TaskD D = task_decode<FINAL>(8 * u0);
    STAGE_LOAD(D); LOADQN(D);
    int tb_ch = -1;
    for (int u = u0; u < u1; ++u) {
        const TaskD Dn = task_decode<FINAL>(8 * (u + 1 < u1 ? u + 1 : u));
        AT_BAR();
#pragma unroll
        for (int t_ = 0; t_ < AT_NT; ++t_) *(LAS bf16x8*)(L0 + t_ * AT_TILE + sdst) = st[t_];
        if (tb_ch != D.c * 8 + D.h) { tb_ch = D.c * 8 + D.h; if (F.tid < 192) tbl[F.tid] = F.TBG[tb_ch * 192 + F.tid]; }
#pragma unroll
        for (int d0 = 0; d0 < 4; ++d0) qr[d0] = qn[d0];
        AT_BAR();
        STAGE_LOAD(Dn); LOADQN(Dn);
        const int i0w = D.i0 + 32 * w;
        v4u p4[4], p16[4], zg[4]; float l4[4], l16[4];
#define FIN_LOAD(i) do { const int row = (i) * 8 + (lane >> 3), ch = lane & 7; const unsigned tok = (unsigned)(D.tok0 + i0w + row); const unsigned eo = tok * AW + D.hq + ch * 8; \
            p4[i] = *(const v4u*)(F.OP4 + eo); p16[i] = *(const v4u*)(F.OP16 + eo); zg[i] = *(const v4u*)(F.ZG + eo); l4[i] = F.LP4[tok * 8 + D.h]; l16[i] = F.LP16[tok * 8 + D.h]; } while (0)
        if (FINAL) { FIN_LOAD(0); }
        f32x16 o0 = {}, o1 = {}; float lsum = 0.f;
        CHUNK(0); CHUNK(1); CHUNK(2); CHUNK(3); CHUNK(4);
        lsum += __shfl_xor(lsum, 32);
#pragma unroll
        for (int rr = 0; rr < 16; rr += 2) {
            const unsigned a01 = cvtpk_s(o0[rr], o0[rr + 1]), b01 = cvtpk_s(o1[rr], o1[rr + 1]);
            const int q0 = crow(rr, hi), q1 = crow(rr + 1, hi);
            stgb[q0 * 64 + r32] = (unsigned short)(a01 & 0xffffu); stgb[q1 * 64 + r32] = (unsigned short)(a01 >> 16);
            stgb[q0 * 64 + 32 + r32] = (unsigned short)(b01 & 0xffffu); stgb[q1 * 64 + 32 + r32] = (unsigned short)(b01 >> 16);
        }
        if (FINAL) { if (hi == 0) lw[r32] = lsum; FIN_LOAD(1); FIN_LOAD(2); FIN_LOAD(3); }
        else { if (hi == 0) { float* lp = F.LP4 + (size_t)(D.c - 1) * (size_t)(256u << 10) + (unsigned)((D.tok0 + D.dil * (i0w + r32)) * 8 + D.h); *lp = lsum; } }
#pragma unroll
        for (int i = 0; i < 4; ++i) {
            const int row = i * 8 + (lane >> 3), ch = lane & 7;
            const unsigned tok = (unsigned)(D.tok0 + D.dil * (i0w + row));
            const v4u ov = *(const LAS v4u*)(stgb + row * 64 + ch * 8);
            if (!FINAL) {
                *(v4u*)(F.OP4 + (size_t)(D.c - 1) * (size_t)(16u << 20) + (tok * AW + D.hq + ch * 8)) = ov;
            } else {
                const float inv = 1.f / (lw[row] + l4[i] + l16[i]);
                float y[8];
                y[0] = (bflo(ov.x) + bflo(p4[i].x) + bflo(p16[i].x)) * inv * bflo(zg[i].x); y[1] = (bfhi(ov.x) + bfhi(p4[i].x) + bfhi(p16[i].x)) * inv * bfhi(zg[i].x);
                y[2] = (bflo(ov.y) + bflo(p4[i].y) + bflo(p16[i].y)) * inv * bflo(zg[i].y); y[3] = (bfhi(ov.y) + bfhi(p4[i].y) + bfhi(p16[i].y)) * inv * bfhi(zg[i].y);
                y[4] = (bflo(ov.z) + bflo(p4[i].z) + bflo(p16[i].z)) * inv * bflo(zg[i].z); y[5] = (bfhi(ov.z) + bfhi(p4[i].z) + bfhi(p16[i].z)) * inv * bfhi(zg[i].z);
                y[6] = (bflo(ov.w) + bflo(p4[i].w) + bflo(p16[i].w)) * inv * bflo(zg[i].w); y[7] = (bfhi(ov.w) + bfhi(p4[i].w) + bfhi(p16[i].w)) * inv * bfhi(zg[i].w);
                v4u wv; wv.x = cvtpk_s(y[0], y[1]); wv.y = cvtpk_s(y[2], y[3]); wv.z = cvtpk_s(y[4], y[5]); wv.w = cvtpk_s(y[6], y[7]);
                *(v4u*)(F.Y + (tok * D_MODEL + 512 + D.hq + ch * 8)) = wv;
            }
        }
        D = Dn;
    }
    AT_BAR();
#undef STAGE_LOAD
#undef LOADQN
#undef CHUNK
#undef FIN_LOAD
}
template <int NB>
__device__ __forceinline__ void conv_batch(Frame& F, int s0, int lane, const float (&w0)[8], const float (&w1)[8], const float (&w2)[8], const float (&cb)[8]) {
    const v4u zero = {0u, 0u, 0u, 0u};
    v4u tr[NB + 2], g[NB];
#pragma unroll
    for (int j = 0; j < NB + 2; ++j) { const int s = s0 - 1 + j; const bool ok = (j == 0) ? (s0 % SEQ != 0) : ((j == NB + 1) ? ((s0 + NB) % SEQ != 0) : true);
        tr[j] = zero; if (ok) tr[j] = *(const v4u*)(F.T + (size_t)s * AW + 8 * lane); }
#pragma unroll
    for (int j = 0; j < NB; ++j) g[j] = *(const v4u*)(F.Gt + (size_t)(s0 + j) * AW + 8 * lane);
#pragma unroll
    for (int j = 0; j < NB; ++j) {
        const v4u tp = tr[j], tc = tr[j + 1], tn = tr[j + 2], gg = g[j];
        float y[8];
#define CV(i, P, C, N, GG, sel) y[i] = sel(GG) * (w0[i] * sel(P) + w1[i] * sel(C) + w2[i] * sel(N) + cb[i])
        CV(0, tp.x, tc.x, tn.x, gg.x, bflo); CV(1, tp.x, tc.x, tn.x, gg.x, bfhi); CV(2, tp.y, tc.y, tn.y, gg.y, bflo); CV(3, tp.y, tc.y, tn.y, gg.y, bfhi);
        CV(4, tp.z, tc.z, tn.z, gg.z, bflo); CV(5, tp.z, tc.z, tn.z, gg.z, bfhi); CV(6, tp.w, tc.w, tn.w, gg.w, bflo); CV(7, tp.w, tc.w, tn.w, gg.w, bfhi);
#undef CV
        v4u w; w.x = cvtpk_s(y[0], y[1]); w.y = cvtpk_s(y[2], y[3]); w.z = cvtpk_s(y[4], y[5]); w.w = cvtpk_s(y[6], y[7]);
        *(v4u*)(F.Y + (size_t)(s0 + j) * D_MODEL + 8 * lane) = w;
    }
}
__device__ __forceinline__ void conv_rows(Frame& F, int s0, int s1, int lane) {
    float w0[8], w1[8], w2[8], cb[8];
#pragma unroll
    for (int i = 0; i < 8; ++i) { w0[i] = F.conv_w[8 * lane + i]; w1[i] = F.conv_w[512 + 8 * lane + i]; w2[i] = F.conv_w[1024 + 8 * lane + i]; cb[i] = F.conv_b[8 * lane + i]; }
    int s = s0;
    for (; s + 8 <= s1; s += 8) conv_batch<8>(F, s, lane, w0, w1, w2, cb);
    for (; s < s1; ++s) conv_batch<1>(F, s, lane, w0, w1, w2, cb);
}
__device__ __forceinline__ void attn_pass_a(Frame& F) {
    constexpr int NU = 2048;
    const int per = (NU + F.G - 1) / F.G;
    const int u0 = F.vcu * per, u1 = (u0 + per < NU) ? u0 + per : NU;
    attn_units<false>(F, u0, u1);
    const int gw = F.vcu * NWAVES + F.wave, NGW = F.G * NWAVES;
    const int rper = (M + NGW - 1) / NGW;
    const int s0 = gw * rper, s1 = (s0 + rper < M) ? s0 + rper : M;
    if (s0 < M) conv_rows(F, s0, s1, F.lane);
}
__device__ __forceinline__ void attn_pass_b(Frame& F) {
    constexpr int NU = 1024;
    const int per = (NU + F.G - 1) / F.G;
    const int u0 = F.vcu * per, u1 = (u0 + per < NU) ? u0 + per : NU;
    attn_units<true>(F, u0, u1);
}

struct Args { const float* in[9]; float* out; unsigned char* ws; int ph_lo, ph_hi; };
__global__ void __launch_bounds__(NWAVES * 64, 2) mega(Args args) {
    extern __shared__ __attribute__((aligned(16))) unsigned char lds[];
    Frame F;
    F.lds = (LAS unsigned char*)lds;
    F.MISC = (volatile LAS unsigned*)(F.lds + MISC_OFF);
    F.tid = threadIdx.x; F.lane = F.tid & 63; F.wave = __builtin_amdgcn_readfirstlane(F.tid >> 6);
    F.G = gridDim.x; { const int bx = blockIdx.x; F.vcu = (F.G % 8 == 0) ? (bx % 8) * (F.G / 8) + bx / 8 : bx; }
    unsigned char* ws = args.ws;
    F.ctl = (gu32*)(ws + WS_CTL);
    F.x = args.in[0]; F.norm_w = args.in[1]; F.w_in = args.in[2]; F.conv_w = args.in[3]; F.conv_b = args.in[4]; F.qw = args.in[5]; F.kw = args.in[6]; F.rel_bias = args.in[7]; F.w_out = args.in[8];
    F.out = args.out;
    F.WinT = (bf16*)(ws + WS_WIN); F.WoutT = (bf16*)(ws + WS_WOUT); F.XN = (bf16*)(ws + WS_XN);
    F.T = (bf16*)(ws + WS_T); F.Gt = (bf16*)(ws + WS_G); F.Q = (bf16*)(ws + WS_Q); F.K = (bf16*)(ws + WS_K); F.V = (bf16*)(ws + WS_V); F.ZG = (bf16*)(ws + WS_ZG);
    F.OP4 = (bf16*)(ws + WS_OP4); F.OP16 = (bf16*)(ws + WS_OP16); F.Y = (bf16*)(ws + WS_Y);
    F.TBG = (float*)(ws + WS_TBG); F.LP4 = (float*)(ws + WS_LP4); F.LP16 = (float*)(ws + WS_LP16);
    for (int u = F.tid; u < (LDS_BYTES - LDSCTL_OFF) / 4; u += NWAVES * 64) ((LAS unsigned*)(F.lds + LDSCTL_OFF))[u] = 0u;
    __syncthreads();
    const int lo = args.ph_lo, hi = args.ph_hi;
    const bool multi = (hi - lo) > 1;
    XcdBarrier bar; bar.bar = (unsigned*)(F.ctl + CW_BAR); bar.x = 0; bar.st = nullptr;
    if (multi) bar = xcd_barrier_post((unsigned*)(F.ctl + CW_BAR), F.MISC + 8);
#define IN(k) (lo <= (k) && (k) < hi)
#define BOTH(k) (IN(k) && IN((k) + 1))
    if (IN(0)) { p0_prologue(F); if (BOTH(0)) xcd_barrier(bar); }
    if (IN(1)) {
        pg8::Gemm g{F.XN, F.WinT, M, NPROJ, D_MODEL}; pg8::StaticOrder S; S.init(M, NPROJ, F.G, (int)blockIdx.x);
        pg8::EpiProj E{F.T, F.Gt, F.Q, F.qw, F.kw};
        pg8::gemm_phase<pg8::EpiProj, pg8::StaticOrder, true, true>(F.lds + RING_OFF, g, S, E);
        if (BOTH(1)) xcd_barrier(bar);
    }
    if (IN(2)) { attn_pass_a(F); if (BOTH(2)) xcd_barrier(bar); }
    if (IN(3)) { attn_pass_b(F); if (BOTH(3)) xcd_barrier(bar); }
    if (IN(4)) {
        pg8::Gemm g{F.Y, F.WoutT, M, D_MODEL, D_MODEL}; pg8::StaticOrder S; S.init(M, D_MODEL, F.G, (int)blockIdx.x);
        pg8::EpiRes E{F.x, F.out, D_MODEL};
        pg8::gemm_phase<pg8::EpiRes, pg8::StaticOrder, true, true>(F.lds + RING_OFF, g, S, E);
    }
#undef IN
#undef BOTH
}

namespace naive {
__global__ void __launch_bounds__(256) k_conv(const bf16* T, const bf16* G, const float* conv_w, const float* conv_b, bf16* Y) {
    const int i = blockIdx.x * 256 + threadIdx.x;
    const int s = i >> 9, c = i & 511;
    if (s >= M) return;
    const float t1 = bf2f(T[(size_t)s * AW + c]);
    const float t0 = (s % SEQ == 0) ? 0.f : bf2f(T[(size_t)(s - 1) * AW + c]);
    const float t2 = (s % SEQ == SEQ - 1) ? 0.f : bf2f(T[(size_t)(s + 1) * AW + c]);
    const float z = conv_w[c] * t0 + conv_w[512 + c] * t1 + conv_w[1024 + c] * t2 + conv_b[c];
    Y[(size_t)s * D_MODEL + c] = (bf16)f2bf(bf2f(G[(size_t)s * AW + c]) * z);
}
__global__ void __launch_bounds__(64) k_attn(const bf16* Q, const bf16* K, const bf16* V, const bf16* ZG, const float* TBG, bf16* Y) {
    __shared__ float qs[64];
    __shared__ float ps[3 * 129];
    __shared__ int toks[3 * 129];
    const int lane = threadIdx.x, h = blockIdx.x & 7, tok = blockIdx.x >> 3, b = tok / SEQ, s = tok % SEQ;
    qs[lane] = bf2f(Q[(size_t)tok * AW + h * 64 + lane]);
    __syncthreads();
    for (int c = 0; c < 3; ++c) {
        const int d = c == 0 ? 1 : (c == 1 ? 4 : 16);
        for (int j = lane; j < 129; j += 64) {
            const int tk = s + (j - 64) * d;
            float lg = -1e30f; int tkv = -1;
            if (tk >= 0 && tk < SEQ) {
                const bf16* kr = K + ((size_t)b * SEQ + tk) * AW + h * 64;
                float dot = 0.f;
                for (int e = 0; e < 64; ++e) dot = fmaf(qs[e], bf2f(kr[e]), dot);
                lg = dot + TBG[(c * 8 + h) * 192 + 32 + j];
                tkv = b * SEQ + tk;
            }
            ps[c * 129 + j] = lg; toks[c * 129 + j] = tkv;
        }
    }
    __syncthreads();
    float lsum = 0.f;
    for (int j = lane; j < 387; j += 64) { const float p = toks[j] >= 0 ? exp2f(ps[j]) : 0.f; ps[j] = p; lsum += p; }
    lsum = wave_sum(lsum);
    __syncthreads();
    float o = 0.f;
    for (int j = 0; j < 387; ++j) { const int tk = toks[j]; if (tk >= 0) o = fmaf(ps[j], bf2f(V[(size_t)tk * AW + h * 64 + lane]), o); }
    Y[(size_t)tok * D_MODEL + 512 + h * 64 + lane] = (bf16)f2bf((o / lsum) * bf2f(ZG[(size_t)tok * AW + h * 64 + lane]));
}
__global__ void __launch_bounds__(256) k_gemm2(const bf16* A, const float* B, const float* X, float* C) {
    __shared__ float As[16][132];
    __shared__ float Bs[16][132];
    const int t = threadIdx.x, m0 = blockIdx.y * 128, n0 = blockIdx.x * 128;
    const int ar = t >> 1, ak = (t & 1) * 8, bk = t >> 4, bn = (t & 15) * 8, ty = t >> 4, tx = t & 15;
    float acc[8][8];
#pragma unroll
    for (int i = 0; i < 8; ++i)
#pragma unroll
        for (int j = 0; j < 8; ++j) acc[i][j] = 0.f;
    for (int k0 = 0; k0 < 1024; k0 += 16) {
        const v4u a = *(const v4u*)(A + (size_t)(m0 + ar) * 1024 + k0 + ak);
        const float av[8] = {bflo(a.x), bfhi(a.x), bflo(a.y), bfhi(a.y), bflo(a.z), bfhi(a.z), bflo(a.w), bfhi(a.w)};
        const float4 b0 = *(const float4*)(B + (size_t)(k0 + bk) * 1024 + n0 + bn);
        const float4 b1 = *(const float4*)(B + (size_t)(k0 + bk) * 1024 + n0 + bn + 4);
        __syncthreads();
#pragma unroll
        for (int i = 0; i < 8; ++i) As[ak + i][ar] = av[i];
        *(float4*)&Bs[bk][bn] = b0; *(float4*)&Bs[bk][bn + 4] = b1;
        __syncthreads();
#pragma unroll
        for (int k = 0; k < 16; ++k) {
            float a8[8], b8[8];
#pragma unroll
            for (int i = 0; i < 8; ++i) a8[i] = As[k][ty * 8 + i];
#pragma unroll
            for (int j = 0; j < 8; ++j) b8[j] = Bs[k][tx * 8 + j];
#pragma unroll
            for (int i = 0; i < 8; ++i)
#pragma unroll
                for (int j = 0; j < 8; ++j) acc[i][j] = fmaf(a8[i], b8[j], acc[i][j]);
        }
    }
#pragma unroll
    for (int i = 0; i < 8; ++i) { const size_t row = (size_t)(m0 + ty * 8 + i);
#pragma unroll
        for (int j = 0; j < 8; ++j) C[row * 1024 + n0 + tx * 8 + j] = acc[i][j] + X[row * 1024 + n0 + tx * 8 + j]; }
}
}

extern "C" void kernel_launch(void* const* d_in, const int* in_sizes, int n_in, void* d_out, int out_size, void* d_ws, size_t ws_size, hipStream_t stream) {
    static int grid = 0;
    if (grid == 0) {
        if (n_in != 9 || in_sizes[0] != M * D_MODEL || out_size != M * D_MODEL || ws_size < WS_END) { fprintf(stderr, "kernel_launch: unexpected shapes (n_in %d, in0 %d, out %d, ws %zu)\n", n_in, n_in > 0 ? in_sizes[0] : -1, out_size, ws_size); grid = -1; return; }
        int dev = 0, cus = 0, per_cu = 0;
        if (hipGetDevice(&dev) != hipSuccess || hipDeviceGetAttribute(&cus, hipDeviceAttributeMultiprocessorCount, dev) != hipSuccess) { grid = -1; return; }
        if (hipFuncSetAttribute((const void*)mega, hipFuncAttributeMaxDynamicSharedMemorySize, LDS_BYTES) != hipSuccess) { fprintf(stderr, "kernel_launch: hipFuncSetAttribute failed\n"); grid = -1; return; }
        if (hipOccupancyMaxActiveBlocksPerMultiprocessor(&per_cu, (const void*)mega, NWAVES * 64, LDS_BYTES) != hipSuccess || per_cu < 1) { fprintf(stderr, "kernel_launch: occupancy query says %d blocks per CU\n", per_cu); (void)hipGetLastError(); grid = -1; return; }
        grid = cus;
    }
    if (grid < 0) return;
    (void)hipMemsetAsync((char*)d_ws + WS_CTL, 0, CTL_ZERO_BYTES, stream);
    Args a{};
    for (int i = 0; i < 9; ++i) a.in[i] = (const float*)d_in[i];
    a.out = (float*)d_out; a.ws = (unsigned char*)d_ws;
    unsigned char* ws = (unsigned char*)d_ws;
#if STAGE == 4
    a.ph_lo = 0; a.ph_hi = 5;
    hipLaunchKernelGGL(mega, dim3(grid), dim3(NWAVES * 64), LDS_BYTES, stream, a);
#else
    const int nper = (STAGE == 3) ? 5 : 2;
    for (int p = 0; p < nper; ++p) { a.ph_lo = p; a.ph_hi = p + 1; hipLaunchKernelGGL(mega, dim3(grid), dim3(NWAVES * 64), LDS_BYTES, stream, a); }
#if STAGE <= 2
    naive::k_conv<<<M * 512 / 256, 256, 0, stream>>>((const bf16*)(ws + WS_T), (const bf16*)(ws + WS_G), (const float*)d_in[3], (const float*)d_in[4], (bf16*)(ws + WS_Y));
    naive::k_attn<<<M * 8, 64, 0, stream>>>((const bf16*)(ws + WS_Q), (const bf16*)(ws + WS_K), (const bf16*)(ws + WS_V), (const bf16*)(ws + WS_ZG), (const float*)(ws + WS_TBG), (bf16*)(ws + WS_Y));
#if STAGE == 1
    naive::k_gemm2<<<dim3(8, M / 128), 256, 0, stream>>>((const bf16*)(ws + WS_Y), (const float*)d_in[8], (const float*)d_in[0], (float*)d_out);
#else
    a.ph_lo = 4; a.ph_hi = 5; hipLaunchKernelGGL(mega, dim3(grid), dim3(NWAVES * 64), LDS_BYTES, stream, a);
#endif
#endif
#endif
}
```

```cpp
#include <hip/hip_runtime.h>
#include <cstdio>
#include <cstdint>

#ifndef PROBE_PHASE
#define PROBE_PHASE -1
#endif
#ifndef STAGE
#define STAGE 4
#endif

namespace pg8 {
#define PG8_LAS __attribute__((address_space(3)))
typedef unsigned short bf16_t;
typedef short bf16x8 __attribute__((ext_vector_type(8)));
typedef float f32x4 __attribute__((ext_vector_type(4)));
typedef unsigned u32x4 __attribute__((ext_vector_type(4)));
typedef unsigned u32x2 __attribute__((ext_vector_type(2)));
constexpr int BM = 256, BK = 64, HALF = 128, HTB = HALF * BK * 2, STAGE_BYTES = 8 * HTB, NXCD = 8, WGM = 8;

__host__ __device__ __forceinline__ int lds_byte(int r, int c) { const int st = (r >> 4) * 2 + (c >> 5), rr = r & 15, cc = c & 31, ob = rr * 64 + cc * 2; return st * 1024 + (ob ^ (((ob >> 9) & 1) << 5)); }
__host__ __device__ __forceinline__ void stage_rc(int b, int& R, int& C) { const int st = b / 1024, sb = b % 1024, swz = sb ^ (((sb >> 9) & 1) << 5); R = (st >> 1) * 16 + swz / 64; C = (st & 1) * 32 + (swz % 64) / 2; }

struct Unit { int pm, pn; };
struct Gemm { const bf16_t* A; const bf16_t* Bt; int M, N, K; };

struct StaticOrder {
    int nM, nN, nwg, G, c;
    __host__ __device__ void init(int M, int N, int G_, int c_) { nM = M / BM; nN = N / BM; nwg = nM * nN; G = G_; c = c_; }
    __host__ __device__ bool next(int i, Unit& u) const {
        const long L = (long)i * G + c; if (L >= nwg) return false;
        int wgid = (int)L; { const int q = nwg / NXCD, r = nwg % NXCD, xcd = wgid % NXCD, off = wgid / NXCD; wgid = (xcd < r ? xcd * (q + 1) : r * (q + 1) + (xcd - r) * q) + off; }
        const int nig = WGM * nN, gid = wgid / nig, fm = gid * WGM, gsz = (nM - fm) < WGM ? (nM - fm) : WGM;
        u.pm = fm + ((wgid % nig) % gsz); u.pn = (wgid % nig) / gsz; return true;
    }
};

__device__ __forceinline__ unsigned cvt_pk_bf16(float lo, float hi) { unsigned r; asm volatile("v_cvt_pk_bf16_f32 %0, %1, %2" : "=v"(r) : "v"(lo), "v"(hi)); return r; }
__device__ __forceinline__ float silu_f(float z) { return z * __builtin_amdgcn_rcpf(1.f + __builtin_amdgcn_exp2f(-1.4426950408889634f * z)); }

struct EpiProj {
    static constexpr bool PERM = false, AFTER_DRAIN = false;
    bf16_t *Y, *QKVZ; float *SBT, *SBG; PG8_LAS unsigned char* xl;
    __device__ __forceinline__ void operator()(const f32x4 (&acc)[2][2][4][2], const Unit& u, int wr, int wc, int fr, int fq) const {
        const int row0 = u.pm * BM + wr * 64 + fr;
        if (u.pn < 8) {
            const int lane = fr + 16 * fq, chl = 16 * wc + 4 * fq, ch0 = 64 * u.pn + chl;
            PG8_LAS float* X = (PG8_LAS float*)xl;
            const PG8_LAS float* CWl = (const PG8_LAS float*)(xl + 2048);
            f32x4 t[2][4], g[2][4];
#pragma unroll
            for (int ai = 0; ai < 2; ++ai)
#pragma unroll
                for (int m = 0; m < 4; ++m) {
                    const f32x4 uu = acc[ai][0][m][0], gb = acc[ai][0][m][1], gc = acc[ai][1][m][0], z = acc[ai][1][m][1];
                    t[ai][m] = gc * uu;
#pragma unroll
                    for (int i = 0; i < 4; ++i) g[ai][m][i] = gb[i] * silu_f(z[i]);
                }
#pragma unroll
            for (int ai = 0; ai < 2; ++ai) { const int grpi = 2 * ai + wr;
                if (fr == 0) *(PG8_LAS f32x4*)(X + (grpi * 2 + 0) * 64 + chl) = t[ai][0];
                if (fr == 15) *(PG8_LAS f32x4*)(X + (grpi * 2 + 1) * 64 + chl) = t[ai][3]; }
            if (wr == 0 && fr < 2) { *(f32x4*)(SBT + ((size_t)(u.pm * 4 + fr) * 512 + ch0)) = t[0][0]; if (fr == 0) *(f32x4*)(SBG + ((size_t)(u.pm * 2 + 0) * 512 + ch0)) = g[0][0]; }
            if (wr == 1 && fr >= 14) { *(f32x4*)(SBT + ((size_t)(u.pm * 4 + fr - 12) * 512 + ch0)) = t[1][3]; if (fr == 15) *(f32x4*)(SBG + ((size_t)(u.pm * 2 + 1) * 512 + ch0)) = g[1][3]; }
            asm volatile("s_waitcnt lgkmcnt(0)" ::: "memory"); __builtin_amdgcn_s_barrier(); asm volatile("" ::: "memory");
            const f32x4 w0 = *(const PG8_LAS f32x4*)(CWl + ch0), w1 = *(const PG8_LAS f32x4*)(CWl + 512 + ch0), w2 = *(const PG8_LAS f32x4*)(CWl + 1024 + ch0), cb = *(const PG8_LAS f32x4*)(CWl + 1536 + ch0);
            const int lprev = (lane & 48) | ((lane - 1) & 15), lnext = (lane & 48) | ((lane + 1) & 15);
#pragma unroll
            for (int ai = 0; ai < 2; ++ai) { const int grpi = 2 * ai + wr;
                const f32x4 xprev = *(const PG8_LAS f32x4*)(X + (((grpi + 3) & 3) * 2 + 1) * 64 + chl), xnext = *(const PG8_LAS f32x4*)(X + (((grpi + 1) & 3) * 2 + 0) * 64 + chl);
#pragma unroll
                for (int m = 0; m < 4; ++m) {
                    const f32x4 ps = m > 0 ? t[ai][m - 1] : xprev, ns = m < 3 ? t[ai][m + 1] : xnext, tc = t[ai][m];
                    f32x4 tp, tn;
#pragma unroll
                    for (int i = 0; i < 4; ++i) { tp[i] = __shfl(fr == 15 ? ps[i] : tc[i], lprev); tn[i] = __shfl(fr == 0 ? ns[i] : tc[i], lnext); }
                    const f32x4 y = g[ai][m] * (w0 * tp + w1 * tc + w2 * tn + cb);
                    const int rt = 128 * ai + 64 * wr + 16 * m + fr;
                    u32x2 yw; yw.x = cvt_pk_bf16(y[0], y[1]); yw.y = cvt_pk_bf16(y[2], y[3]);
                    if (rt != 0 && rt != 255) *(u32x2*)(Y + (size_t)(u.pm * BM + rt) * 1024 + ch0) = yw;
                }
            }
        } else {
            const int grp = (u.pn - 8) >> 1, head = 4 * ((u.pn - 8) & 1) + wc;
            bf16_t* dst = QKVZ + (size_t)grp * (size_t)(16u << 20);
            const int col0 = head * 64 + 8 * fq;
            f32x4 wv[2][2];
            if (grp < 2) { const PG8_LAS float* w = (const PG8_LAS float*)(xl + 10240) + 64 * grp;
#pragma unroll
                for (int bj = 0; bj < 2; ++bj)
#pragma unroll
                    for (int n = 0; n < 2; ++n) wv[bj][n] = *(const PG8_LAS f32x4*)(w + 32 * bj + 8 * fq + 4 * n); }
            const float sc = grp == 0 ? 0.125f * 1.4426950408889634f : 1.f;
#pragma unroll
            for (int ai = 0; ai < 2; ++ai)
#pragma unroll
                for (int m = 0; m < 4; ++m) {
                    f32x4 v[2][2];
#pragma unroll
                    for (int bj = 0; bj < 2; ++bj)
#pragma unroll
                        for (int n = 0; n < 2; ++n) v[bj][n] = acc[ai][bj][m][n];
                    if (grp < 2) {
                        float ss = 0.f;
#pragma unroll
                        for (int bj = 0; bj < 2; ++bj)
#pragma unroll
                            for (int n = 0; n < 2; ++n) ss += (v[bj][n][0] * v[bj][n][0] + v[bj][n][1] * v[bj][n][1]) + (v[bj][n][2] * v[bj][n][2] + v[bj][n][3] * v[bj][n][3]);
                        ss += __shfl_xor(ss, 16); ss += __shfl_xor(ss, 32);
                        const float rs = __builtin_amdgcn_rsqf(ss * (1.f / 64.f) + 1e-6f) * sc;
#pragma unroll
                        for (int bj = 0; bj < 2; ++bj)
#pragma unroll
                            for (int n = 0; n < 2; ++n) v[bj][n] = v[bj][n] * rs * wv[bj][n];
                    } else if (grp == 3) {
#pragma unroll
                        for (int bj = 0; bj < 2; ++bj)
#pragma unroll
                            for (int n = 0; n < 2; ++n)
#pragma unroll
                                for (int i = 0; i < 4; ++i) v[bj][n][i] = silu_f(v[bj][n][i]);
                    }
                    bf16_t* rowp = dst + (size_t)(row0 + ai * HALF + m * 16) * 512 + col0;
#pragma unroll
                    for (int bj = 0; bj < 2; ++bj) { u32x4 w; w.x = cvt_pk_bf16(v[bj][0][0], v[bj][0][1]); w.y = cvt_pk_bf16(v[bj][0][2], v[bj][0][3]); w.z = cvt_pk_bf16(v[bj][1][0], v[bj][1][1]); w.w = cvt_pk_bf16(v[bj][1][2], v[bj][1][3]);
                        *(u32x4*)(rowp + 32 * bj) = w; }
                }
        }
    }
};
struct EpiRes {
    static constexpr bool PERM = false, AFTER_DRAIN = false;
    const float* X; float* O; int ldc;
    __device__ __forceinline__ void operator()(const f32x4 (&acc)[2][2][4][2], const Unit& u, int wr, int wc, int fr, int fq) const {
        const int row0 = u.pm * BM + wr * 64 + fr, col0 = u.pn * BM + wc * 32 + 4 * fq;
#pragma unroll
        for (int ai = 0; ai < 2; ++ai)
#pragma unroll
            for (int m = 0; m < 4; ++m) { const size_t off = (size_t)(row0 + ai * HALF + m * 16) * ldc + col0;
#pragma unroll
                for (int bj = 0; bj < 2; ++bj)
#pragma unroll
                    for (int n = 0; n < 2; ++n) *(f32x4*)(O + off + bj * HALF + n * 16) = acc[ai][bj][m][n] + *(const f32x4*)(X + off + bj * HALF + n * 16); }
    }
};

template <class Epi, class Sched, bool ALIGN_EPI = false, bool SP2 = false>
__device__ __forceinline__ void gemm_phase(PG8_LAS unsigned char* lds, const Gemm g, const Sched& S, const Epi& E) {
    const int tid = threadIdx.x, wid = __builtin_amdgcn_readfirstlane(tid >> 6), lane = tid & 63, wr = wid >> 2, wc = wid & 3, fr = lane & 15, fq = lane >> 4;
    const int K = g.K, nt = K / BK;
    unsigned voffA[2], voffB[2];
#pragma unroll
    for (int i = 0; i < 2; ++i) { int R, C; stage_rc(tid * 16 + i * 8192, R, C);
        voffA[i] = (unsigned)(R * K + C) * 2u; voffB[i] = (unsigned)(R * K + C) * 2u; }
    const size_t kstep = (size_t)(BK * 2);
    const size_t hstep = (size_t)HALF * K * 2;
    const size_t tstep = 2 * hstep;
    const unsigned ldsw = (unsigned)wid * 1024u;
    const int aoff = lds_byte(wr * 64 + fr, fq * 8), boff = lds_byte(wc * 32 + fr, fq * 8);
#define PG8_SA(b, h) (((b) * 2 + (h)) * HTB)
#define PG8_SB(b, h) ((4 + (b) * 2 + (h)) * HTB)
#define PG8_STAGE(bufoff, gbase, voff) do { _Pragma("unroll") for (int _i = 0; _i < 2; ++_i) \
        __builtin_amdgcn_global_load_lds((const unsigned*)((const char*)(gbase) + (voff)[_i]), (PG8_LAS unsigned*)(lds + (bufoff) + ldsw + _i * 8192), 16, 0, 0); } while (0)
#define PG8_LDA(dst, b, h) do { _Pragma("unroll") for (int m = 0; m < 4; ++m) _Pragma("unroll") for (int k = 0; k < 2; ++k) dst[m][k] = *(const PG8_LAS bf16x8*)(lds + PG8_SA(b, h) + aoff + m * 2048 + k * 1024); } while (0)
#define PG8_LDB(dst, b, h) do { _Pragma("unroll") for (int n = 0; n < 2; ++n) _Pragma("unroll") for (int k = 0; k < 2; ++k) dst[n][k] = *(const PG8_LAS bf16x8*)(lds + PG8_SB(b, h) + boff + n * 2048 + k * 1024); } while (0)
#define PG8_MMA(ai, bj, At, Bt) do { __builtin_amdgcn_s_setprio(1); _Pragma("unroll") for (int m = 0; m < 4; ++m) _Pragma("unroll") for (int n = 0; n < 2; ++n) _Pragma("unroll") for (int k = 0; k < 2; ++k) \
        acc[ai][bj][m][n] = __builtin_amdgcn_mfma_f32_16x16x32_bf16(Bt[n][k], At[m][k], acc[ai][bj][m][n], 0, 0, 0); __builtin_amdgcn_s_setprio(0); } while (0)
#define PG8_WAIT_V(n) asm volatile("s_waitcnt vmcnt(" #n ")" ::: "memory")
#define PG8_WAIT_L(n) asm volatile("s_waitcnt lgkmcnt(" #n ")" ::: "memory")
#define PG8_BAR __builtin_amdgcn_s_barrier()
#define PG8_SCHED __builtin_amdgcn_sched_barrier(0)
    Unit cur, nxt; int ui = 0;
    if (!S.next(0, cur)) return;
    f32x4 acc[2][2][4][2];
#pragma unroll
    for (int a = 0; a < 2; ++a)
#pragma unroll
        for (int b = 0; b < 2; ++b)
#pragma unroll
            for (int m = 0; m < 4; ++m)
#pragma unroll
                for (int n = 0; n < 2; ++n) acc[a][b][m][n] = (f32x4){0.f, 0.f, 0.f, 0.f};
    bf16x8 At[4][2], B0[2][2], B1[2][2];
    const char* cA = (const char*)g.A + (size_t)cur.pm * tstep; const char* cB = (const char*)g.Bt + (size_t)cur.pn * tstep;
    if constexpr (SP2) {
        PG8_STAGE(PG8_SB(0, 0), cB, voffB); PG8_STAGE(PG8_SB(0, 1), cB + hstep, voffB); PG8_STAGE(PG8_SA(0, 0), cA, voffA); PG8_STAGE(PG8_SA(0, 1), cA + hstep, voffA);
        if (wr == 1) PG8_BAR;
        PG8_WAIT_V(2); PG8_BAR;
        PG8_STAGE(PG8_SB(1, 0), cB + kstep, voffB); PG8_STAGE(PG8_SA(1, 0), cA + kstep, voffA); PG8_STAGE(PG8_SB(1, 1), cB + hstep + kstep, voffB);
        PG8_WAIT_V(6); PG8_BAR;
    } else {
        PG8_STAGE(PG8_SB(0, 0), cB, voffB); PG8_STAGE(PG8_SA(0, 0), cA, voffA); PG8_STAGE(PG8_SB(0, 1), cB + hstep, voffB); PG8_STAGE(PG8_SA(0, 1), cA + hstep, voffA);
        if (wr == 1) PG8_BAR;
        PG8_WAIT_V(4); PG8_BAR;
        PG8_STAGE(PG8_SB(1, 0), cB + kstep, voffB); PG8_STAGE(PG8_SA(1, 0), cA + kstep, voffA); PG8_STAGE(PG8_SB(1, 1), cB + hstep + kstep, voffB);
        PG8_WAIT_V(6); PG8_BAR;
    }
    for (;;) {
        const bool has_next = S.next(ui + 1, nxt);
        const char* nA = has_next ? (const char*)g.A + (size_t)nxt.pm * tstep : cA; const char* nB = has_next ? (const char*)g.Bt + (size_t)nxt.pn * tstep : cB;
        for (int t = 0; t < nt; t += 2) {
            const bool last = (t == nt - 2);
            const char* a1 = cA + (size_t)(t + 1) * kstep;
            const char* a2 = last ? nA : cA + (size_t)(t + 2) * kstep; const char* b2 = last ? nB : cB + (size_t)(t + 2) * kstep;
            const char* a3 = a2 + kstep; const char* b3 = b2 + kstep;
            if constexpr (SP2) {
            PG8_LDB(B0, 0, 0); PG8_LDB(B1, 0, 1); PG8_SCHED; PG8_LDA(At, 0, 0); PG8_STAGE(PG8_SA(1, 1), a1 + hstep, voffA);
            PG8_WAIT_V(8); PG8_WAIT_L(0); PG8_BAR; PG8_MMA(0, 0, At, B0); PG8_MMA(0, 1, At, B1); PG8_BAR; PG8_SCHED;
            PG8_LDA(At, 0, 1); PG8_STAGE(PG8_SB(0, 0), b2, voffB); PG8_STAGE(PG8_SB(0, 1), b2 + hstep, voffB); PG8_STAGE(PG8_SA(0, 0), a2, voffA);
            PG8_WAIT_V(8); PG8_WAIT_L(0); PG8_BAR; PG8_MMA(1, 0, At, B0); PG8_MMA(1, 1, At, B1); PG8_BAR; PG8_SCHED;
            PG8_LDB(B0, 1, 0); PG8_LDB(B1, 1, 1); PG8_SCHED; PG8_LDA(At, 1, 0); PG8_STAGE(PG8_SA(0, 1), a2 + hstep, voffA);
            PG8_WAIT_V(8); PG8_WAIT_L(0); PG8_BAR; PG8_MMA(0, 0, At, B0); PG8_MMA(0, 1, At, B1); PG8_BAR; PG8_SCHED;
            PG8_LDA(At, 1, 1); PG8_STAGE(PG8_SB(1, 0), b3, voffB); PG8_STAGE(PG8_SB(1, 1), b3 + hstep, voffB); PG8_STAGE(PG8_SA(1, 0), a3, voffA);
            PG8_WAIT_V(8); PG8_WAIT_L(0); PG8_BAR; PG8_MMA(1, 0, At, B0); PG8_MMA(1, 1, At, B1); PG8_BAR; PG8_SCHED;
            } else {
            PG8_LDB(B0, 0, 0); PG8_SCHED; PG8_LDA(At, 0, 0); PG8_STAGE(PG8_SA(1, 1), a1 + hstep, voffA);
            PG8_WAIT_L(8); PG8_BAR; PG8_WAIT_L(0); PG8_MMA(0, 0, At, B0); PG8_BAR; PG8_SCHED;
            PG8_LDB(B1, 0, 1); PG8_STAGE(PG8_SB(0, 0), b2, voffB);
            PG8_BAR; PG8_WAIT_L(0); PG8_MMA(0, 1, At, B1); PG8_BAR;
            PG8_LDA(At, 0, 1); PG8_STAGE(PG8_SA(0, 0), a2, voffA);
            PG8_BAR; PG8_WAIT_L(0); PG8_MMA(1, 0, At, B0); PG8_BAR; PG8_SCHED;
            PG8_STAGE(PG8_SB(0, 1), b2 + hstep, voffB);
            PG8_WAIT_V(6); PG8_BAR; PG8_MMA(1, 1, At, B1); PG8_BAR;
            PG8_LDB(B0, 1, 0); PG8_SCHED; PG8_LDA(At, 1, 0); PG8_STAGE(PG8_SA(0, 1), a2 + hstep, voffA);
            PG8_WAIT_L(8); PG8_BAR; PG8_WAIT_L(0); PG8_MMA(0, 0, At, B0); PG8_BAR; PG8_SCHED;
            PG8_LDB(B1, 1, 1); PG8_STAGE(PG8_SB(1, 0), b3, voffB);
            PG8_BAR; PG8_WAIT_L(0); PG8_MMA(0, 1, At, B1); PG8_BAR;
            PG8_LDA(At, 1, 1); PG8_STAGE(PG8_SA(1, 0), a3, voffA);
            PG8_BAR; PG8_WAIT_L(0); PG8_MMA(1, 0, At, B0); PG8_BAR; PG8_SCHED;
            PG8_STAGE(PG8_SB(1, 1), b3 + hstep, voffB);
            PG8_WAIT_V(6); PG8_BAR; PG8_MMA(1, 1, At, B1); PG8_BAR;
            }
        }
        if constexpr (ALIGN_EPI) { if (wr == 0) PG8_BAR; }
        E(acc, cur, wr, wc, fr, fq);
        if (!has_next) break;
#pragma unroll
        for (int a = 0; a < 2; ++a)
#pragma unroll
            for (int b = 0; b < 2; ++b)
#pragma unroll
                for (int m = 0; m < 4; ++m)
#pragma unroll
                    for (int n = 0; n < 2; ++n) acc[a][b][m][n] = (f32x4){0.f, 0.f, 0.f, 0.f};
        cur = nxt; cA = nA; cB = nB; ++ui;
        if constexpr (ALIGN_EPI) { if (wr == 1) PG8_BAR; }
    }
    PG8_WAIT_V(0);
    if constexpr (!ALIGN_EPI) { if (wr == 0) PG8_BAR; }
    PG8_BAR;
#undef PG8_SA
#undef PG8_SB
#undef PG8_STAGE
#undef PG8_LDA
#undef PG8_LDB
#undef PG8_MMA
#undef PG8_WAIT_V
#undef PG8_WAIT_L
#undef PG8_BAR
#undef PG8_SCHED
}
}

constexpr int D_MODEL = 1024, BATCH = 2, SEQ = 16384, M = BATCH * SEQ, NPROJ = 4096, AW = 512, NHEAD = 8;
constexpr int NWAVES = 8;
constexpr size_t MiB = 1u << 20;
constexpr size_t WS_CTL = 0, CTL_ZERO_BYTES = 1 * MiB;
constexpr size_t WS_TBG = 1 * MiB;
constexpr size_t WS_WIN = 2 * MiB;
constexpr size_t WS_WOUT = 10 * MiB;
constexpr size_t WS_LP4 = 12 * MiB, WS_LP16 = 13 * MiB;
constexpr size_t WS_XN = 16 * MiB;
constexpr size_t WS_SBT = 80 * MiB, WS_SBG = 82 * MiB;
constexpr size_t WS_Q = 144 * MiB, WS_K = 176 * MiB, WS_V = 208 * MiB, WS_ZG = 240 * MiB;
constexpr size_t WS_OP4 = 272 * MiB, WS_OP16 = 304 * MiB;
constexpr size_t WS_Y = 336 * MiB;
constexpr size_t WS_END = 400 * MiB;
constexpr int CW_BAR = 4096;

constexpr int RING_OFF = 0, RING_BYTES = 131072;
constexpr int LDSCTL_OFF = 146432, MISC_OFF = LDSCTL_OFF + 320;
constexpr int LDS_BYTES = 147456;
constexpr int XL_OFF = 131072;
static_assert(XL_OFF + 10752 <= LDSCTL_OFF, "LDS map");

#define GAS __attribute__((address_space(1)))
#define LAS __attribute__((address_space(3)))
typedef unsigned short bf16;
typedef unsigned v4u __attribute__((ext_vector_type(4)));
typedef float f32x4 __attribute__((ext_vector_type(4)));
typedef float f32x16 __attribute__((ext_vector_type(16)));
typedef short bf16x8 __attribute__((ext_vector_type(8)));
typedef short s16x4 __attribute__((ext_vector_type(4)));
typedef GAS unsigned gu32;
#define RLX_AGENT __ATOMIC_RELAXED, __HIP_MEMORY_SCOPE_AGENT
#define LDS_WAIT() asm volatile("s_waitcnt lgkmcnt(0)" ::: "memory")
__device__ __forceinline__ unsigned f2bf(float f) { unsigned u = __builtin_bit_cast(unsigned, f); return (u + 0x7fffu + ((u >> 16) & 1u)) >> 16; }
__device__ __forceinline__ unsigned pk2(float lo, float hi) { return f2bf(lo) | (f2bf(hi) << 16); }
__device__ __forceinline__ float bf2f(unsigned short b) { return __builtin_bit_cast(float, (unsigned)b << 16); }
__device__ __forceinline__ float bflo(unsigned w) { return __builtin_bit_cast(float, w << 16); }
__device__ __forceinline__ float bfhi(unsigned w) { return __builtin_bit_cast(float, w & 0xffff0000u); }

#define XB_TMO      128
#define XB_XCNT(j)  (256  + 64 * (j))
#define XB_XSUB(j)  (1280 + 64 * (j))
#define XB_XGEN(j)  (2304 + 64 * (j))
#define XB_TOP      3328
#define XB_TOPGEN   3392
#define XCD_BAR_WORDS 3456
#define XB_SPIN_CAP (1u << 18)
__device__ __forceinline__ unsigned xb_ld(unsigned* p)              { return __hip_atomic_load(p, __ATOMIC_RELAXED, __HIP_MEMORY_SCOPE_AGENT); }
__device__ __forceinline__ unsigned xb_add(unsigned* p, unsigned v) { return __hip_atomic_fetch_add(p, v, __ATOMIC_RELAXED, __HIP_MEMORY_SCOPE_AGENT); }
__device__ __forceinline__ unsigned xb_xcc_id() { return (unsigned)__builtin_amdgcn_s_getreg((3 << 11) | 20) & 0xFu; }
#define XB_SPIN(cond, bar) do { unsigned _sp = 0; while (cond) { __builtin_amdgcn_s_sleep(1); \
    if ((++_sp & 255u) == 0u) { if (xb_ld(&(bar)[XB_TMO])) break; if (_sp > XB_SPIN_CAP) { atomicAdd(&(bar)[XB_TMO], 1u); break; } } } } while (0)
struct XcdBarrier { unsigned* bar; unsigned x; volatile LAS unsigned* st; };
__device__ __forceinline__ XcdBarrier xcd_barrier_post(unsigned* bar, volatile LAS unsigned* st) {
    XcdBarrier b; b.bar = bar; b.x = xb_xcc_id(); b.st = st;
    if (threadIdx.x == 0) (void)xb_add(&bar[XB_XCNT(b.x)], 1u);
    return b;
}
__device__ __forceinline__ void xcd_barrier_complete(unsigned* bar, unsigned x, unsigned& nloc, unsigned& nx) {
    const unsigned G = gridDim.x * gridDim.y * gridDim.z;
    unsigned sum, cnt, mine, sp = 0u;
    for (;;) {
        sum = 0u; cnt = 0u; mine = 0u;
#pragma unroll
        for (unsigned j = 0; j < 16; ++j) { const unsigned c = xb_ld(&bar[XB_XCNT(j)]); sum += c; cnt += (c > 0u) ? 1u : 0u; mine = (j == x) ? c : mine; }
        if (sum == G) break;
        __builtin_amdgcn_s_sleep(1);
        if ((++sp & 255u) == 0u) { if (xb_ld(&bar[XB_TMO])) break; if (sp > XB_SPIN_CAP) { atomicAdd(&bar[XB_TMO], 1u); break; } }
    }
    nloc = mine > 0u ? mine : 1u; nx = cnt > 0u ? cnt : 1u;
}
__device__ __forceinline__ void xcd_barrier(const XcdBarrier& b) {
    asm volatile("s_waitcnt vmcnt(0)" ::: "memory");
    __syncthreads();
    if (threadIdx.x == 0) {
        unsigned* bar = b.bar;
        __builtin_amdgcn_s_waitcnt(0);
        unsigned nloc = b.st[0], nx = b.st[1];
        if (nloc == 0u) { xcd_barrier_complete(bar, b.x, nloc, nx); b.st[0] = nloc; b.st[1] = nx; }
        const unsigned old = xb_add(&bar[XB_XSUB(b.x)], 1u);
        const unsigned gen = old / nloc;
        if (old + 1u == (gen + 1u) * nloc) {
            __builtin_amdgcn_fence(__ATOMIC_RELEASE, "agent");
            asm volatile("s_waitcnt vmcnt(0)" ::: "memory");
            const unsigned og = xb_add(&bar[XB_TOP], 1u);
            const unsigned tg = og / nx;
            if (og + 1u == (tg + 1u) * nx) xb_add(&bar[XB_TOPGEN], 1u);
            else XB_SPIN(xb_ld(&bar[XB_TOPGEN]) == tg, bar);
            __builtin_amdgcn_fence(__ATOMIC_ACQUIRE, "agent");
            xb_add(&bar[XB_XGEN(b.x)], 1u);
            asm volatile("s_waitcnt vmcnt(0)" ::: "memory");
        } else {
            XB_SPIN(xb_ld(&bar[XB_XGEN(b.x)]) == gen, bar);
            __builtin_amdgcn_fence(__ATOMIC_ACQUIRE, "agent");
            asm volatile("s_waitcnt vmcnt(0)" ::: "memory");
        }
    }
    __syncthreads();
}

struct Frame {
    LAS unsigned char* lds;
    volatile LAS unsigned* MISC;
    gu32* ctl;
    int tid, lane, wave, vcu, G;
    const float *x, *norm_w, *w_in, *conv_w, *conv_b, *qw, *kw, *rel_bias, *w_out; float* out;
    bf16 *WinT, *WoutT, *XN, *Q, *K, *V, *ZG, *OP4, *OP16, *Y;
    float *TBG, *LP4, *LP16, *SBT, *SBG;
};
__device__ __forceinline__ float wave_sum(float v) {
#pragma unroll
    for (int o = 1; o < 64; o <<= 1) v += __shfl_xor(v, o);
    return v;
}
__device__ __forceinline__ float wave_max(float v) {
#pragma unroll
    for (int o = 1; o < 64; o <<= 1) v = fmaxf(v, __shfl_xor(v, o));
    return v;
}
__device__ __forceinline__ int win_row(int L) {
    int pn, wc, bj, n, fq, reg;
    if (L < 2048) { const int which = L >> 9, ch = L & 511; pn = ch >> 6; wc = (ch >> 4) & 3; fq = (ch >> 2) & 3; reg = ch & 3; bj = which >> 1; n = which & 1; }
    else { const int Lp = L - 2048, grp = Lp >> 9, head = (Lp >> 6) & 7, e = Lp & 63; pn = 8 + 2 * grp + (head >> 2); wc = head & 3; bj = e >> 5; fq = (e >> 3) & 3; n = (e >> 2) & 1; reg = e & 3; }
    return pn * 256 + 128 * bj + 32 * wc + 16 * n + 4 * fq + reg;
}
template <bool PERMUTE>
__device__ __forceinline__ void p0_transpose_item(const float* W, int K, int N, bf16* WT, LAS float* scr, int item, int lane) {
    const int nblk = N / 32, kb = item / nblk, nb = item % nblk, k0 = 64 * kb, n0 = 32 * nb;
#pragma unroll 8
    for (int i = 0; i < 32; ++i) { const int kk = 2 * i + (lane >> 5); scr[kk * 33 + (lane & 31)] = W[(size_t)(k0 + kk) * N + n0 + (lane & 31)]; }
    LDS_WAIT(); asm volatile("" ::: "memory");
    const int c = lane & 7;
#pragma unroll
    for (int j = 0; j < 4; ++j) { const int n = (lane >> 3) + 8 * j; const LAS float* s = scr + (8 * c) * 33 + n;
        v4u o; o.x = pk2(s[0 * 33], s[1 * 33]); o.y = pk2(s[2 * 33], s[3 * 33]); o.z = pk2(s[4 * 33], s[5 * 33]); o.w = pk2(s[6 * 33], s[7 * 33]);
        const int dr = PERMUTE ? win_row(n0 + n) : (n0 + n);
        *(GAS v4u*)(WT + (size_t)dr * K + k0 + 8 * c) = o; }
    LDS_WAIT(); asm volatile("" ::: "memory");
}
__device__ __forceinline__ int t5_bucket(int rel) {
    const int n = rel < 0 ? -rel : rel; int b = rel > 0 ? 16 : 0;
    if (n < 8) return b + n;
    int large = 8 + (int)(logf((float)n / 8.f) / logf(128.f) * 8.f);
    if (large > 15) large = 15;
    return b + large;
}
__device__ __forceinline__ void p0_prologue(Frame& F) {
    LAS float* scr = (LAS float*)(F.lds + RING_OFF + F.wave * 16384);
    const int gw = F.vcu * NWAVES + F.wave, NGW = F.G * NWAVES;
    constexpr int I_IN = (D_MODEL / 64) * (NPROJ / 32), I_OUT = (D_MODEL / 64) * (D_MODEL / 32);
    for (int it = gw; it < I_IN + I_OUT; it += NGW) {
        if (it < I_IN) p0_transpose_item<true>(F.w_in, D_MODEL, NPROJ, F.WinT, scr, it, F.lane);
        else p0_transpose_item<false>(F.w_out, D_MODEL, D_MODEL, F.WoutT, scr, it - I_IN, F.lane);
    }
    f32x4 nw[4];
#pragma unroll
    for (int j = 0; j < 4; ++j) nw[j] = ((const f32x4*)F.norm_w)[F.lane + 64 * j];
    for (int m = gw; m < M; m += NGW) {
        const GAS f32x4* xr = (const GAS f32x4*)(F.x + (size_t)m * D_MODEL) + F.lane;
        f32x4 v[4]; float s = 0.f;
#pragma unroll
        for (int j = 0; j < 4; ++j) { v[j] = xr[64 * j]; s += (v[j].x * v[j].x + v[j].y * v[j].y) + (v[j].z * v[j].z + v[j].w * v[j].w); }
        const float rstd = 1.f / sqrtf(wave_sum(s) * (1.f / D_MODEL) + 1e-6f);
        GAS unsigned long long* o8 = (GAS unsigned long long*)(F.XN + (size_t)m * D_MODEL) + F.lane;
#pragma unroll
        for (int j = 0; j < 4; ++j) { const f32x4 y = v[j] * rstd * nw[j]; o8[64 * j] = (unsigned long long)pk2(y.x, y.y) | ((unsigned long long)pk2(y.z, y.w) << 32); }
    }
    if (blockIdx.x == 0) {
        const float mq = wave_max(fabsf(F.qw[F.lane])), mk = wave_max(fabsf(F.kw[F.lane]));
        float mb = 0.f;
#pragma unroll
        for (int j = 0; j < 4; ++j) mb = fmaxf(mb, fabsf(F.rel_bias[F.lane + 64 * j]));
        mb = wave_max(mb);
        const float M2 = (8.f * mq * mk + mb) * 1.4426950408889634f;
        for (int i = F.tid; i < 3 * 8 * 192; i += NWAVES * 64) {
            const int jp = i % 192, h = (i / 192) & 7, c = i / (192 * 8), j = jp - 32;
            const int dil = c == 0 ? 1 : (c == 1 ? 4 : 16);
            float v = -1e30f;
            if (j >= 0 && j <= 128) v = F.rel_bias[t5_bucket((j - 64) * dil) * 8 + h] * 1.4426950408889634f - M2;
            F.TBG[i] = v;
        }
    }
}

__device__ __forceinline__ int crow(int r, int hi) { return (r & 3) + 8 * (r >> 2) + 4 * hi; }
__device__ __forceinline__ unsigned cvtpk_s(float lo, float hi) { typedef float f2 __attribute__((ext_vector_type(2))); typedef __bf16 b2 __attribute__((ext_vector_type(2))); f2 v = {lo, hi}; b2 b = __builtin_convertvector(v, b2); return __builtin_bit_cast(unsigned, b); }
typedef short v4i16_t __attribute__((ext_vector_type(4)));
__device__ __forceinline__ s16x4 vtr(LAS const unsigned char* p) { return __builtin_bit_cast(s16x4, __builtin_amdgcn_ds_read_tr16_b64_v4i16((LAS v4i16_t*)p)); }

constexpr int AT_TILE = 8448, AT_KCH = 528, AT_VOFF = 4224, AT_VPC = 1056, AT_NT = 12;
constexpr int AT_OST = AT_NT * AT_TILE;
constexpr int AT_TBL = AT_OST + NWAVES * 4096;
constexpr int AT_LW = AT_TBL + 768;
static_assert(AT_LW + NWAVES * 128 <= LDSCTL_OFF, "attention LDS map");
struct TaskD { int dil, L, i0, hq, c, h, tok0; };
template <bool FINAL>
__device__ __forceinline__ TaskD unit_decode(int vcu, int i) {
    TaskD D; const int x = vcu >> 5, j = vcu & 31;
    int pair, r, blk;
    if (FINAL) { pair = 2 * x + (i >> 1); r = 0; blk = 2 * j + (i & 1); D.c = 0; D.dil = 1; D.L = SEQ; }
    else { pair = 2 * x + (i >> 2); const int k = i & 3;
        if (j < 16) { D.c = 1; D.dil = 4; D.L = SEQ / 4; r = j >> 2; blk = 4 * (j & 3) + k; } else { D.c = 2; D.dil = 16; D.L = SEQ / 16; r = j - 16; blk = k; } }
    D.h = pair & 7; D.hq = D.h * 64; D.tok0 = (pair >> 3) * SEQ + r; D.i0 = blk * 256;
    return D;
}
#define AT_BAR() do { asm volatile("s_waitcnt lgkmcnt(0)" ::: "memory"); __builtin_amdgcn_s_barrier(); asm volatile("" ::: "memory"); } while (0)
template <bool FINAL>
__device__ __forceinline__ void attn_units(Frame& F) {
    constexpr int u0 = 0, u1 = FINAL ? 4 : 8;
    const int lane = F.lane, w = F.wave, r32 = lane & 31, hi = lane >> 5;
    LAS unsigned char* L0 = F.lds;
    LAS unsigned short* stgb = (LAS unsigned short*)(F.lds + AT_OST + w * 4096);
    LAS float* tbl = (LAS float*)(F.lds + AT_TBL);
    LAS float* lw = (LAS float*)(F.lds + AT_LW) + w * 32;
    const int vaddr = AT_VOFF + ((lane >> 4) & 1) * 32 + (lane & 3) * 8 + (4 * hi + ((lane & 15) >> 2)) * 64;
    const bool isV = w >= 4; const int srow = 8 * (w & 3) + (lane >> 3), sch = lane & 7;
    const int sdst = isV ? (AT_VOFF + (sch >> 2) * (2 * AT_VPC) + (srow >> 4) * AT_VPC + (srow & 15) * 64 + (sch & 3) * 16) : (sch * AT_KCH + srow * 16);
    const bf16* ssrc = isV ? F.V : F.K;
    bf16x8 st[AT_NT], qn[4], qr[4];
#define STAGE_LOAD(D_) do { _Pragma("unroll") for (int t_ = 0; t_ < AT_NT; ++t_) { int key_ = (D_).i0 - 64 + 32 * t_ + srow; key_ = key_ < 0 ? 0 : (key_ > (D_).L - 1 ? (D_).L - 1 : key_); \
        st[t_] = *(const bf16x8*)(ssrc + (unsigned)(((D_).tok0 + (D_).dil * key_) * AW + (D_).hq + sch * 8)); } } while (0)
#define LOADQN(D_) do { const unsigned qo_ = (unsigned)(((D_).tok0 + (D_).dil * ((D_).i0 + 32 * w + r32)) * AW + (D_).hq + hi * 8); \
        _Pragma("unroll") for (int d0 = 0; d0 < 4; ++d0) qn[d0] = *(const bf16x8*)(F.Q + qo_ + d0 * 16); } while (0)
#define CHUNK(kc) do { const LAS unsigned char* tb_ = L0 + (w + (kc)) * AT_TILE; const int k0_ = i0w - 64 + 32 * (kc); \
        f32x16 a_; { const LAS float* tp_ = tbl + (32 + 32 * (kc) + 4 * hi - r32); \
            _Pragma("unroll") for (int rr = 0; rr < 16; ++rr) a_[rr] = tp_[(rr & 3) + 8 * (rr >> 2)]; } \
        if (k0_ < 0 || k0_ + 32 > D.L) { _Pragma("unroll") for (int rr = 0; rr < 16; ++rr) { const int key_ = k0_ + crow(rr, hi); if (key_ < 0 || key_ >= D.L) a_[rr] = -1e30f; } } \
        _Pragma("unroll") for (int d0 = 0; d0 < 4; ++d0) { const bf16x8 kf_ = *(const LAS bf16x8*)(tb_ + (2 * d0 + hi) * AT_KCH + r32 * 16); \
            a_ = __builtin_amdgcn_mfma_f32_32x32x16_bf16(kf_, qr[d0], a_, 0, 0, 0); } \
        _Pragma("unroll") for (int rr = 0; rr < 16; ++rr) { a_[rr] = __builtin_amdgcn_exp2f(a_[rr]); lsum += a_[rr]; } \
        v4u pw0_, pw1_; pw0_.x = cvtpk_s(a_[0], a_[1]); pw0_.y = cvtpk_s(a_[2], a_[3]); pw0_.z = cvtpk_s(a_[4], a_[5]); pw0_.w = cvtpk_s(a_[6], a_[7]); \
        pw1_.x = cvtpk_s(a_[8], a_[9]); pw1_.y = cvtpk_s(a_[10], a_[11]); pw1_.z = cvtpk_s(a_[12], a_[13]); pw1_.w = cvtpk_s(a_[14], a_[15]); \
        const LAS unsigned char* vb_ = tb_ + vaddr; \
        { s16x4 l0 = vtr(vb_), h0 = vtr(vb_ + 512), l1 = vtr(vb_ + AT_VPC), h1 = vtr(vb_ + AT_VPC + 512); \
          o0 = __builtin_amdgcn_mfma_f32_32x32x16_bf16(__builtin_bit_cast(bf16x8, pw0_), (bf16x8){l0[0], l0[1], l0[2], l0[3], h0[0], h0[1], h0[2], h0[3]}, o0, 0, 0, 0); \
          o0 = __builtin_amdgcn_mfma_f32_32x32x16_bf16(__builtin_bit_cast(bf16x8, pw1_), (bf16x8){l1[0], l1[1], l1[2], l1[3], h1[0], h1[1], h1[2], h1[3]}, o0, 0, 0, 0); } \
        { s16x4 l2 = vtr(vb_ + 2 * AT_VPC), h2 = vtr(vb_ + 2 * AT_VPC + 512), l3 = vtr(vb_ + 3 * AT_VPC), h3 = vtr(vb_ + 3 * AT_VPC + 512); \
          o1 = __builtin_amdgcn_mfma_f32_32x32x16_bf16(__builtin_bit_cast(bf16x8, pw0_), (bf16x8){l2[0], l2[1], l2[2], l2[3], h2[0], h2[1], h2[2], h2[3]}, o1, 0, 0, 0); \
          o1 = __builtin_amdgcn_mfma_f32_32x32x16_bf16(__builtin_bit_cast(bf16x8, pw1_), (bf16x8){l3[0], l3[1], l3[2], l3[3], h3[0], h3[1], h3[2], h3[3]}, o1, 0, 0, 0); } } while (0)
    TaskD D = unit_decode<FINAL>(F.vcu, u0);
    STAGE_LOAD(D); LOADQN(D);
    int tb_ch = -1;
    for (int u = u0; u < u1; ++u) {
        const TaskD Dn = unit_decode<FINAL>(F.vcu, u + 1 < u1 ? u + 1 : u);
        AT_BAR();
#pragma unroll
        for (int t_ = 0; t_ < AT_NT; ++t_) *(LAS bf16x8*)(L0 + t_ * AT_TILE + sdst) = st[t_];
        if (tb_ch != D.c * 8 + D.h) { tb_ch = D.c * 8 + D.h; if (F.tid < 192) tbl[F.tid] = F.TBG[tb_ch * 192 + F.tid]; }
#pragma unroll
        for (int d0 = 0; d0 < 4; ++d0) qr[d0] = qn[d0];
        AT_BAR();
        STAGE_LOAD(Dn); LOADQN(Dn);
        const int i0w = D.i0 + 32 * w;
        v4u p4[4], p16[4], zg[4]; float l4[4], l16[4];
#define FIN_LOAD(i) do { const int row = (i) * 8 + (lane >> 3), ch = lane & 7; const unsigned tok = (unsigned)(D.tok0 + i0w + row); const unsigned eo = tok * AW + D.hq + ch * 8; \
            p4[i] = *(const v4u*)(F.OP4 + eo); p16[i] = *(const v4u*)(F.OP16 + eo); zg[i] = *(const v4u*)(F.ZG + eo); l4[i] = F.LP4[tok * 8 + D.h]; l16[i] = F.LP16[tok * 8 + D.h]; } while (0)
        if (FINAL) { FIN_LOAD(0); }
        f32x16 o0 = {}, o1 = {}; float lsum = 0.f;
        CHUNK(0); CHUNK(1); CHUNK(2); CHUNK(3); CHUNK(4);
        lsum += __shfl_xor(lsum, 32);
#pragma unroll
        for (int rr = 0; rr < 16; rr += 2) {
            const unsigned a01 = cvtpk_s(o0[rr], o0[rr + 1]), b01 = cvtpk_s(o1[rr], o1[rr + 1]);
            const int q0 = crow(rr, hi), q1 = crow(rr + 1, hi);
            stgb[q0 * 64 + r32] = (unsigned short)(a01 & 0xffffu); stgb[q1 * 64 + r32] = (unsigned short)(a01 >> 16);
            stgb[q0 * 64 + 32 + r32] = (unsigned short)(b01 & 0xffffu); stgb[q1 * 64 + 32 + r32] = (unsigned short)(b01 >> 16);
        }
        if (FINAL) { if (hi == 0) lw[r32] = lsum; FIN_LOAD(1); FIN_LOAD(2); FIN_LOAD(3); }
        else { if (hi == 0) { float* lp = F.LP4 + (size_t)(D.c - 1) * (size_t)(256u << 10) + (unsigned)((D.tok0 + D.dil * (i0w + r32)) * 8 + D.h); *lp = lsum; } }
#pragma unroll
        for (int i = 0; i < 4; ++i) {
            const int row = i * 8 + (lane >> 3), ch = lane & 7;
            const unsigned tok = (unsigned)(D.tok0 + D.dil * (i0w + row));
            const v4u ov = *(const LAS v4u*)(stgb + row * 64 + ch * 8);
            if (!FINAL) {
                *(v4u*)(F.OP4 + (size_t)(D.c - 1) * (size_t)(16u << 20) + (tok * AW + D.hq + ch * 8)) = ov;
            } else {
                const float inv = 1.f / (lw[row] + l4[i] + l16[i]);
                float y[8];
                y[0] = (bflo(ov.x) + bflo(p4[i].x) + bflo(p16[i].x)) * inv * bflo(zg[i].x); y[1] = (bfhi(ov.x) + bfhi(p4[i].x) + bfhi(p16[i].x)) * inv * bfhi(zg[i].x);
                y[2] = (bflo(ov.y) + bflo(p4[i].y) + bflo(p16[i].y)) * inv * bflo(zg[i].y); y[3] = (bfhi(ov.y) + bfhi(p4[i].y) + bfhi(p16[i].y)) * inv * bfhi(zg[i].y);
                y[4] = (bflo(ov.z) + bflo(p4[i].z) + bflo(p16[i].z)) * inv * bflo(zg[i].z); y[5] = (bfhi(ov.z) + bfhi(p4[i].z) + bfhi(p16[i].z)) * inv * bfhi(zg[i].z);
                y[6] = (bflo(ov.w) + bflo(p4[i].w) + bflo(p16[i].w)) * inv * bflo(zg[i].w); y[7] = (bfhi(ov.w) + bfhi(p4[i].w) + bfhi(p16[i].w)) * inv * bfhi(zg[i].w);
                v4u wv; wv.x = cvtpk_s(y[0], y[1]); wv.y = cvtpk_s(y[2], y[3]); wv.z = cvtpk_s(y[4], y[5]); wv.w = cvtpk_s(y[6], y[7]);
                *(v4u*)(F.Y + (tok * D_MODEL + 512 + D.hq + ch * 8)) = wv;
            }
        }
        D = Dn;
    }
    AT_BAR();
#undef STAGE_LOAD
#undef LOADQN
#undef CHUNK
#undef FIN_LOAD
}
__device__ __forceinline__ void conv_fixup_row(Frame& F, int idx, int lane) {
    const int pm = idx >> 1, last = idx & 1;
    const float* tcp = F.SBT + (size_t)(pm * 4 + (last ? 3 : 0)) * 512 + 8 * lane;
    const bool hasp = last || (pm % (SEQ / 256) != 0), hasn = !last || (pm % (SEQ / 256) != SEQ / 256 - 1);
    const float* tpp = last ? F.SBT + (size_t)(pm * 4 + 2) * 512 + 8 * lane : F.SBT + (size_t)((hasp ? pm - 1 : pm) * 4 + 3) * 512 + 8 * lane;
    const float* tnp = last ? F.SBT + (size_t)((hasn ? pm + 1 : pm) * 4 + 0) * 512 + 8 * lane : F.SBT + (size_t)(pm * 4 + 1) * 512 + 8 * lane;
    const float* gp = F.SBG + (size_t)(pm * 2 + last) * 512 + 8 * lane;
    float y[8];
#pragma unroll
    for (int i = 0; i < 8; ++i) {
        const float tp = hasp ? tpp[i] : 0.f, tn = hasn ? tnp[i] : 0.f;
        y[i] = gp[i] * (F.conv_w[8 * lane + i] * tp + F.conv_w[512 + 8 * lane + i] * tcp[i] + F.conv_w[1024 + 8 * lane + i] * tn + F.conv_b[8 * lane + i]);
    }
    v4u w; w.x = cvtpk_s(y[0], y[1]); w.y = cvtpk_s(y[2], y[3]); w.z = cvtpk_s(y[4], y[5]); w.w = cvtpk_s(y[6], y[7]);
    *(v4u*)(F.Y + (size_t)(pm * 256 + (last ? 255 : 0)) * D_MODEL + 8 * lane) = w;
}
__device__ __forceinline__ void attn_pass_a(Frame& F) {
    attn_units<false>(F);
    const int gw = F.vcu * NWAVES + F.wave, NGW = F.G * NWAVES;
    for (int idx = gw; idx < 2 * (M / 256); idx += NGW) conv_fixup_row(F, idx, F.lane);
}
__device__ __forceinline__ void attn_pass_b(Frame& F) {
    attn_units<true>(F);
}

struct Args { const float* in[9]; float* out; unsigned char* ws; int ph_lo, ph_hi; };
__global__ void __launch_bounds__(NWAVES * 64, 2) mega(Args args) {
    extern __shared__ __attribute__((aligned(16))) unsigned char lds[];
    Frame F;
    F.lds = (LAS unsigned char*)lds;
    F.MISC = (volatile LAS unsigned*)(F.lds + MISC_OFF);
    F.tid = threadIdx.x; F.lane = F.tid & 63; F.wave = __builtin_amdgcn_readfirstlane(F.tid >> 6);
    F.G = gridDim.x; { const int bx = blockIdx.x; F.vcu = (F.G % 8 == 0) ? (bx % 8) * (F.G / 8) + bx / 8 : bx; }
    unsigned char* ws = args.ws;
    F.ctl = (gu32*)(ws + WS_CTL);
    F.x = args.in[0]; F.norm_w = args.in[1]; F.w_in = args.in[2]; F.conv_w = args.in[3]; F.conv_b = args.in[4]; F.qw = args.in[5]; F.kw = args.in[6]; F.rel_bias = args.in[7]; F.w_out = args.in[8];
    F.out = args.out;
    F.WinT = (bf16*)(ws + WS_WIN); F.WoutT = (bf16*)(ws + WS_WOUT); F.XN = (bf16*)(ws + WS_XN);
    F.SBT = (float*)(ws + WS_SBT); F.SBG = (float*)(ws + WS_SBG); F.Q = (bf16*)(ws + WS_Q); F.K = (bf16*)(ws + WS_K); F.V = (bf16*)(ws + WS_V); F.ZG = (bf16*)(ws + WS_ZG);
    F.OP4 = (bf16*)(ws + WS_OP4); F.OP16 = (bf16*)(ws + WS_OP16); F.Y = (bf16*)(ws + WS_Y);
    F.TBG = (float*)(ws + WS_TBG); F.LP4 = (float*)(ws + WS_LP4); F.LP16 = (float*)(ws + WS_LP16);
    for (int u = F.tid; u < (LDS_BYTES - LDSCTL_OFF) / 4; u += NWAVES * 64) ((LAS unsigned*)(F.lds + LDSCTL_OFF))[u] = 0u;
    __syncthreads();
    const int lo = args.ph_lo, hi = args.ph_hi;
    const bool multi = (hi - lo) > 1;
    XcdBarrier bar; bar.bar = (unsigned*)(F.ctl + CW_BAR); bar.x = 0; bar.st = nullptr;
    if (multi) bar = xcd_barrier_post((unsigned*)(F.ctl + CW_BAR), F.MISC + 8);
#define IN(k) (lo <= (k) && (k) < hi)
#define BOTH(k) (IN(k) && IN((k) + 1))
    if (IN(0)) { p0_prologue(F); if (BOTH(0)) xcd_barrier(bar); }
    if (IN(1)) {
        pg8::Gemm g{F.XN, F.WinT, M, NPROJ, D_MODEL}; pg8::StaticOrder S; S.init(M, NPROJ, F.G, (int)blockIdx.x);
        { LAS float* cwl = (LAS float*)(F.lds + XL_OFF + 2048);
          for (int i = F.tid; i < 2048; i += NWAVES * 64) cwl[i] = i < 1536 ? F.conv_w[i] : F.conv_b[i - 1536];
          if (F.tid < 128) cwl[2048 + F.tid] = F.tid < 64 ? F.qw[F.tid] : F.kw[F.tid - 64];
          __syncthreads(); }
        pg8::EpiProj E{F.Y, F.Q, F.SBT, F.SBG, F.lds + XL_OFF};
        pg8::gemm_phase<pg8::EpiProj, pg8::StaticOrder, true, true>(F.lds + RING_OFF, g, S, E);
        if (BOTH(1)) xcd_barrier(bar);
    }
    if (IN(2)) { attn_pass_a(F); if (BOTH(2)) xcd_barrier(bar); }
    if (IN(3)) { attn_pass_b(F); if (BOTH(3)) xcd_barrier(bar); }
    if (IN(4)) {
        pg8::Gemm g{F.Y, F.WoutT, M, D_MODEL, D_MODEL}; pg8::StaticOrder S; S.init(M, D_MODEL, F.G, (int)blockIdx.x);
        pg8::EpiRes E{F.x, F.out, D_MODEL};
        pg8::gemm_phase<pg8::EpiRes, pg8::StaticOrder, true, true>(F.lds + RING_OFF, g, S, E);
    }
#undef IN
#undef BOTH
}

extern "C" void kernel_launch(void* const* d_in, const int* in_sizes, int n_in, void* d_out, int out_size, void* d_ws, size_t ws_size, hipStream_t stream) {
    static int grid = 0;
    if (grid == 0) {
        if (n_in != 9 || in_sizes[0] != M * D_MODEL || out_size != M * D_MODEL || ws_size < WS_END) { fprintf(stderr, "kernel_launch: unexpected shapes (n_in %d, in0 %d, out %d, ws %zu)\n", n_in, n_in > 0 ? in_sizes[0] : -1, out_size, ws_size); grid = -1; return; }
        int dev = 0, cus = 0, per_cu = 0;
        if (hipGetDevice(&dev) != hipSuccess || hipDeviceGetAttribute(&cus, hipDeviceAttributeMultiprocessorCount, dev) != hipSuccess) { grid = -1; return; }
        if (hipFuncSetAttribute((const void*)mega, hipFuncAttributeMaxDynamicSharedMemorySize, LDS_BYTES) != hipSuccess) { fprintf(stderr, "kernel_launch: hipFuncSetAttribute failed\n"); grid = -1; return; }
        if (hipOccupancyMaxActiveBlocksPerMultiprocessor(&per_cu, (const void*)mega, NWAVES * 64, LDS_BYTES) != hipSuccess || per_cu < 1) { fprintf(stderr, "kernel_launch: occupancy query says %d blocks per CU\n", per_cu); (void)hipGetLastError(); grid = -1; return; }
        grid = cus;
        if (grid != 256) { fprintf(stderr, "kernel_launch: built for a 256-CU device (got %d CUs)\n", cus); grid = -1; return; }
    }
    if (grid < 0) return;
    (void)hipMemsetAsync((char*)d_ws + WS_CTL, 0, CTL_ZERO_BYTES, stream);
    Args a{};
    for (int i = 0; i < 9; ++i) a.in[i] = (const float*)d_in[i];
    a.out = (float*)d_out; a.ws = (unsigned char*)d_ws;
    unsigned char* ws = (unsigned char*)d_ws;
#if STAGE == 4
    a.ph_lo = 0; a.ph_hi = 5;
    hipLaunchKernelGGL(mega, dim3(grid), dim3(NWAVES * 64), LDS_BYTES, stream, a);
    if (PROBE_PHASE >= 0) { a.ph_lo = PROBE_PHASE; a.ph_hi = PROBE_PHASE + 1; hipLaunchKernelGGL(mega, dim3(grid), dim3(NWAVES * 64), LDS_BYTES, stream, a); }
#else
    const int nper = 5;
    for (int p = 0; p < nper; ++p) { a.ph_lo = p; a.ph_hi = p + 1; hipLaunchKernelGGL(mega, dim3(grid), dim3(NWAVES * 64), LDS_BYTES, stream, a); }
#endif
}
```

```cpp
#include <hip/hip_runtime.h>
#include <cstdio>
#include <cstdint>

#ifndef PROBE_PHASE
#define PROBE_PHASE -1
#endif
#ifndef STAGE
#define STAGE 4
#endif

namespace pg8 {
#define PG8_LAS __attribute__((address_space(3)))
typedef unsigned short bf16_t;
typedef short bf16x8 __attribute__((ext_vector_type(8)));
typedef float f32x4 __attribute__((ext_vector_type(4)));
typedef unsigned u32x4 __attribute__((ext_vector_type(4)));
typedef unsigned u32x2 __attribute__((ext_vector_type(2)));
constexpr int BM = 256, BK = 64, HALF = 128, HTB = HALF * BK * 2, STAGE_BYTES = 8 * HTB, NXCD = 8, WGM = 8;

__host__ __device__ __forceinline__ int lds_byte(int r, int c) { const int st = (r >> 4) * 2 + (c >> 5), rr = r & 15, cc = c & 31, ob = rr * 64 + cc * 2; return st * 1024 + (ob ^ (((ob >> 9) & 1) << 5)); }
__host__ __device__ __forceinline__ void stage_rc(int b, int& R, int& C) { const int st = b / 1024, sb = b % 1024, swz = sb ^ (((sb >> 9) & 1) << 5); R = (st >> 1) * 16 + swz / 64; C = (st & 1) * 32 + (swz % 64) / 2; }

struct Unit { int pm, pn; };
struct Gemm { const bf16_t* A; const bf16_t* Bt; int M, N, K; };

struct StaticOrder {
    int nM, nN, nwg, G, c;
    __host__ __device__ void init(int M, int N, int G_, int c_) { nM = M / BM; nN = N / BM; nwg = nM * nN; G = G_; c = c_; }
    __host__ __device__ bool next(int i, Unit& u) const {
        const long L = (long)i * G + c; if (L >= nwg) return false;
        int wgid = (int)L; { const int q = nwg / NXCD, r = nwg % NXCD, xcd = wgid % NXCD, off = wgid / NXCD; wgid = (xcd < r ? xcd * (q + 1) : r * (q + 1) + (xcd - r) * q) + off; }
        const int nig = WGM * nN, gid = wgid / nig, fm = gid * WGM, gsz = (nM - fm) < WGM ? (nM - fm) : WGM;
        u.pm = fm + ((wgid % nig) % gsz); u.pn = (wgid % nig) / gsz; return true;
    }
};

__device__ __forceinline__ unsigned cvt_pk_bf16(float lo, float hi) { unsigned r; asm volatile("v_cvt_pk_bf16_f32 %0, %1, %2" : "=v"(r) : "v"(lo), "v"(hi)); return r; }
__device__ __forceinline__ float silu_f(float z) { return z * __builtin_amdgcn_rcpf(1.f + __builtin_amdgcn_exp2f(-1.4426950408889634f * z)); }

struct EpiProj {
    static constexpr bool PERM = false, AFTER_DRAIN = false, XPRE = false;
    bf16_t *Y, *QKVZ; float *SBT, *SBG; PG8_LAS unsigned char* xl;
    __device__ __forceinline__ void operator()(const f32x4 (&acc)[2][2][4][2], const Unit& u, int wr, int wc, int fr, int fq) const {
        const int row0 = u.pm * BM + wr * 64 + fr;
        if (u.pn < 8) {
            const int lane = fr + 16 * fq, chl = 16 * wc + 4 * fq, ch0 = 64 * u.pn + chl;
            PG8_LAS float* X = (PG8_LAS float*)xl;
            const PG8_LAS float* CWl = (const PG8_LAS float*)(xl + 2048);
            f32x4 t[2][4], g[2][4];
#pragma unroll
            for (int ai = 0; ai < 2; ++ai)
#pragma unroll
                for (int m = 0; m < 4; ++m) {
                    const f32x4 uu = acc[ai][0][m][0], gb = acc[ai][0][m][1], gc = acc[ai][1][m][0], z = acc[ai][1][m][1];
                    t[ai][m] = gc * uu;
#pragma unroll
                    for (int i = 0; i < 4; ++i) g[ai][m][i] = gb[i] * silu_f(z[i]);
                }
#pragma unroll
            for (int ai = 0; ai < 2; ++ai) { const int grpi = 2 * ai + wr;
                if (fr == 0) *(PG8_LAS f32x4*)(X + (grpi * 2 + 0) * 64 + chl) = t[ai][0];
                if (fr == 15) *(PG8_LAS f32x4*)(X + (grpi * 2 + 1) * 64 + chl) = t[ai][3]; }
            if (wr == 0 && fr < 2) { *(f32x4*)(SBT + ((size_t)(u.pm * 4 + fr) * 512 + ch0)) = t[0][0]; if (fr == 0) *(f32x4*)(SBG + ((size_t)(u.pm * 2 + 0) * 512 + ch0)) = g[0][0]; }
            if (wr == 1 && fr >= 14) { *(f32x4*)(SBT + ((size_t)(u.pm * 4 + fr - 12) * 512 + ch0)) = t[1][3]; if (fr == 15) *(f32x4*)(SBG + ((size_t)(u.pm * 2 + 1) * 512 + ch0)) = g[1][3]; }
            asm volatile("s_waitcnt lgkmcnt(0)" ::: "memory"); __builtin_amdgcn_s_barrier(); asm volatile("" ::: "memory");
            const f32x4 w0 = *(const PG8_LAS f32x4*)(CWl + ch0), w1 = *(const PG8_LAS f32x4*)(CWl + 512 + ch0), w2 = *(const PG8_LAS f32x4*)(CWl + 1024 + ch0), cb = *(const PG8_LAS f32x4*)(CWl + 1536 + ch0);
#pragma unroll
            for (int ai = 0; ai < 2; ++ai) { const int grpi = 2 * ai + wr;
                const f32x4 xprev = *(const PG8_LAS f32x4*)(X + (((grpi + 3) & 3) * 2 + 1) * 64 + chl), xnext = *(const PG8_LAS f32x4*)(X + (((grpi + 1) & 3) * 2 + 0) * 64 + chl);
#pragma unroll
                for (int m = 0; m < 4; ++m) {
                    const f32x4 ps = m > 0 ? t[ai][m - 1] : xprev, ns = m < 3 ? t[ai][m + 1] : xnext, tc = t[ai][m];
                    f32x4 tp, tn;
#pragma unroll
                    for (int i = 0; i < 4; ++i) {
                        tp[i] = __builtin_bit_cast(float, __builtin_amdgcn_update_dpp(0, __builtin_bit_cast(int, fr == 15 ? ps[i] : tc[i]), 0x121, 0xf, 0xf, false));
                        tn[i] = __builtin_bit_cast(float, __builtin_amdgcn_update_dpp(0, __builtin_bit_cast(int, fr == 0 ? ns[i] : tc[i]), 0x12F, 0xf, 0xf, false)); }
                    const f32x4 y = g[ai][m] * (w0 * tp + w1 * tc + w2 * tn + cb);
                    const int rt = 128 * ai + 64 * wr + 16 * m + fr;
                    u32x2 yw; yw.x = cvt_pk_bf16(y[0], y[1]); yw.y = cvt_pk_bf16(y[2], y[3]);
                    if (rt != 0 && rt != 255) *(u32x2*)(Y + (size_t)(u.pm * BM + rt) * 1024 + ch0) = yw;
                }
            }
        } else {
            const int grp = (u.pn - 8) >> 1, head = 4 * ((u.pn - 8) & 1) + wc;
            bf16_t* dst = QKVZ + (size_t)grp * (size_t)(16u << 20);
            const int col0 = head * 64 + 8 * fq;
            f32x4 wv[2][2];
            if (grp < 2) { const PG8_LAS float* w = (const PG8_LAS float*)(xl + 10240) + 64 * grp;
#pragma unroll
                for (int bj = 0; bj < 2; ++bj)
#pragma unroll
                    for (int n = 0; n < 2; ++n) wv[bj][n] = *(const PG8_LAS f32x4*)(w + 32 * bj + 8 * fq + 4 * n); }
            const float sc = grp == 0 ? 0.125f * 1.4426950408889634f : 1.f;
#pragma unroll
            for (int ai = 0; ai < 2; ++ai)
#pragma unroll
                for (int m = 0; m < 4; ++m) {
                    f32x4 v[2][2];
#pragma unroll
                    for (int bj = 0; bj < 2; ++bj)
#pragma unroll
                        for (int n = 0; n < 2; ++n) v[bj][n] = acc[ai][bj][m][n];
                    if (grp < 2) {
                        float ss = 0.f;
#pragma unroll
                        for (int bj = 0; bj < 2; ++bj)
#pragma unroll
                            for (int n = 0; n < 2; ++n) ss += (v[bj][n][0] * v[bj][n][0] + v[bj][n][1] * v[bj][n][1]) + (v[bj][n][2] * v[bj][n][2] + v[bj][n][3] * v[bj][n][3]);
                        ss += __shfl_xor(ss, 16); ss += __shfl_xor(ss, 32);
                        const float rs = __builtin_amdgcn_rsqf(ss * (1.f / 64.f) + 1e-6f) * sc;
#pragma unroll
                        for (int bj = 0; bj < 2; ++bj)
#pragma unroll
                            for (int n = 0; n < 2; ++n) v[bj][n] = v[bj][n] * rs * wv[bj][n];
                    }
                    bf16_t* rowp = dst + (size_t)(row0 + ai * HALF + m * 16) * 512 + col0;
#pragma unroll
                    for (int bj = 0; bj < 2; ++bj) { u32x4 w; w.x = cvt_pk_bf16(v[bj][0][0], v[bj][0][1]); w.y = cvt_pk_bf16(v[bj][0][2], v[bj][0][3]); w.z = cvt_pk_bf16(v[bj][1][0], v[bj][1][1]); w.w = cvt_pk_bf16(v[bj][1][2], v[bj][1][3]);
                        *(u32x4*)(rowp + 32 * bj) = w; }
                }
        }
    }
};
struct EpiRes {
    static constexpr bool PERM = false, AFTER_DRAIN = false, XPRE = true;
    const float* X; float* O; int ldc;
    __device__ __forceinline__ void xissue(const Unit& u, int it, int wr, int wc, int fr, int fq, f32x4 (&xv)[4]) const {
        const int ai = it >> 2, bj = (it >> 1) & 1, m0 = 2 * (it & 1);
        const float* ba = X + ((size_t)(u.pm * BM + ai * HALF + m0 * 16) * ldc + u.pn * BM + bj * HALF);
        const float* bb = ba + (size_t)16 * ldc;
        const unsigned voff = (unsigned)(((wr * 64 + fr) * ldc + wc * 32 + 4 * fq) * 4);
        asm volatile("global_load_dwordx4 %0, %4, %5\n\tglobal_load_dwordx4 %1, %4, %5 offset:64\n\tglobal_load_dwordx4 %2, %4, %6\n\tglobal_load_dwordx4 %3, %4, %6 offset:64"
                     : "=&v"(xv[0]), "=&v"(xv[1]), "=&v"(xv[2]), "=&v"(xv[3]) : "v"(voff), "s"(ba), "s"(bb) : "memory");
    }
    __device__ __forceinline__ void xadd(f32x4 (&acc)[2][2][4][2], int it, f32x4 (&xv)[4]) const {
        asm volatile("" : "+v"(xv[0]), "+v"(xv[1]), "+v"(xv[2]), "+v"(xv[3]));
#define XA(AI, BJ, M0) do { acc[AI][BJ][M0][0] += xv[0]; acc[AI][BJ][M0][1] += xv[1]; acc[AI][BJ][M0 + 1][0] += xv[2]; acc[AI][BJ][M0 + 1][1] += xv[3]; } while (0)
        switch (it) { case 0: XA(0, 0, 0); break; case 1: XA(0, 0, 2); break; case 2: XA(0, 1, 0); break; case 3: XA(0, 1, 2); break;
                      case 4: XA(1, 0, 0); break; case 5: XA(1, 0, 2); break; case 6: XA(1, 1, 0); break; default: XA(1, 1, 2); break; }
#undef XA
    }
    __device__ __forceinline__ void operator()(const f32x4 (&acc)[2][2][4][2], const Unit& u, int wr, int wc, int fr, int fq) const {
        const int row0 = u.pm * BM + wr * 64 + fr, col0 = u.pn * BM + wc * 32 + 4 * fq;
#pragma unroll
        for (int ai = 0; ai < 2; ++ai)
#pragma unroll
            for (int m = 0; m < 4; ++m) { const size_t off = (size_t)(row0 + ai * HALF + m * 16) * ldc + col0;
#pragma unroll
                for (int bj = 0; bj < 2; ++bj)
#pragma unroll
                    for (int n = 0; n < 2; ++n) *(f32x4*)(O + off + bj * HALF + n * 16) = acc[ai][bj][m][n]; }
    }
};

template <class Epi, class Sched, bool ALIGN_EPI = false, bool SP2 = false>
__device__ __forceinline__ void gemm_phase(PG8_LAS unsigned char* lds, const Gemm g, const Sched& S, const Epi& E) {
    const int tid = threadIdx.x, wid = __builtin_amdgcn_readfirstlane(tid >> 6), lane = tid & 63, wr = wid >> 2, wc = wid & 3, fr = lane & 15, fq = lane >> 4;
    const int K = g.K, nt = K / BK;
    unsigned voffA[2], voffB[2];
#pragma unroll
    for (int i = 0; i < 2; ++i) { int R, C; stage_rc(tid * 16 + i * 8192, R, C);
        voffA[i] = (unsigned)(R * K + C) * 2u; voffB[i] = (unsigned)(R * K + C) * 2u; }
    const size_t kstep = (size_t)(BK * 2);
    const size_t hstep = (size_t)HALF * K * 2;
    const size_t tstep = 2 * hstep;
    const unsigned ldsw = (unsigned)wid * 1024u;
    const int aoff = lds_byte(wr * 64 + fr, fq * 8), boff = lds_byte(wc * 32 + fr, fq * 8);
#define PG8_SA(b, h) (((b) * 2 + (h)) * HTB)
#define PG8_SB(b, h) ((4 + (b) * 2 + (h)) * HTB)
#define PG8_STAGE(bufoff, gbase, voff) do { _Pragma("unroll") for (int _i = 0; _i < 2; ++_i) \
        __builtin_amdgcn_global_load_lds((const unsigned*)((const char*)(gbase) + (voff)[_i]), (PG8_LAS unsigned*)(lds + (bufoff) + ldsw + _i * 8192), 16, 0, 0); } while (0)
#define PG8_LDA(dst, b, h) do { _Pragma("unroll") for (int m = 0; m < 4; ++m) _Pragma("unroll") for (int k = 0; k < 2; ++k) dst[m][k] = *(const PG8_LAS bf16x8*)(lds + PG8_SA(b, h) + aoff + m * 2048 + k * 1024); } while (0)
#define PG8_LDB(dst, b, h) do { _Pragma("unroll") for (int n = 0; n < 2; ++n) _Pragma("unroll") for (int k = 0; k < 2; ++k) dst[n][k] = *(const PG8_LAS bf16x8*)(lds + PG8_SB(b, h) + boff + n * 2048 + k * 1024); } while (0)
#define PG8_MMA(ai, bj, At, Bt) do { __builtin_amdgcn_s_setprio(1); _Pragma("unroll") for (int m = 0; m < 4; ++m) _Pragma("unroll") for (int n = 0; n < 2; ++n) _Pragma("unroll") for (int k = 0; k < 2; ++k) \
        acc[ai][bj][m][n] = __builtin_amdgcn_mfma_f32_16x16x32_bf16(Bt[n][k], At[m][k], acc[ai][bj][m][n], 0, 0, 0); __builtin_amdgcn_s_setprio(0); } while (0)
#define PG8_WAIT_V(n) asm volatile("s_waitcnt vmcnt(" #n ")" ::: "memory")
#define PG8_WAIT_L(n) asm volatile("s_waitcnt lgkmcnt(" #n ")" ::: "memory")
#define PG8_BAR __builtin_amdgcn_s_barrier()
#define PG8_SCHED __builtin_amdgcn_sched_barrier(0)
    Unit cur, nxt; int ui = 0;
    if (!S.next(0, cur)) return;
    f32x4 acc[2][2][4][2];
#pragma unroll
    for (int a = 0; a < 2; ++a)
#pragma unroll
        for (int b = 0; b < 2; ++b)
#pragma unroll
            for (int m = 0; m < 4; ++m)
#pragma unroll
                for (int n = 0; n < 2; ++n) acc[a][b][m][n] = (f32x4){0.f, 0.f, 0.f, 0.f};
    bf16x8 At[4][2], B0[2][2], B1[2][2]; f32x4 xv[4];
    const char* cA = (const char*)g.A + (size_t)cur.pm * tstep; const char* cB = (const char*)g.Bt + (size_t)cur.pn * tstep;
    if constexpr (SP2) {
        PG8_STAGE(PG8_SB(0, 0), cB, voffB); PG8_STAGE(PG8_SB(0, 1), cB + hstep, voffB); PG8_STAGE(PG8_SA(0, 0), cA, voffA); PG8_STAGE(PG8_SA(0, 1), cA + hstep, voffA);
        if (wr == 1) PG8_BAR;
        PG8_WAIT_V(2); PG8_BAR;
        PG8_STAGE(PG8_SB(1, 0), cB + kstep, voffB); PG8_STAGE(PG8_SA(1, 0), cA + kstep, voffA); PG8_STAGE(PG8_SB(1, 1), cB + hstep + kstep, voffB);
        PG8_WAIT_V(6); PG8_BAR;
    } else {
        PG8_STAGE(PG8_SB(0, 0), cB, voffB); PG8_STAGE(PG8_SA(0, 0), cA, voffA); PG8_STAGE(PG8_SB(0, 1), cB + hstep, voffB); PG8_STAGE(PG8_SA(0, 1), cA + hstep, voffA);
        if (wr == 1) PG8_BAR;
        PG8_WAIT_V(4); PG8_BAR;
        PG8_STAGE(PG8_SB(1, 0), cB + kstep, voffB); PG8_STAGE(PG8_SA(1, 0), cA + kstep, voffA); PG8_STAGE(PG8_SB(1, 1), cB + hstep + kstep, voffB);
        PG8_WAIT_V(6); PG8_BAR;
    }
    for (;;) {
        const bool has_next = S.next(ui + 1, nxt);
        const char* nA = has_next ? (const char*)g.A + (size_t)nxt.pm * tstep : cA; const char* nB = has_next ? (const char*)g.Bt + (size_t)nxt.pn * tstep : cB;
        if constexpr (Epi::XPRE) {
#pragma unroll
        for (int t = 0; t < 16; t += 2) {
            const bool last = (t == nt - 2);
            const char* a1 = cA + (size_t)(t + 1) * kstep;
            const char* a2 = last ? nA : cA + (size_t)(t + 2) * kstep; const char* b2 = last ? nB : cB + (size_t)(t + 2) * kstep;
            const char* a3 = a2 + kstep; const char* b3 = b2 + kstep;
            if constexpr (SP2) {
            if constexpr (Epi::XPRE) E.xissue(cur, t >> 1, wr, wc, fr, fq, xv);
            PG8_LDB(B0, 0, 0); PG8_LDB(B1, 0, 1); PG8_SCHED; PG8_LDA(At, 0, 0); PG8_STAGE(PG8_SA(1, 1), a1 + hstep, voffA);
            if constexpr (Epi::XPRE) PG8_WAIT_V(12); else PG8_WAIT_V(8);
            PG8_WAIT_L(0); PG8_BAR; PG8_MMA(0, 0, At, B0); PG8_MMA(0, 1, At, B1); PG8_BAR; PG8_SCHED;
            PG8_LDA(At, 0, 1); PG8_STAGE(PG8_SB(0, 0), b2, voffB); PG8_STAGE(PG8_SB(0, 1), b2 + hstep, voffB); PG8_STAGE(PG8_SA(0, 0), a2, voffA);
            if constexpr (Epi::XPRE) PG8_WAIT_V(12); else PG8_WAIT_V(8);
            PG8_WAIT_L(0); PG8_BAR; PG8_MMA(1, 0, At, B0); PG8_MMA(1, 1, At, B1); PG8_BAR; PG8_SCHED;
            PG8_LDB(B0, 1, 0); PG8_LDB(B1, 1, 1); PG8_SCHED; PG8_LDA(At, 1, 0); PG8_STAGE(PG8_SA(0, 1), a2 + hstep, voffA);
            PG8_WAIT_V(8); PG8_WAIT_L(0); PG8_BAR;
            if constexpr (Epi::XPRE) E.xadd(acc, t >> 1, xv);
            PG8_MMA(0, 0, At, B0); PG8_MMA(0, 1, At, B1); PG8_BAR; PG8_SCHED;
            PG8_LDA(At, 1, 1); PG8_STAGE(PG8_SB(1, 0), b3, voffB); PG8_STAGE(PG8_SB(1, 1), b3 + hstep, voffB); PG8_STAGE(PG8_SA(1, 0), a3, voffA);
            PG8_WAIT_V(8); PG8_WAIT_L(0); PG8_BAR; PG8_MMA(1, 0, At, B0); PG8_MMA(1, 1, At, B1); PG8_BAR; PG8_SCHED;
            } else {
            PG8_LDB(B0, 0, 0); PG8_SCHED; PG8_LDA(At, 0, 0); PG8_STAGE(PG8_SA(1, 1), a1 + hstep, voffA);
            PG8_WAIT_L(8); PG8_BAR; PG8_WAIT_L(0); PG8_MMA(0, 0, At, B0); PG8_BAR; PG8_SCHED;
            PG8_LDB(B1, 0, 1); PG8_STAGE(PG8_SB(0, 0), b2, voffB);
            PG8_BAR; PG8_WAIT_L(0); PG8_MMA(0, 1, At, B1); PG8_BAR;
            PG8_LDA(At, 0, 1); PG8_STAGE(PG8_SA(0, 0), a2, voffA);
            PG8_BAR; PG8_WAIT_L(0); PG8_MMA(1, 0, At, B0); PG8_BAR; PG8_SCHED;
            PG8_STAGE(PG8_SB(0, 1), b2 + hstep, voffB);
            PG8_WAIT_V(6); PG8_BAR; PG8_MMA(1, 1, At, B1); PG8_BAR;
            PG8_LDB(B0, 1, 0); PG8_SCHED; PG8_LDA(At, 1, 0); PG8_STAGE(PG8_SA(0, 1), a2 + hstep, voffA);
            PG8_WAIT_L(8); PG8_BAR; PG8_WAIT_L(0); PG8_MMA(0, 0, At, B0); PG8_BAR; PG8_SCHED;
            PG8_LDB(B1, 1, 1); PG8_STAGE(PG8_SB(1, 0), b3, voffB);
            PG8_BAR; PG8_WAIT_L(0); PG8_MMA(0, 1, At, B1); PG8_BAR;
            PG8_LDA(At, 1, 1); PG8_STAGE(PG8_SA(1, 0), a3, voffA);
            PG8_BAR; PG8_WAIT_L(0); PG8_MMA(1, 0, At, B0); PG8_BAR; PG8_SCHED;
            PG8_STAGE(PG8_SB(1, 1), b3 + hstep, voffB);
            PG8_WAIT_V(6); PG8_BAR; PG8_MMA(1, 1, At, B1); PG8_BAR;
            }
                }
        } else {
        for (int t = 0; t < nt; t += 2) {
            const bool last = (t == nt - 2);
            const char* a1 = cA + (size_t)(t + 1) * kstep;
            const char* a2 = last ? nA : cA + (size_t)(t + 2) * kstep; const char* b2 = last ? nB : cB + (size_t)(t + 2) * kstep;
            const char* a3 = a2 + kstep; const char* b3 = b2 + kstep;
            if constexpr (SP2) {
            if constexpr (Epi::XPRE) E.xissue(cur, t >> 1, wr, wc, fr, fq, xv);
            PG8_LDB(B0, 0, 0); PG8_LDB(B1, 0, 1); PG8_SCHED; PG8_LDA(At, 0, 0); PG8_STAGE(PG8_SA(1, 1), a1 + hstep, voffA);
            if constexpr (Epi::XPRE) PG8_WAIT_V(12); else PG8_WAIT_V(8);
            PG8_WAIT_L(0); PG8_BAR; PG8_MMA(0, 0, At, B0); PG8_MMA(0, 1, At, B1); PG8_BAR; PG8_SCHED;
            PG8_LDA(At, 0, 1); PG8_STAGE(PG8_SB(0, 0), b2, voffB); PG8_STAGE(PG8_SB(0, 1), b2 + hstep, voffB); PG8_STAGE(PG8_SA(0, 0), a2, voffA);
            if constexpr (Epi::XPRE) PG8_WAIT_V(12); else PG8_WAIT_V(8);
            PG8_WAIT_L(0); PG8_BAR; PG8_MMA(1, 0, At, B0); PG8_MMA(1, 1, At, B1); PG8_BAR; PG8_SCHED;
            PG8_LDB(B0, 1, 0); PG8_LDB(B1, 1, 1); PG8_SCHED; PG8_LDA(At, 1, 0); PG8_STAGE(PG8_SA(0, 1), a2 + hstep, voffA);
            PG8_WAIT_V(8); PG8_WAIT_L(0); PG8_BAR;
            if constexpr (Epi::XPRE) E.xadd(acc, t >> 1, xv);
            PG8_MMA(0, 0, At, B0); PG8_MMA(0, 1, At, B1); PG8_BAR; PG8_SCHED;
            PG8_LDA(At, 1, 1); PG8_STAGE(PG8_SB(1, 0), b3, voffB); PG8_STAGE(PG8_SB(1, 1), b3 + hstep, voffB); PG8_STAGE(PG8_SA(1, 0), a3, voffA);
            PG8_WAIT_V(8); PG8_WAIT_L(0); PG8_BAR; PG8_MMA(1, 0, At, B0); PG8_MMA(1, 1, At, B1); PG8_BAR; PG8_SCHED;
            } else {
            PG8_LDB(B0, 0, 0); PG8_SCHED; PG8_LDA(At, 0, 0); PG8_STAGE(PG8_SA(1, 1), a1 + hstep, voffA);
            PG8_WAIT_L(8); PG8_BAR; PG8_WAIT_L(0); PG8_MMA(0, 0, At, B0); PG8_BAR; PG8_SCHED;
            PG8_LDB(B1, 0, 1); PG8_STAGE(PG8_SB(0, 0), b2, voffB);
            PG8_BAR; PG8_WAIT_L(0); PG8_MMA(0, 1, At, B1); PG8_BAR;
            PG8_LDA(At, 0, 1); PG8_STAGE(PG8_SA(0, 0), a2, voffA);
            PG8_BAR; PG8_WAIT_L(0); PG8_MMA(1, 0, At, B0); PG8_BAR; PG8_SCHED;
            PG8_STAGE(PG8_SB(0, 1), b2 + hstep, voffB);
            PG8_WAIT_V(6); PG8_BAR; PG8_MMA(1, 1, At, B1); PG8_BAR;
            PG8_LDB(B0, 1, 0); PG8_SCHED; PG8_LDA(At, 1, 0); PG8_STAGE(PG8_SA(0, 1), a2 + hstep, voffA);
            PG8_WAIT_L(8); PG8_BAR; PG8_WAIT_L(0); PG8_MMA(0, 0, At, B0); PG8_BAR; PG8_SCHED;
            PG8_LDB(B1, 1, 1); PG8_STAGE(PG8_SB(1, 0), b3, voffB);
            PG8_BAR; PG8_WAIT_L(0); PG8_MMA(0, 1, At, B1); PG8_BAR;
            PG8_LDA(At, 1, 1); PG8_STAGE(PG8_SA(1, 0), a3, voffA);
            PG8_BAR; PG8_WAIT_L(0); PG8_MMA(1, 0, At, B0); PG8_BAR; PG8_SCHED;
            PG8_STAGE(PG8_SB(1, 1), b3 + hstep, voffB);
            PG8_WAIT_V(6); PG8_BAR; PG8_MMA(1, 1, At, B1); PG8_BAR;
            }
                }
        }
        if constexpr (ALIGN_EPI) { if (wr == 0) PG8_BAR; }
        E(acc, cur, wr, wc, fr, fq);
        if (!has_next) break;
#pragma unroll
        for (int a = 0; a < 2; ++a)
#pragma unroll
            for (int b = 0; b < 2; ++b)
#pragma unroll
                for (int m = 0; m < 4; ++m)
#pragma unroll
                    for (int n = 0; n < 2; ++n) acc[a][b][m][n] = (f32x4){0.f, 0.f, 0.f, 0.f};
        cur = nxt; cA = nA; cB = nB; ++ui;
        if constexpr (ALIGN_EPI) { if (wr == 1) PG8_BAR; }
    }
    PG8_WAIT_V(0);
    if constexpr (!ALIGN_EPI) { if (wr == 0) PG8_BAR; }
    PG8_BAR;
#undef PG8_SA
#undef PG8_SB
#undef PG8_STAGE
#undef PG8_LDA
#undef PG8_LDB
#undef PG8_MMA
#undef PG8_WAIT_V
#undef PG8_WAIT_L
#undef PG8_BAR
#undef PG8_SCHED
}
}

constexpr int D_MODEL = 1024, BATCH = 2, SEQ = 16384, M = BATCH * SEQ, NPROJ = 4096, AW = 512, NHEAD = 8;
constexpr int NWAVES = 8;
constexpr size_t MiB = 1u << 20;
constexpr size_t WS_CTL = 0, CTL_ZERO_BYTES = 32768;
constexpr size_t WS_TBG = 1 * MiB;
constexpr size_t WS_WIN = 2 * MiB;
constexpr size_t WS_WOUT = 10 * MiB;
constexpr size_t WS_LP4 = 12 * MiB, WS_LP16 = 13 * MiB;
constexpr size_t WS_XN = 16 * MiB;
constexpr size_t WS_SBT = 80 * MiB, WS_SBG = 82 * MiB;
constexpr size_t WS_Q = 144 * MiB, WS_K = 176 * MiB, WS_V = 208 * MiB, WS_ZG = 240 * MiB;
constexpr size_t WS_OP4 = 272 * MiB, WS_OP16 = 304 * MiB;
constexpr size_t WS_Y = 336 * MiB;
constexpr size_t WS_END = 400 * MiB;
constexpr int CW_BAR = 4096;

constexpr int RING_OFF = 0, RING_BYTES = 131072;
constexpr int LDSCTL_OFF = 146432, MISC_OFF = LDSCTL_OFF + 320;
constexpr int LDS_BYTES = 147456;
constexpr int XL_OFF = 131072;
static_assert(XL_OFF + 10752 <= LDSCTL_OFF, "LDS map");

#define GAS __attribute__((address_space(1)))
#define LAS __attribute__((address_space(3)))
typedef unsigned short bf16;
typedef unsigned v4u __attribute__((ext_vector_type(4)));
typedef float f32x4 __attribute__((ext_vector_type(4)));
typedef float f32x16 __attribute__((ext_vector_type(16)));
typedef short bf16x8 __attribute__((ext_vector_type(8)));
typedef short s16x4 __attribute__((ext_vector_type(4)));
typedef GAS unsigned gu32;
#define RLX_AGENT __ATOMIC_RELAXED, __HIP_MEMORY_SCOPE_AGENT
#define LDS_WAIT() asm volatile("s_waitcnt lgkmcnt(0)" ::: "memory")
__device__ __forceinline__ unsigned f2bf(float f) { unsigned u = __builtin_bit_cast(unsigned, f); return (u + 0x7fffu + ((u >> 16) & 1u)) >> 16; }
__device__ __forceinline__ unsigned pk2(float lo, float hi) { return f2bf(lo) | (f2bf(hi) << 16); }
__device__ __forceinline__ float bf2f(unsigned short b) { return __builtin_bit_cast(float, (unsigned)b << 16); }
__device__ __forceinline__ float bflo(unsigned w) { return __builtin_bit_cast(float, w << 16); }
__device__ __forceinline__ float bfhi(unsigned w) { return __builtin_bit_cast(float, w & 0xffff0000u); }

#define XB_TMO      128
#define XB_XCNT(j)  (256  + 64 * (j))
#define XB_XSUB(j)  (1280 + 64 * (j))
#define XB_XGEN(j)  (2304 + 64 * (j))
#define XB_TOP      3328
#define XB_TOPGEN   3392
#define XCD_BAR_WORDS 3456
#define XB_SPIN_CAP (1u << 18)
__device__ __forceinline__ unsigned xb_ld(unsigned* p)              { return __hip_atomic_load(p, __ATOMIC_RELAXED, __HIP_MEMORY_SCOPE_AGENT); }
__device__ __forceinline__ unsigned xb_add(unsigned* p, unsigned v) { return __hip_atomic_fetch_add(p, v, __ATOMIC_RELAXED, __HIP_MEMORY_SCOPE_AGENT); }
__device__ __forceinline__ unsigned xb_xcc_id() { return (unsigned)__builtin_amdgcn_s_getreg((3 << 11) | 20) & 0xFu; }
#define XB_SPIN(cond, bar) do { unsigned _sp = 0; while (cond) { __builtin_amdgcn_s_sleep(1); \
    if ((++_sp & 255u) == 0u) { if (xb_ld(&(bar)[XB_TMO])) break; if (_sp > XB_SPIN_CAP) { atomicAdd(&(bar)[XB_TMO], 1u); break; } } } } while (0)
struct XcdBarrier { unsigned* bar; unsigned x; volatile LAS unsigned* st; };
__device__ __forceinline__ XcdBarrier xcd_barrier_post(unsigned* bar, volatile LAS unsigned* st) {
    XcdBarrier b; b.bar = bar; b.x = xb_xcc_id(); b.st = st;
    if (threadIdx.x == 0) (void)xb_add(&bar[XB_XCNT(b.x)], 1u);
    return b;
}
__device__ __forceinline__ void xcd_barrier_complete(unsigned* bar, unsigned x, unsigned& nloc, unsigned& nx) {
    const unsigned G = gridDim.x * gridDim.y * gridDim.z;
    unsigned sum, cnt, mine, sp = 0u;
    for (;;) {
        sum = 0u; cnt = 0u; mine = 0u;
#pragma unroll
        for (unsigned j = 0; j < 16; ++j) { const unsigned c = xb_ld(&bar[XB_XCNT(j)]); sum += c; cnt += (c > 0u) ? 1u : 0u; mine = (j == x) ? c : mine; }
        if (sum == G) break;
        __builtin_amdgcn_s_sleep(1);
        if ((++sp & 255u) == 0u) { if (xb_ld(&bar[XB_TMO])) break; if (sp > XB_SPIN_CAP) { atomicAdd(&bar[XB_TMO], 1u); break; } }
    }
    nloc = mine > 0u ? mine : 1u; nx = cnt > 0u ? cnt : 1u;
}
__device__ __forceinline__ void xcd_barrier(const XcdBarrier& b) {
    asm volatile("s_waitcnt vmcnt(0)" ::: "memory");
    __syncthreads();
    if (threadIdx.x == 0) {
        unsigned* bar = b.bar;
        __builtin_amdgcn_s_waitcnt(0);
        unsigned nloc = b.st[0], nx = b.st[1];
        if (nloc == 0u) { xcd_barrier_complete(bar, b.x, nloc, nx); b.st[0] = nloc; b.st[1] = nx; }
        const unsigned old = xb_add(&bar[XB_XSUB(b.x)], 1u);
        const unsigned gen = old / nloc;
        if (old + 1u == (gen + 1u) * nloc) {
            __builtin_amdgcn_fence(__ATOMIC_RELEASE, "agent");
            asm volatile("s_waitcnt vmcnt(0)" ::: "memory");
            const unsigned og = xb_add(&bar[XB_TOP], 1u);
            const unsigned tg = og / nx;
            if (og + 1u == (tg + 1u) * nx) xb_add(&bar[XB_TOPGEN], 1u);
            else XB_SPIN(xb_ld(&bar[XB_TOPGEN]) == tg, bar);
            __builtin_amdgcn_fence(__ATOMIC_ACQUIRE, "agent");
            xb_add(&bar[XB_XGEN(b.x)], 1u);
            asm volatile("s_waitcnt vmcnt(0)" ::: "memory");
        } else {
            XB_SPIN(xb_ld(&bar[XB_XGEN(b.x)]) == gen, bar);
            __builtin_amdgcn_fence(__ATOMIC_ACQUIRE, "agent");
            asm volatile("s_waitcnt vmcnt(0)" ::: "memory");
        }
    }
    __syncthreads();
}

struct Frame {
    LAS unsigned char* lds;
    volatile LAS unsigned* MISC;
    gu32* ctl;
    int tid, lane, wave, vcu, G;
    const float *x, *norm_w, *w_in, *conv_w, *conv_b, *qw, *kw, *rel_bias, *w_out; float* out;
    bf16 *WinT, *WoutT, *XN, *Q, *K, *V, *ZG, *OP4, *OP16, *Y;
    float *TBG, *LP4, *LP16, *SBT, *SBG;
};
__device__ __forceinline__ float wave_sum(float v) {
#pragma unroll
    for (int o = 1; o < 64; o <<= 1) v += __shfl_xor(v, o);
    return v;
}
__device__ __forceinline__ float wave_max(float v) {
#pragma unroll
    for (int o = 1; o < 64; o <<= 1) v = fmaxf(v, __shfl_xor(v, o));
    return v;
}
__device__ __forceinline__ int win_row(int L) {
    int pn, wc, bj, n, fq, reg;
    if (L < 2048) { const int which = L >> 9, ch = L & 511; pn = ch >> 6; wc = (ch >> 4) & 3; fq = (ch >> 2) & 3; reg = ch & 3; bj = which >> 1; n = which & 1; }
    else { const int Lp = L - 2048, grp = Lp >> 9, head = (Lp >> 6) & 7, e = Lp & 63; pn = 8 + 2 * grp + (head >> 2); wc = head & 3; bj = e >> 5; fq = (e >> 3) & 3; n = (e >> 2) & 1; reg = e & 3; }
    return pn * 256 + 128 * bj + 32 * wc + 16 * n + 4 * fq + reg;
}
template <bool PERMUTE>
__device__ __forceinline__ void p0_transpose_item(const float* W, int K, int N, bf16* WT, LAS float* scr, int item, int lane) {
    const int nblk = N / 32, kb = item / nblk, nb = item % nblk, k0 = 64 * kb, n0 = 32 * nb;
#pragma unroll 8
    for (int i = 0; i < 32; ++i) { const int kk = 2 * i + (lane >> 5); scr[kk * 33 + (lane & 31)] = W[(size_t)(k0 + kk) * N + n0 + (lane & 31)]; }
    LDS_WAIT(); asm volatile("" ::: "memory");
    const int c = lane & 7;
#pragma unroll
    for (int j = 0; j < 4; ++j) { const int n = (lane >> 3) + 8 * j; const LAS float* s = scr + (8 * c) * 33 + n;
        v4u o; o.x = pk2(s[0 * 33], s[1 * 33]); o.y = pk2(s[2 * 33], s[3 * 33]); o.z = pk2(s[4 * 33], s[5 * 33]); o.w = pk2(s[6 * 33], s[7 * 33]);
        const int dr = PERMUTE ? win_row(n0 + n) : (n0 + n);
        *(GAS v4u*)(WT + (size_t)dr * K + k0 + 8 * c) = o; }
    LDS_WAIT(); asm volatile("" ::: "memory");
}
__device__ __forceinline__ int t5_bucket(int rel) {
    const int n = rel < 0 ? -rel : rel; int b = rel > 0 ? 16 : 0;
    if (n < 8) return b + n;
    int large = 8 + (int)(logf((float)n / 8.f) / logf(128.f) * 8.f);
    if (large > 15) large = 15;
    return b + large;
}
__device__ __forceinline__ void p0_prologue(Frame& F) {
    LAS float* scr = (LAS float*)(F.lds + RING_OFF + F.wave * 16384);
    const int gw = F.vcu * NWAVES + F.wave, NGW = F.G * NWAVES;
    constexpr int I_IN = (D_MODEL / 64) * (NPROJ / 32), I_OUT = (D_MODEL / 64) * (D_MODEL / 32);
    for (int it = gw; it < I_IN + I_OUT; it += NGW) {
        if (it < I_IN) p0_transpose_item<true>(F.w_in, D_MODEL, NPROJ, F.WinT, scr, it, F.lane);
        else p0_transpose_item<false>(F.w_out, D_MODEL, D_MODEL, F.WoutT, scr, it - I_IN, F.lane);
    }
    f32x4 nw[4];
#pragma unroll
    for (int j = 0; j < 4; ++j) nw[j] = ((const f32x4*)F.norm_w)[F.lane + 64 * j];
    for (int m = gw; m < M; m += NGW) {
        const GAS f32x4* xr = (const GAS f32x4*)(F.x + (size_t)m * D_MODEL) + F.lane;
        f32x4 v[4]; float s = 0.f;
#pragma unroll
        for (int j = 0; j < 4; ++j) { v[j] = xr[64 * j]; s += (v[j].x * v[j].x + v[j].y * v[j].y) + (v[j].z * v[j].z + v[j].w * v[j].w); }
        const float rstd = 1.f / sqrtf(wave_sum(s) * (1.f / D_MODEL) + 1e-6f);
        GAS unsigned long long* o8 = (GAS unsigned long long*)(F.XN + (size_t)m * D_MODEL) + F.lane;
#pragma unroll
        for (int j = 0; j < 4; ++j) { const f32x4 y = v[j] * rstd * nw[j]; o8[64 * j] = (unsigned long long)pk2(y.x, y.y) | ((unsigned long long)pk2(y.z, y.w) << 32); }
    }
    if (blockIdx.x == 0) {
        const float mq = wave_max(fabsf(F.qw[F.lane])), mk = wave_max(fabsf(F.kw[F.lane]));
        float mb = 0.f;
#pragma unroll
        for (int j = 0; j < 4; ++j) mb = fmaxf(mb, fabsf(F.rel_bias[F.lane + 64 * j]));
        mb = wave_max(mb);
        const float M2 = (8.f * mq * mk + mb) * 1.4426950408889634f;
        for (int i = F.tid; i < 3 * 8 * 192; i += NWAVES * 64) {
            const int jp = i % 192, h = (i / 192) & 7, c = i / (192 * 8), j = jp - 32;
            const int dil = c == 0 ? 1 : (c == 1 ? 4 : 16);
            float v = -1e30f;
            if (j >= 0 && j <= 128) v = F.rel_bias[t5_bucket((j - 64) * dil) * 8 + h] * 1.4426950408889634f - M2;
            F.TBG[i] = v;
        }
    }
}

__device__ __forceinline__ int crow(int r, int hi) { return (r & 3) + 8 * (r >> 2) + 4 * hi; }
__device__ __forceinline__ unsigned cvtpk_s(float lo, float hi) { typedef float f2 __attribute__((ext_vector_type(2))); typedef __bf16 b2 __attribute__((ext_vector_type(2))); f2 v = {lo, hi}; b2 b = __builtin_convertvector(v, b2); return __builtin_bit_cast(unsigned, b); }
typedef short v4i16_t __attribute__((ext_vector_type(4)));
__device__ __forceinline__ s16x4 vtr(LAS const unsigned char* p) { return __builtin_bit_cast(s16x4, __builtin_amdgcn_ds_read_tr16_b64_v4i16((LAS v4i16_t*)p)); }

constexpr int AT_TILE = 8448, AT_KCH = 528, AT_VOFF = 4224, AT_VPC = 1056, AT_NT = 12;
constexpr int AT_OST = AT_NT * AT_TILE;
constexpr int AT_TBL = AT_OST + NWAVES * 4096;
constexpr int AT_LW = AT_TBL + 768;
static_assert(AT_LW + NWAVES * 128 <= LDSCTL_OFF, "attention LDS map");
struct TaskD { int dil, L, i0, hq, c, h, tok0; };
template <bool FINAL>
__device__ __forceinline__ TaskD unit_decode(int vcu, int i) {
    TaskD D; const int x = vcu >> 5, j = vcu & 31;
    int pair, r, blk;
    if (FINAL) { pair = 2 * x + (i >> 1); r = 0; blk = 2 * j + (i & 1); D.c = 0; D.dil = 1; D.L = SEQ; }
    else { pair = 2 * x + (i >> 2); const int k = i & 3;
        if (j < 16) { D.c = 1; D.dil = 4; D.L = SEQ / 4; r = j >> 2; blk = 4 * (j & 3) + k; } else { D.c = 2; D.dil = 16; D.L = SEQ / 16; r = j - 16; blk = k; } }
    D.h = pair & 7; D.hq = D.h * 64; D.tok0 = (pair >> 3) * SEQ + r; D.i0 = blk * 256;
    return D;
}
#define AT_BAR() do { asm volatile("s_waitcnt lgkmcnt(0)" ::: "memory"); __builtin_amdgcn_s_barrier(); asm volatile("" ::: "memory"); } while (0)
template <bool FINAL>
__device__ __forceinline__ void attn_units(Frame& F) {
    constexpr int u0 = 0, u1 = FINAL ? 4 : 8;
    const int lane = F.lane, w = F.wave, r32 = lane & 31, hi = lane >> 5;
    LAS unsigned char* L0 = F.lds;
    LAS unsigned short* stgb = (LAS unsigned short*)(F.lds + AT_OST + w * 4096);
    LAS float* tbl = (LAS float*)(F.lds + AT_TBL);
    LAS float* lw = (LAS float*)(F.lds + AT_LW) + w * 32;
    const int vaddr = AT_VOFF + ((lane >> 4) & 1) * 32 + (lane & 3) * 8 + (4 * hi + ((lane & 15) >> 2)) * 64;
    const bool isV = w >= 4; const int srow = 8 * (w & 3) + (lane >> 3), sch = lane & 7;
    const int sdst = isV ? (AT_VOFF + (sch >> 2) * (2 * AT_VPC) + (srow >> 4) * AT_VPC + (srow & 15) * 64 + (sch & 3) * 16) : (sch * AT_KCH + srow * 16);
    const bf16* ssrc = isV ? F.V : F.K;
    bf16x8 st[AT_NT], qn[4], qr[4];
#define STAGE_LOAD(D_) do { _Pragma("unroll") for (int t_ = 0; t_ < AT_NT; ++t_) { int key_ = (D_).i0 - 64 + 32 * t_ + srow; key_ = key_ < 0 ? 0 : (key_ > (D_).L - 1 ? (D_).L - 1 : key_); \
        st[t_] = *(const bf16x8*)(ssrc + (unsigned)(((D_).tok0 + (D_).dil * key_) * AW + (D_).hq + sch * 8)); } } while (0)
#define LOADQN(D_) do { const unsigned qo_ = (unsigned)(((D_).tok0 + (D_).dil * ((D_).i0 + 32 * w + r32)) * AW + (D_).hq + hi * 8); \
        _Pragma("unroll") for (int d0 = 0; d0 < 4; ++d0) qn[d0] = *(const bf16x8*)(F.Q + qo_ + d0 * 16); } while (0)
#define CHUNK(kc) do { const LAS unsigned char* tb_ = L0 + (w + (kc)) * AT_TILE; const int k0_ = i0w - 64 + 32 * (kc); \
        f32x16 a_; { const LAS float* tp_ = tbl + (32 + 32 * (kc) + 4 * hi - r32); \
            _Pragma("unroll") for (int rr = 0; rr < 16; ++rr) a_[rr] = tp_[(rr & 3) + 8 * (rr >> 2)]; } \
        if (k0_ < 0 || k0_ + 32 > D.L) { _Pragma("unroll") for (int rr = 0; rr < 16; ++rr) { const int key_ = k0_ + crow(rr, hi); if (key_ < 0 || key_ >= D.L) a_[rr] = -1e30f; } } \
        _Pragma("unroll") for (int d0 = 0; d0 < 4; ++d0) { const bf16x8 kf_ = *(const LAS bf16x8*)(tb_ + (2 * d0 + hi) * AT_KCH + r32 * 16); \
            a_ = __builtin_amdgcn_mfma_f32_32x32x16_bf16(kf_, qr[d0], a_, 0, 0, 0); } \
        _Pragma("unroll") for (int rr = 0; rr < 16; ++rr) { a_[rr] = __builtin_amdgcn_exp2f(a_[rr]); lsum += a_[rr]; } \
        v4u pw0_, pw1_; pw0_.x = cvtpk_s(a_[0], a_[1]); pw0_.y = cvtpk_s(a_[2], a_[3]); pw0_.z = cvtpk_s(a_[4], a_[5]); pw0_.w = cvtpk_s(a_[6], a_[7]); \
        pw1_.x = cvtpk_s(a_[8], a_[9]); pw1_.y = cvtpk_s(a_[10], a_[11]); pw1_.z = cvtpk_s(a_[12], a_[13]); pw1_.w = cvtpk_s(a_[14], a_[15]); \
        const LAS unsigned char* vb_ = tb_ + vaddr; \
        { s16x4 l0 = vtr(vb_), h0 = vtr(vb_ + 512), l1 = vtr(vb_ + AT_VPC), h1 = vtr(vb_ + AT_VPC + 512); \
          o0 = __builtin_amdgcn_mfma_f32_32x32x16_bf16(__builtin_bit_cast(bf16x8, pw0_), (bf16x8){l0[0], l0[1], l0[2], l0[3], h0[0], h0[1], h0[2], h0[3]}, o0, 0, 0, 0); \
          o0 = __builtin_amdgcn_mfma_f32_32x32x16_bf16(__builtin_bit_cast(bf16x8, pw1_), (bf16x8){l1[0], l1[1], l1[2], l1[3], h1[0], h1[1], h1[2], h1[3]}, o0, 0, 0, 0); } \
        { s16x4 l2 = vtr(vb_ + 2 * AT_VPC), h2 = vtr(vb_ + 2 * AT_VPC + 512), l3 = vtr(vb_ + 3 * AT_VPC), h3 = vtr(vb_ + 3 * AT_VPC + 512); \
          o1 = __builtin_amdgcn_mfma_f32_32x32x16_bf16(__builtin_bit_cast(bf16x8, pw0_), (bf16x8){l2[0], l2[1], l2[2], l2[3], h2[0], h2[1], h2[2], h2[3]}, o1, 0, 0, 0); \
          o1 = __builtin_amdgcn_mfma_f32_32x32x16_bf16(__builtin_bit_cast(bf16x8, pw1_), (bf16x8){l3[0], l3[1], l3[2], l3[3], h3[0], h3[1], h3[2], h3[3]}, o1, 0, 0, 0); } } while (0)
    TaskD D = unit_decode<FINAL>(F.vcu, u0);
    STAGE_LOAD(D); LOADQN(D);
    int tb_ch = -1;
    for (int u = u0; u < u1; ++u) {
        const TaskD Dn = unit_decode<FINAL>(F.vcu, u + 1 < u1 ? u + 1 : u);
        AT_BAR();
#pragma unroll
        for (int t_ = 0; t_ < AT_NT; ++t_) *(LAS bf16x8*)(L0 + t_ * AT_TILE + sdst) = st[t_];
        if (tb_ch != D.c * 8 + D.h) { tb_ch = D.c * 8 + D.h; if (F.tid < 192) tbl[F.tid] = F.TBG[tb_ch * 192 + F.tid]; }
#pragma unroll
        for (int d0 = 0; d0 < 4; ++d0) qr[d0] = qn[d0];
        AT_BAR();
        STAGE_LOAD(Dn); LOADQN(Dn);
        const int i0w = D.i0 + 32 * w;
        v4u p4[4], p16[4], zg[4]; float l4[4], l16[4];
#define FIN_LOAD(i) do { const int row = (i) * 8 + (lane >> 3), ch = lane & 7; const unsigned tok = (unsigned)(D.tok0 + i0w + row); const unsigned eo = tok * AW + D.hq + ch * 8; \
            p4[i] = *(const v4u*)(F.OP4 + eo); p16[i] = *(const v4u*)(F.OP16 + eo); zg[i] = *(const v4u*)(F.ZG + eo); l4[i] = F.LP4[tok * 8 + D.h]; l16[i] = F.LP16[tok * 8 + D.h]; } while (0)
        if (FINAL) { FIN_LOAD(0); }
        f32x16 o0 = {}, o1 = {}; float lsum = 0.f;
        CHUNK(0); CHUNK(1); CHUNK(2); CHUNK(3); CHUNK(4);
        lsum += __shfl_xor(lsum, 32);
#pragma unroll
        for (int rr = 0; rr < 16; rr += 2) {
            const unsigned a01 = cvtpk_s(o0[rr], o0[rr + 1]), b01 = cvtpk_s(o1[rr], o1[rr + 1]);
            const int q0 = crow(rr, hi), q1 = crow(rr + 1, hi);
            stgb[q0 * 64 + r32] = (unsigned short)(a01 & 0xffffu); stgb[q1 * 64 + r32] = (unsigned short)(a01 >> 16);
            stgb[q0 * 64 + 32 + r32] = (unsigned short)(b01 & 0xffffu); stgb[q1 * 64 + 32 + r32] = (unsigned short)(b01 >> 16);
        }
        if (FINAL) { if (hi == 0) lw[r32] = lsum; FIN_LOAD(1); FIN_LOAD(2); FIN_LOAD(3); }
        else { if (hi == 0) { float* lp = F.LP4 + (size_t)(D.c - 1) * (size_t)(256u << 10) + (unsigned)((D.tok0 + D.dil * (i0w + r32)) * 8 + D.h); *lp = lsum; } }
#pragma unroll
        for (int i = 0; i < 4; ++i) {
            const int row = i * 8 + (lane >> 3), ch = lane & 7;
            const unsigned tok = (unsigned)(D.tok0 + D.dil * (i0w + row));
            const v4u ov = *(const LAS v4u*)(stgb + row * 64 + ch * 8);
            if (!FINAL) {
                *(v4u*)(F.OP4 + (size_t)(D.c - 1) * (size_t)(16u << 20) + (tok * AW + D.hq + ch * 8)) = ov;
            } else {
                const float inv = 1.f / (lw[row] + l4[i] + l16[i]);
                float y[8];
#define SZ(x) pg8::silu_f(x)
                y[0] = (bflo(ov.x) + bflo(p4[i].x) + bflo(p16[i].x)) * inv * SZ(bflo(zg[i].x)); y[1] = (bfhi(ov.x) + bfhi(p4[i].x) + bfhi(p16[i].x)) * inv * SZ(bfhi(zg[i].x));
                y[2] = (bflo(ov.y) + bflo(p4[i].y) + bflo(p16[i].y)) * inv * SZ(bflo(zg[i].y)); y[3] = (bfhi(ov.y) + bfhi(p4[i].y) + bfhi(p16[i].y)) * inv * SZ(bfhi(zg[i].y));
                y[4] = (bflo(ov.z) + bflo(p4[i].z) + bflo(p16[i].z)) * inv * SZ(bflo(zg[i].z)); y[5] = (bfhi(ov.z) + bfhi(p4[i].z) + bfhi(p16[i].z)) * inv * SZ(bfhi(zg[i].z));
                y[6] = (bflo(ov.w) + bflo(p4[i].w) + bflo(p16[i].w)) * inv * SZ(bflo(zg[i].w)); y[7] = (bfhi(ov.w) + bfhi(p4[i].w) + bfhi(p16[i].w)) * inv * SZ(bfhi(zg[i].w));
#undef SZ
                v4u wv; wv.x = cvtpk_s(y[0], y[1]); wv.y = cvtpk_s(y[2], y[3]); wv.z = cvtpk_s(y[4], y[5]); wv.w = cvtpk_s(y[6], y[7]);
                *(v4u*)(F.Y + (tok * D_MODEL + 512 + D.hq + ch * 8)) = wv;
            }
        }
        D = Dn;
    }
    AT_BAR();
#undef STAGE_LOAD
#undef LOADQN
#undef CHUNK
#undef FIN_LOAD
}
__device__ __forceinline__ void conv_fixup_row(Frame& F, int idx, int lane) {
    const int pm = idx >> 1, last = idx & 1;
    const float* tcp = F.SBT + (size_t)(pm * 4 + (last ? 3 : 0)) * 512 + 8 * lane;
    const bool hasp = last || (pm % (SEQ / 256) != 0), hasn = !last || (pm % (SEQ / 256) != SEQ / 256 - 1);
    const float* tpp = last ? F.SBT + (size_t)(pm * 4 + 2) * 512 + 8 * lane : F.SBT + (size_t)((hasp ? pm - 1 : pm) * 4 + 3) * 512 + 8 * lane;
    const float* tnp = last ? F.SBT + (size_t)((hasn ? pm + 1 : pm) * 4 + 0) * 512 + 8 * lane : F.SBT + (size_t)(pm * 4 + 1) * 512 + 8 * lane;
    const float* gp = F.SBG + (size_t)(pm * 2 + last) * 512 + 8 * lane;
    float y[8];
#pragma unroll
    for (int i = 0; i < 8; ++i) {
        const float tp = hasp ? tpp[i] : 0.f, tn = hasn ? tnp[i] : 0.f;
        y[i] = gp[i] * (F.conv_w[8 * lane + i] * tp + F.conv_w[512 + 8 * lane + i] * tcp[i] + F.conv_w[1024 + 8 * lane + i] * tn + F.conv_b[8 * lane + i]);
    }
    v4u w; w.x = cvtpk_s(y[0], y[1]); w.y = cvtpk_s(y[2], y[3]); w.z = cvtpk_s(y[4], y[5]); w.w = cvtpk_s(y[6], y[7]);
    *(v4u*)(F.Y + (size_t)(pm * 256 + (last ? 255 : 0)) * D_MODEL + 8 * lane) = w;
}
__device__ __forceinline__ void attn_pass_a(Frame& F) {
    attn_units<false>(F);
    const int gw = F.vcu * NWAVES + F.wave, NGW = F.G * NWAVES;
    for (int idx = gw; idx < 2 * (M / 256); idx += NGW) conv_fixup_row(F, idx, F.lane);
}
__device__ __forceinline__ void attn_pass_b(Frame& F) {
    attn_units<true>(F);
}

struct Args { const float* in[9]; float* out; unsigned char* ws; int ph_lo, ph_hi; };
__global__ void __launch_bounds__(NWAVES * 64, 2) mega(Args args) {
    extern __shared__ __attribute__((aligned(16))) unsigned char lds[];
    Frame F;
    F.lds = (LAS unsigned char*)lds;
    F.MISC = (volatile LAS unsigned*)(F.lds + MISC_OFF);
    F.tid = threadIdx.x; F.lane = F.tid & 63; F.wave = __builtin_amdgcn_readfirstlane(F.tid >> 6);
    F.G = gridDim.x; { const int bx = blockIdx.x; F.vcu = (F.G % 8 == 0) ? (bx % 8) * (F.G / 8) + bx / 8 : bx; }
    unsigned char* ws = args.ws;
    F.ctl = (gu32*)(ws + WS_CTL);
    F.x = args.in[0]; F.norm_w = args.in[1]; F.w_in = args.in[2]; F.conv_w = args.in[3]; F.conv_b = args.in[4]; F.qw = args.in[5]; F.kw = args.in[6]; F.rel_bias = args.in[7]; F.w_out = args.in[8];
    F.out = args.out;
    F.WinT = (bf16*)(ws + WS_WIN); F.WoutT = (bf16*)(ws + WS_WOUT); F.XN = (bf16*)(ws + WS_XN);
    F.SBT = (float*)(ws + WS_SBT); F.SBG = (float*)(ws + WS_SBG); F.Q = (bf16*)(ws + WS_Q); F.K = (bf16*)(ws + WS_K); F.V = (bf16*)(ws + WS_V); F.ZG = (bf16*)(ws + WS_ZG);
    F.OP4 = (bf16*)(ws + WS_OP4); F.OP16 = (bf16*)(ws + WS_OP16); F.Y = (bf16*)(ws + WS_Y);
    F.TBG = (float*)(ws + WS_TBG); F.LP4 = (float*)(ws + WS_LP4); F.LP16 = (float*)(ws + WS_LP16);
    for (int u = F.tid; u < (LDS_BYTES - LDSCTL_OFF) / 4; u += NWAVES * 64) ((LAS unsigned*)(F.lds + LDSCTL_OFF))[u] = 0u;
    __syncthreads();
    const int lo = args.ph_lo, hi = args.ph_hi;
    const bool multi = (hi - lo) > 1;
    XcdBarrier bar; bar.bar = (unsigned*)(F.ctl + CW_BAR); bar.x = 0; bar.st = nullptr;
    if (multi) bar = xcd_barrier_post((unsigned*)(F.ctl + CW_BAR), F.MISC + 8);
#define IN(k) (lo <= (k) && (k) < hi)
#define BOTH(k) (IN(k) && IN((k) + 1))
    if (IN(0)) { p0_prologue(F); if (BOTH(0)) xcd_barrier(bar); }
    if (IN(1)) {
        pg8::Gemm g{F.XN, F.WinT, M, NPROJ, D_MODEL}; pg8::StaticOrder S; S.init(M, NPROJ, F.G, (int)blockIdx.x);
        { LAS float* cwl = (LAS float*)(F.lds + XL_OFF + 2048);
          for (int i = F.tid; i < 2048; i += NWAVES * 64) cwl[i] = i < 1536 ? F.conv_w[i] : F.conv_b[i - 1536];
          if (F.tid < 128) cwl[2048 + F.tid] = F.tid < 64 ? F.qw[F.tid] : F.kw[F.tid - 64];
          __syncthreads(); }
        pg8::EpiProj E{F.Y, F.Q, F.SBT, F.SBG, F.lds + XL_OFF};
        pg8::gemm_phase<pg8::EpiProj, pg8::StaticOrder, true, true>(F.lds + RING_OFF, g, S, E);
        if (BOTH(1)) xcd_barrier(bar);
    }
    if (IN(2)) { attn_pass_a(F); if (BOTH(2)) xcd_barrier(bar); }
    if (IN(3)) { attn_pass_b(F); if (BOTH(3)) xcd_barrier(bar); }
    if (IN(4)) {
        pg8::Gemm g{F.Y, F.WoutT, M, D_MODEL, D_MODEL}; pg8::StaticOrder S; S.init(M, D_MODEL, F.G, (int)blockIdx.x);
        pg8::EpiRes E{F.x, F.out, D_MODEL};
        pg8::gemm_phase<pg8::EpiRes, pg8::StaticOrder, true, true>(F.lds + RING_OFF, g, S, E);
    }
#undef IN
#undef BOTH
}

extern "C" void kernel_launch(void* const* d_in, const int* in_sizes, int n_in, void* d_out, int out_size, void* d_ws, size_t ws_size, hipStream_t stream) {
    static int grid = 0;
    if (grid == 0) {
        if (n_in != 9 || in_sizes[0] != M * D_MODEL || out_size != M * D_MODEL || ws_size < WS_END) { fprintf(stderr, "kernel_launch: unexpected shapes (n_in %d, in0 %d, out %d, ws %zu)\n", n_in, n_in > 0 ? in_sizes[0] : -1, out_size, ws_size); grid = -1; return; }
        int dev = 0, cus = 0, per_cu = 0;
        if (hipGetDevice(&dev) != hipSuccess || hipDeviceGetAttribute(&cus, hipDeviceAttributeMultiprocessorCount, dev) != hipSuccess) { grid = -1; return; }
        if (hipFuncSetAttribute((const void*)mega, hipFuncAttributeMaxDynamicSharedMemorySize, LDS_BYTES) != hipSuccess) { fprintf(stderr, "kernel_launch: hipFuncSetAttribute failed\n"); grid = -1; return; }
        if (hipOccupancyMaxActiveBlocksPerMultiprocessor(&per_cu, (const void*)mega, NWAVES * 64, LDS_BYTES) != hipSuccess || per_cu < 1) { fprintf(stderr, "kernel_launch: occupancy query says %d blocks per CU\n", per_cu); (void)hipGetLastError(); grid = -1; return; }
        grid = cus;
        if (grid != 256) { fprintf(stderr, "kernel_launch: built for a 256-CU device (got %d CUs)\n", cus); grid = -1; return; }
    }
    if (grid < 0) return;
    (void)hipMemsetAsync((char*)d_ws + WS_CTL, 0, CTL_ZERO_BYTES, stream);
    Args a{};
    for (int i = 0; i < 9; ++i) a.in[i] = (const float*)d_in[i];
    a.out = (float*)d_out; a.ws = (unsigned char*)d_ws;
    unsigned char* ws = (unsigned char*)d_ws;
#if STAGE == 4
    a.ph_lo = 0; a.ph_hi = 5;
    hipLaunchKernelGGL(mega, dim3(grid), dim3(NWAVES * 64), LDS_BYTES, stream, a);
    if (PROBE_PHASE >= 0) { a.ph_lo = PROBE_PHASE; a.ph_hi = PROBE_PHASE + 1; hipLaunchKernelGGL(mega, dim3(grid), dim3(NWAVES * 64), LDS_BYTES, stream, a); }
#else
    const int nper = 5;
    for (int p = 0; p < nper; ++p) { a.ph_lo = p; a.ph_hi = p + 1; hipLaunchKernelGGL(mega, dim3(grid), dim3(NWAVES * 64), LDS_BYTES, stream, a); }
#endif
}
```

```cpp
#include <hip/hip_runtime.h>
#include <cstdio>
#include <cstdint>

#ifndef PROBE_PHASE
#define PROBE_PHASE -1
#endif
#ifndef STAGE
#define STAGE 4
#endif

__device__ __forceinline__ int hw_lane() { return (int)__builtin_amdgcn_mbcnt_hi(~0u, __builtin_amdgcn_mbcnt_lo(~0u, 0u)); }

namespace pg8 {
#define PG8_LAS __attribute__((address_space(3)))
typedef unsigned short bf16_t;
typedef short bf16x8 __attribute__((ext_vector_type(8)));
typedef float f32x4 __attribute__((ext_vector_type(4)));
typedef unsigned u32x4 __attribute__((ext_vector_type(4)));
typedef unsigned u32x2 __attribute__((ext_vector_type(2)));
constexpr int BM = 256, BK = 64, HALF = 128, HTB = HALF * BK * 2, STAGE_BYTES = 8 * HTB, NXCD = 8, WGM = 8;

__host__ __device__ __forceinline__ int lds_byte(int r, int c) { const int st = (r >> 4) * 2 + (c >> 5), rr = r & 15, cc = c & 31, ob = rr * 64 + cc * 2; return st * 1024 + (ob ^ (((ob >> 9) & 1) << 5)); }
__host__ __device__ __forceinline__ void stage_rc(int b, int& R, int& C) { const int st = b / 1024, sb = b % 1024, swz = sb ^ (((sb >> 9) & 1) << 5); R = (st >> 1) * 16 + swz / 64; C = (st & 1) * 32 + (swz % 64) / 2; }

struct Unit { int pm, pn; };
struct Gemm { const bf16_t* A; const bf16_t* Bt; int M, N, K; };

struct StaticOrder {
    int nM, nN, nwg, G, c;
    __host__ __device__ void init(int M, int N, int G_, int c_) { nM = M / BM; nN = N / BM; nwg = nM * nN; G = G_; c = c_; }
    __host__ __device__ bool next(int i, Unit& u) const {
        const long L = (long)i * G + c; if (L >= nwg) return false;
        int wgid = (int)L; { const int q = nwg / NXCD, r = nwg % NXCD, xcd = wgid % NXCD, off = wgid / NXCD; wgid = (xcd < r ? xcd * (q + 1) : r * (q + 1) + (xcd - r) * q) + off; }
        const int nig = WGM * nN, gid = wgid / nig, fm = gid * WGM, gsz = (nM - fm) < WGM ? (nM - fm) : WGM;
        u.pm = fm + ((wgid % nig) % gsz); u.pn = (wgid % nig) / gsz; return true;
    }
};

__device__ __forceinline__ unsigned cvt_pk_bf16(float lo, float hi) { unsigned r; asm volatile("v_cvt_pk_bf16_f32 %0, %1, %2" : "=v"(r) : "v"(lo), "v"(hi)); return r; }
__device__ __forceinline__ float silu_f(float z) { return z * __builtin_amdgcn_rcpf(1.f + __builtin_amdgcn_exp2f(-1.4426950408889634f * z)); }

struct EpiProj {
    static constexpr bool PERM = false, AFTER_DRAIN = false, XPRE = false;
    bf16_t *Y, *QKVZ; float *SBT, *SBG; PG8_LAS unsigned char* xl;
    __device__ __forceinline__ void operator()(const f32x4 (&acc)[2][2][4][2], const Unit& u, int wr, int wc, int fr, int fq) const {
        const int row0 = u.pm * BM + wr * 64 + fr;
        if (u.pn < 8) {
            const int lane = fr + 16 * fq, chl = 16 * wc + 4 * fq, ch0 = 64 * u.pn + chl;
            PG8_LAS float* X = (PG8_LAS float*)xl;
            const PG8_LAS float* CWl = (const PG8_LAS float*)(xl + 2048);
            f32x4 t[2][4], g[2][4];
#pragma unroll
            for (int ai = 0; ai < 2; ++ai)
#pragma unroll
                for (int m = 0; m < 4; ++m) {
                    const f32x4 uu = acc[ai][0][m][0], gb = acc[ai][0][m][1], gc = acc[ai][1][m][0], z = acc[ai][1][m][1];
                    t[ai][m] = gc * uu;
#pragma unroll
                    for (int i = 0; i < 4; ++i) g[ai][m][i] = gb[i] * silu_f(z[i]);
                }
#pragma unroll
            for (int ai = 0; ai < 2; ++ai) { const int grpi = 2 * ai + wr;
                if (fr == 0) *(PG8_LAS f32x4*)(X + (grpi * 2 + 0) * 64 + chl) = t[ai][0];
                if (fr == 15) *(PG8_LAS f32x4*)(X + (grpi * 2 + 1) * 64 + chl) = t[ai][3]; }
            if (wr == 0 && fr < 2) { *(f32x4*)(SBT + ((size_t)(u.pm * 4 + fr) * 512 + ch0)) = t[0][0]; if (fr == 0) *(f32x4*)(SBG + ((size_t)(u.pm * 2 + 0) * 512 + ch0)) = g[0][0]; }
            if (wr == 1 && fr >= 14) { *(f32x4*)(SBT + ((size_t)(u.pm * 4 + fr - 12) * 512 + ch0)) = t[1][3]; if (fr == 15) *(f32x4*)(SBG + ((size_t)(u.pm * 2 + 1) * 512 + ch0)) = g[1][3]; }
            asm volatile("s_waitcnt lgkmcnt(0)" ::: "memory"); __builtin_amdgcn_s_barrier(); asm volatile("" ::: "memory");
            const f32x4 w0 = *(const PG8_LAS f32x4*)(CWl + ch0), w1 = *(const PG8_LAS f32x4*)(CWl + 512 + ch0), w2 = *(const PG8_LAS f32x4*)(CWl + 1024 + ch0), cb = *(const PG8_LAS f32x4*)(CWl + 1536 + ch0);
#pragma unroll
            for (int ai = 0; ai < 2; ++ai) { const int grpi = 2 * ai + wr;
                const f32x4 xprev = *(const PG8_LAS f32x4*)(X + (((grpi + 3) & 3) * 2 + 1) * 64 + chl), xnext = *(const PG8_LAS f32x4*)(X + (((grpi + 1) & 3) * 2 + 0) * 64 + chl);
#pragma unroll
                for (int m = 0; m < 4; ++m) {
                    const f32x4 ps = m > 0 ? t[ai][m - 1] : xprev, ns = m < 3 ? t[ai][m + 1] : xnext, tc = t[ai][m];
                    f32x4 tp, tn;
#pragma unroll
                    for (int i = 0; i < 4; ++i) {
                        tp[i] = __builtin_bit_cast(float, __builtin_amdgcn_update_dpp(0, __builtin_bit_cast(int, fr == 15 ? ps[i] : tc[i]), 0x121, 0xf, 0xf, false));
                        tn[i] = __builtin_bit_cast(float, __builtin_amdgcn_update_dpp(0, __builtin_bit_cast(int, fr == 0 ? ns[i] : tc[i]), 0x12F, 0xf, 0xf, false)); }
                    const f32x4 y = g[ai][m] * (w0 * tp + w1 * tc + w2 * tn + cb);
                    const int rt = 128 * ai + 64 * wr + 16 * m + fr;
                    u32x2 yw; yw.x = cvt_pk_bf16(y[0], y[1]); yw.y = cvt_pk_bf16(y[2], y[3]);
                    if (rt != 0 && rt != 255) *(u32x2*)(Y + (size_t)(u.pm * BM + rt) * 1024 + ch0) = yw;
                }
            }
        } else {
            const int grp = (u.pn - 8) >> 1, head = 4 * ((u.pn - 8) & 1) + wc;
            bf16_t* dst = QKVZ + (size_t)grp * (size_t)(16u << 20);
            const int col0 = head * 64 + 8 * fq;
            f32x4 wv[2][2];
            if (grp < 2) { const PG8_LAS float* w = (const PG8_LAS float*)(xl + 10240) + 64 * grp;
#pragma unroll
                for (int bj = 0; bj < 2; ++bj)
#pragma unroll
                    for (int n = 0; n < 2; ++n) wv[bj][n] = *(const PG8_LAS f32x4*)(w + 32 * bj + 8 * fq + 4 * n); }
            const float sc = grp == 0 ? 0.125f * 1.4426950408889634f : 1.f;
#pragma unroll
            for (int ai = 0; ai < 2; ++ai)
#pragma unroll
                for (int m = 0; m < 4; ++m) {
                    f32x4 v[2][2];
#pragma unroll
                    for (int bj = 0; bj < 2; ++bj)
#pragma unroll
                        for (int n = 0; n < 2; ++n) v[bj][n] = acc[ai][bj][m][n];
                    if (grp < 2) {
                        float ss = 0.f;
#pragma unroll
                        for (int bj = 0; bj < 2; ++bj)
#pragma unroll
                            for (int n = 0; n < 2; ++n) ss += (v[bj][n][0] * v[bj][n][0] + v[bj][n][1] * v[bj][n][1]) + (v[bj][n][2] * v[bj][n][2] + v[bj][n][3] * v[bj][n][3]);
                        ss += __shfl_xor(ss, 16); ss += __shfl_xor(ss, 32);
                        const float rs = __builtin_amdgcn_rsqf(ss * (1.f / 64.f) + 1e-6f) * sc;
#pragma unroll
                        for (int bj = 0; bj < 2; ++bj)
#pragma unroll
                            for (int n = 0; n < 2; ++n) v[bj][n] = v[bj][n] * rs * wv[bj][n];
                    }
                    bf16_t* rowp = dst + (size_t)(row0 + ai * HALF + m * 16) * 512 + col0;
#pragma unroll
                    for (int bj = 0; bj < 2; ++bj) { u32x4 w; w.x = cvt_pk_bf16(v[bj][0][0], v[bj][0][1]); w.y = cvt_pk_bf16(v[bj][0][2], v[bj][0][3]); w.z = cvt_pk_bf16(v[bj][1][0], v[bj][1][1]); w.w = cvt_pk_bf16(v[bj][1][2], v[bj][1][3]);
                        *(u32x4*)(rowp + 32 * bj) = w; }
                }
        }
    }
};
struct EpiRes {
    static constexpr bool PERM = false, AFTER_DRAIN = false, XPRE = true;
    const float* X; float* O; int ldc;
    __device__ __forceinline__ void xissue(const Unit& u, int it, int wr, int wc, int fr, int fq, f32x4 (&xv)[4]) const {
        const int ai = it >> 2, bj = (it >> 1) & 1, m0 = 2 * (it & 1);
        const float* ba = X + ((size_t)(u.pm * BM + ai * HALF + m0 * 16) * ldc + u.pn * BM + bj * HALF);
        const float* bb = ba + (size_t)16 * ldc;
        const unsigned voff = (unsigned)(((wr * 64 + fr) * ldc + wc * 32 + 4 * fq) * 4);
        asm volatile("global_load_dwordx4 %0, %4, %5\n\tglobal_load_dwordx4 %1, %4, %5 offset:64\n\tglobal_load_dwordx4 %2, %4, %6\n\tglobal_load_dwordx4 %3, %4, %6 offset:64"
                     : "=&v"(xv[0]), "=&v"(xv[1]), "=&v"(xv[2]), "=&v"(xv[3]) : "v"(voff), "s"(ba), "s"(bb) : "memory");
    }
    __device__ __forceinline__ void xadd(f32x4 (&acc)[2][2][4][2], int it, f32x4 (&xv)[4]) const {
        asm volatile("" : "+v"(xv[0]), "+v"(xv[1]), "+v"(xv[2]), "+v"(xv[3]));
#define XA(AI, BJ, M0) do { acc[AI][BJ][M0][0] += xv[0]; acc[AI][BJ][M0][1] += xv[1]; acc[AI][BJ][M0 + 1][0] += xv[2]; acc[AI][BJ][M0 + 1][1] += xv[3]; } while (0)
        switch (it) { case 0: XA(0, 0, 0); break; case 1: XA(0, 0, 2); break; case 2: XA(0, 1, 0); break; case 3: XA(0, 1, 2); break;
                      case 4: XA(1, 0, 0); break; case 5: XA(1, 0, 2); break; case 6: XA(1, 1, 0); break; default: XA(1, 1, 2); break; }
#undef XA
    }
    __device__ __forceinline__ void operator()(const f32x4 (&acc)[2][2][4][2], const Unit& u, int wr, int wc, int fr, int fq) const {
        const int row0 = u.pm * BM + wr * 64 + fr, col0 = u.pn * BM + wc * 32 + 4 * fq;
#pragma unroll
        for (int ai = 0; ai < 2; ++ai)
#pragma unroll
            for (int m = 0; m < 4; ++m) { const size_t off = (size_t)(row0 + ai * HALF + m * 16) * ldc + col0;
#pragma unroll
                for (int bj = 0; bj < 2; ++bj)
#pragma unroll
                    for (int n = 0; n < 2; ++n) *(f32x4*)(O + off + bj * HALF + n * 16) = acc[ai][bj][m][n]; }
    }
};

template <class Epi, class Sched, bool ALIGN_EPI = false, bool SP2 = false>
__device__ __forceinline__ void gemm_phase(PG8_LAS unsigned char* lds, const Gemm g, const Sched& S, const Epi& E, const int widx) {
    const int lane = hw_lane(), wid = widx, tid = wid * 64 + lane, wr = wid >> 2, wc = wid & 3, fr = lane & 15, fq = lane >> 4;
    const int K = g.K, nt = K / BK;
    unsigned voffA[2], voffB[2];
#pragma unroll
    for (int i = 0; i < 2; ++i) { int R, C; stage_rc(tid * 16 + i * 8192, R, C);
        voffA[i] = (unsigned)(R * K + C) * 2u; voffB[i] = (unsigned)(R * K + C) * 2u; }
    const size_t kstep = (size_t)(BK * 2);
    const size_t hstep = (size_t)HALF * K * 2;
    const size_t tstep = 2 * hstep;
    const unsigned ldsw = (unsigned)wid * 1024u;
    const int aoff = lds_byte(wr * 64 + fr, fq * 8), boff = lds_byte(wc * 32 + fr, fq * 8);
#define PG8_SA(b, h) (((b) * 2 + (h)) * HTB)
#define PG8_SB(b, h) ((4 + (b) * 2 + (h)) * HTB)
#define PG8_STAGE(bufoff, gbase, voff) do { _Pragma("unroll") for (int _i = 0; _i < 2; ++_i) \
        __builtin_amdgcn_global_load_lds((const unsigned*)((const char*)(gbase) + (voff)[_i]), (PG8_LAS unsigned*)(lds + (bufoff) + ldsw + _i * 8192), 16, 0, 0); } while (0)
#define PG8_LDA(dst, b, h) do { _Pragma("unroll") for (int m = 0; m < 4; ++m) _Pragma("unroll") for (int k = 0; k < 2; ++k) dst[m][k] = *(const PG8_LAS bf16x8*)(lds + PG8_SA(b, h) + aoff + m * 2048 + k * 1024); } while (0)
#define PG8_LDB(dst, b, h) do { _Pragma("unroll") for (int n = 0; n < 2; ++n) _Pragma("unroll") for (int k = 0; k < 2; ++k) dst[n][k] = *(const PG8_LAS bf16x8*)(lds + PG8_SB(b, h) + boff + n * 2048 + k * 1024); } while (0)
#define PG8_MMA(ai, bj, At, Bt) do { __builtin_amdgcn_s_setprio(1); _Pragma("unroll") for (int m = 0; m < 4; ++m) _Pragma("unroll") for (int n = 0; n < 2; ++n) _Pragma("unroll") for (int k = 0; k < 2; ++k) \
        acc[ai][bj][m][n] = __builtin_amdgcn_mfma_f32_16x16x32_bf16(Bt[n][k], At[m][k], acc[ai][bj][m][n], 0, 0, 0); __builtin_amdgcn_s_setprio(0); } while (0)
#define PG8_WAIT_V(n) asm volatile("s_waitcnt vmcnt(" #n ")" ::: "memory")
#define PG8_WAIT_L(n) asm volatile("s_waitcnt lgkmcnt(" #n ")" ::: "memory")
#define PG8_BAR __builtin_amdgcn_s_barrier()
#define PG8_SCHED __builtin_amdgcn_sched_barrier(0)
    Unit cur, nxt; int ui = 0;
    if (!S.next(0, cur)) return;
    f32x4 acc[2][2][4][2];
#pragma unroll
    for (int a = 0; a < 2; ++a)
#pragma unroll
        for (int b = 0; b < 2; ++b)
#pragma unroll
            for (int m = 0; m < 4; ++m)
#pragma unroll
                for (int n = 0; n < 2; ++n) acc[a][b][m][n] = (f32x4){0.f, 0.f, 0.f, 0.f};
    bf16x8 At[4][2], B0[2][2], B1[2][2]; f32x4 xv[4];
    const char* cA = (const char*)g.A + (size_t)cur.pm * tstep; const char* cB = (const char*)g.Bt + (size_t)cur.pn * tstep;
    if constexpr (SP2) {
        PG8_STAGE(PG8_SB(0, 0), cB, voffB); PG8_STAGE(PG8_SB(0, 1), cB + hstep, voffB); PG8_STAGE(PG8_SA(0, 0), cA, voffA); PG8_STAGE(PG8_SA(0, 1), cA + hstep, voffA);
        if (wr == 1) PG8_BAR;
        PG8_WAIT_V(2); PG8_BAR;
        PG8_STAGE(PG8_SB(1, 0), cB + kstep, voffB); PG8_STAGE(PG8_SA(1, 0), cA + kstep, voffA); PG8_STAGE(PG8_SB(1, 1), cB + hstep + kstep, voffB);
        PG8_WAIT_V(6); PG8_BAR;
    } else {
        PG8_STAGE(PG8_SB(0, 0), cB, voffB); PG8_STAGE(PG8_SA(0, 0), cA, voffA); PG8_STAGE(PG8_SB(0, 1), cB + hstep, voffB); PG8_STAGE(PG8_SA(0, 1), cA + hstep, voffA);
        if (wr == 1) PG8_BAR;
        PG8_WAIT_V(4); PG8_BAR;
        PG8_STAGE(PG8_SB(1, 0), cB + kstep, voffB); PG8_STAGE(PG8_SA(1, 0), cA + kstep, voffA); PG8_STAGE(PG8_SB(1, 1), cB + hstep + kstep, voffB);
        PG8_WAIT_V(6); PG8_BAR;
    }
    for (;;) {
        const bool has_next = S.next(ui + 1, nxt);
        const char* nA = has_next ? (const char*)g.A + (size_t)nxt.pm * tstep : cA; const char* nB = has_next ? (const char*)g.Bt + (size_t)nxt.pn * tstep : cB;
        if constexpr (Epi::XPRE) {
#pragma unroll
        for (int t = 0; t < 16; t += 2) {
            const bool last = (t == nt - 2);
            const char* a1 = cA + (size_t)(t + 1) * kstep;
            const char* a2 = last ? nA : cA + (size_t)(t + 2) * kstep; const char* b2 = last ? nB : cB + (size_t)(t + 2) * kstep;
            const char* a3 = a2 + kstep; const char* b3 = b2 + kstep;
            if constexpr (SP2) {
            if constexpr (Epi::XPRE) E.xissue(cur, t >> 1, wr, wc, fr, fq, xv);
            PG8_LDB(B0, 0, 0); PG8_LDB(B1, 0, 1); PG8_SCHED; PG8_LDA(At, 0, 0); PG8_STAGE(PG8_SA(1, 1), a1 + hstep, voffA);
            if constexpr (Epi::XPRE) PG8_WAIT_V(12); else PG8_WAIT_V(8);
            PG8_WAIT_L(0); PG8_BAR; PG8_MMA(0, 0, At, B0); PG8_MMA(0, 1, At, B1); PG8_BAR; PG8_SCHED;
            PG8_LDA(At, 0, 1); PG8_STAGE(PG8_SB(0, 0), b2, voffB); PG8_STAGE(PG8_SB(0, 1), b2 + hstep, voffB); PG8_STAGE(PG8_SA(0, 0), a2, voffA);
            if constexpr (Epi::XPRE) PG8_WAIT_V(12); else PG8_WAIT_V(8);
            PG8_WAIT_L(0); PG8_BAR; PG8_MMA(1, 0, At, B0); PG8_MMA(1, 1, At, B1); PG8_BAR; PG8_SCHED;
            PG8_LDB(B0, 1, 0); PG8_LDB(B1, 1, 1); PG8_SCHED; PG8_LDA(At, 1, 0); PG8_STAGE(PG8_SA(0, 1), a2 + hstep, voffA);
            PG8_WAIT_V(8); PG8_WAIT_L(0); PG8_BAR;
            if constexpr (Epi::XPRE) E.xadd(acc, t >> 1, xv);
            PG8_MMA(0, 0, At, B0); PG8_MMA(0, 1, At, B1); PG8_BAR; PG8_SCHED;
            PG8_LDA(At, 1, 1); PG8_STAGE(PG8_SB(1, 0), b3, voffB); PG8_STAGE(PG8_SB(1, 1), b3 + hstep, voffB); PG8_STAGE(PG8_SA(1, 0), a3, voffA);
            PG8_WAIT_V(8); PG8_WAIT_L(0); PG8_BAR; PG8_MMA(1, 0, At, B0); PG8_MMA(1, 1, At, B1); PG8_BAR; PG8_SCHED;
            } else {
            PG8_LDB(B0, 0, 0); PG8_SCHED; PG8_LDA(At, 0, 0); PG8_STAGE(PG8_SA(1, 1), a1 + hstep, voffA);
            PG8_WAIT_L(8); PG8_BAR; PG8_WAIT_L(0); PG8_MMA(0, 0, At, B0); PG8_BAR; PG8_SCHED;
            PG8_LDB(B1, 0, 1); PG8_STAGE(PG8_SB(0, 0), b2, voffB);
            PG8_BAR; PG8_WAIT_L(0); PG8_MMA(0, 1, At, B1); PG8_BAR;
            PG8_LDA(At, 0, 1); PG8_STAGE(PG8_SA(0, 0), a2, voffA);
            PG8_BAR; PG8_WAIT_L(0); PG8_MMA(1, 0, At, B0); PG8_BAR; PG8_SCHED;
            PG8_STAGE(PG8_SB(0, 1), b2 + hstep, voffB);
            PG8_WAIT_V(6); PG8_BAR; PG8_MMA(1, 1, At, B1); PG8_BAR;
            PG8_LDB(B0, 1, 0); PG8_SCHED; PG8_LDA(At, 1, 0); PG8_STAGE(PG8_SA(0, 1), a2 + hstep, voffA);
            PG8_WAIT_L(8); PG8_BAR; PG8_WAIT_L(0); PG8_MMA(0, 0, At, B0); PG8_BAR; PG8_SCHED;
            PG8_LDB(B1, 1, 1); PG8_STAGE(PG8_SB(1, 0), b3, voffB);
            PG8_BAR; PG8_WAIT_L(0); PG8_MMA(0, 1, At, B1); PG8_BAR;
            PG8_LDA(At, 1, 1); PG8_STAGE(PG8_SA(1, 0), a3, voffA);
            PG8_BAR; PG8_WAIT_L(0); PG8_MMA(1, 0, At, B0); PG8_BAR; PG8_SCHED;
            PG8_STAGE(PG8_SB(1, 1), b3 + hstep, voffB);
            PG8_WAIT_V(6); PG8_BAR; PG8_MMA(1, 1, At, B1); PG8_BAR;
            }
                }
        } else {
        for (int t = 0; t < nt; t += 2) {
            const bool last = (t == nt - 2);
            const char* a1 = cA + (size_t)(t + 1) * kstep;
            const char* a2 = last ? nA : cA + (size_t)(t + 2) * kstep; const char* b2 = last ? nB : cB + (size_t)(t + 2) * kstep;
            const char* a3 = a2 + kstep; const char* b3 = b2 + kstep;
            if constexpr (SP2) {
            if constexpr (Epi::XPRE) E.xissue(cur, t >> 1, wr, wc, fr, fq, xv);
            PG8_LDB(B0, 0, 0); PG8_LDB(B1, 0, 1); PG8_SCHED; PG8_LDA(At, 0, 0); PG8_STAGE(PG8_SA(1, 1), a1 + hstep, voffA);
            if constexpr (Epi::XPRE) PG8_WAIT_V(12); else PG8_WAIT_V(8);
            PG8_WAIT_L(0); PG8_BAR; PG8_MMA(0, 0, At, B0); PG8_MMA(0, 1, At, B1); PG8_BAR; PG8_SCHED;
            PG8_LDA(At, 0, 1); PG8_STAGE(PG8_SB(0, 0), b2, voffB); PG8_STAGE(PG8_SB(0, 1), b2 + hstep, voffB); PG8_STAGE(PG8_SA(0, 0), a2, voffA);
            if constexpr (Epi::XPRE) PG8_WAIT_V(12); else PG8_WAIT_V(8);
            PG8_WAIT_L(0); PG8_BAR; PG8_MMA(1, 0, At, B0); PG8_MMA(1, 1, At, B1); PG8_BAR; PG8_SCHED;
            PG8_LDB(B0, 1, 0); PG8_LDB(B1, 1, 1); PG8_SCHED; PG8_LDA(At, 1, 0); PG8_STAGE(PG8_SA(0, 1), a2 + hstep, voffA);
            PG8_WAIT_V(8); PG8_WAIT_L(0); PG8_BAR;
            if constexpr (Epi::XPRE) E.xadd(acc, t >> 1, xv);
            PG8_MMA(0, 0, At, B0); PG8_MMA(0, 1, At, B1); PG8_BAR; PG8_SCHED;
            PG8_LDA(At, 1, 1); PG8_STAGE(PG8_SB(1, 0), b3, voffB); PG8_STAGE(PG8_SB(1, 1), b3 + hstep, voffB); PG8_STAGE(PG8_SA(1, 0), a3, voffA);
            PG8_WAIT_V(8); PG8_WAIT_L(0); PG8_BAR; PG8_MMA(1, 0, At, B0); PG8_MMA(1, 1, At, B1); PG8_BAR; PG8_SCHED;
            } else {
            PG8_LDB(B0, 0, 0); PG8_SCHED; PG8_LDA(At, 0, 0); PG8_STAGE(PG8_SA(1, 1), a1 + hstep, voffA);
            PG8_WAIT_L(8); PG8_BAR; PG8_WAIT_L(0); PG8_MMA(0, 0, At, B0); PG8_BAR; PG8_SCHED;
            PG8_LDB(B1, 0, 1); PG8_STAGE(PG8_SB(0, 0), b2, voffB);
            PG8_BAR; PG8_WAIT_L(0); PG8_MMA(0, 1, At, B1); PG8_BAR;
            PG8_LDA(At, 0, 1); PG8_STAGE(PG8_SA(0, 0), a2, voffA);
            PG8_BAR; PG8_WAIT_L(0); PG8_MMA(1, 0, At, B0); PG8_BAR; PG8_SCHED;
            PG8_STAGE(PG8_SB(0, 1), b2 + hstep, voffB);
            PG8_WAIT_V(6); PG8_BAR; PG8_MMA(1, 1, At, B1); PG8_BAR;
            PG8_LDB(B0, 1, 0); PG8_SCHED; PG8_LDA(At, 1, 0); PG8_STAGE(PG8_SA(0, 1), a2 + hstep, voffA);
            PG8_WAIT_L(8); PG8_BAR; PG8_WAIT_L(0); PG8_MMA(0, 0, At, B0); PG8_BAR; PG8_SCHED;
            PG8_LDB(B1, 1, 1); PG8_STAGE(PG8_SB(1, 0), b3, voffB);
            PG8_BAR; PG8_WAIT_L(0); PG8_MMA(0, 1, At, B1); PG8_BAR;
            PG8_LDA(At, 1, 1); PG8_STAGE(PG8_SA(1, 0), a3, voffA);
            PG8_BAR; PG8_WAIT_L(0); PG8_MMA(1, 0, At, B0); PG8_BAR; PG8_SCHED;
            PG8_STAGE(PG8_SB(1, 1), b3 + hstep, voffB);
            PG8_WAIT_V(6); PG8_BAR; PG8_MMA(1, 1, At, B1); PG8_BAR;
            }
                }
        }
        if constexpr (ALIGN_EPI) { if (wr == 0) PG8_BAR; }
        E(acc, cur, wr, wc, fr, fq);
        if (!has_next) break;
#pragma unroll
        for (int a = 0; a < 2; ++a)
#pragma unroll
            for (int b = 0; b < 2; ++b)
#pragma unroll
                for (int m = 0; m < 4; ++m)
#pragma unroll
                    for (int n = 0; n < 2; ++n) acc[a][b][m][n] = (f32x4){0.f, 0.f, 0.f, 0.f};
        cur = nxt; cA = nA; cB = nB; ++ui;
        if constexpr (ALIGN_EPI) { if (wr == 1) PG8_BAR; }
    }
    PG8_WAIT_V(0);
    if constexpr (!ALIGN_EPI) { if (wr == 0) PG8_BAR; }
    PG8_BAR;
#undef PG8_SA
#undef PG8_SB
#undef PG8_STAGE
#undef PG8_LDA
#undef PG8_LDB
#undef PG8_MMA
#undef PG8_WAIT_V
#undef PG8_WAIT_L
#undef PG8_BAR
#undef PG8_SCHED
}
}

constexpr int D_MODEL = 1024, BATCH = 2, SEQ = 16384, M = BATCH * SEQ, NPROJ = 4096, AW = 512, NHEAD = 8;
constexpr int NWAVES = 8;
constexpr size_t MiB = 1u << 20;
constexpr size_t WS_CTL = 0, CTL_ZERO_BYTES = 32768;
#ifndef WS_SHIFT_MIB
#define WS_SHIFT_MIB 0
#endif
constexpr size_t WS_SH = (size_t)WS_SHIFT_MIB * MiB;
constexpr size_t WS_TBG = WS_SH + 1 * MiB;
constexpr size_t WS_WIN = WS_SH + 2 * MiB;
constexpr size_t WS_WOUT = WS_SH + 10 * MiB;
constexpr size_t WS_LP4 = WS_SH + 12 * MiB, WS_LP16 = WS_SH + 13 * MiB;
constexpr size_t WS_SBT = WS_SH + 14 * MiB, WS_SBG = WS_SH + 15 * MiB;
constexpr size_t WS_XN = WS_SH + 16 * MiB;
constexpr size_t WS_Q = WS_SH + 80 * MiB, WS_K = WS_SH + 112 * MiB, WS_V = WS_SH + 144 * MiB, WS_ZG = WS_SH + 176 * MiB;
constexpr size_t WS_OP4 = WS_XN, WS_OP16 = WS_XN + 32 * MiB;
constexpr size_t WS_Y = WS_SH + 208 * MiB;
constexpr size_t WS_END = WS_SH + 272 * MiB;
constexpr int CW_BAR = 4096;

constexpr int RING_OFF = 0, RING_BYTES = 131072;
constexpr int LDSCTL_OFF = 146432, MISC_OFF = LDSCTL_OFF + 320;
constexpr int LDS_BYTES = 147456;
constexpr int XL_OFF = 131072;
static_assert(XL_OFF + 10752 <= LDSCTL_OFF, "LDS map");

#define GAS __attribute__((address_space(1)))
#define LAS __attribute__((address_space(3)))
typedef unsigned short bf16;
typedef unsigned v4u __attribute__((ext_vector_type(4)));
typedef float f32x4 __attribute__((ext_vector_type(4)));
typedef float f32x16 __attribute__((ext_vector_type(16)));
typedef short bf16x8 __attribute__((ext_vector_type(8)));
typedef short s16x4 __attribute__((ext_vector_type(4)));
typedef GAS unsigned gu32;
#define RLX_AGENT __ATOMIC_RELAXED, __HIP_MEMORY_SCOPE_AGENT
#define LDS_WAIT() asm volatile("s_waitcnt lgkmcnt(0)" ::: "memory")
__device__ __forceinline__ unsigned f2bf(float f) { unsigned u = __builtin_bit_cast(unsigned, f); return (u + 0x7fffu + ((u >> 16) & 1u)) >> 16; }
__device__ __forceinline__ unsigned pk2(float lo, float hi) { return f2bf(lo) | (f2bf(hi) << 16); }
__device__ __forceinline__ float bf2f(unsigned short b) { return __builtin_bit_cast(float, (unsigned)b << 16); }
__device__ __forceinline__ float bflo(unsigned w) { return __builtin_bit_cast(float, w << 16); }
__device__ __forceinline__ float bfhi(unsigned w) { return __builtin_bit_cast(float, w & 0xffff0000u); }

#define XB_TMO      128
#define XB_XCNT(j)  (256  + 64 * (j))
#define XB_XSUB(j)  (1280 + 64 * (j))
#define XB_XGEN(j)  (2304 + 64 * (j))
#define XB_TOP      3328
#define XB_TOPGEN   3392
#define XCD_BAR_WORDS 3456
#define XB_SPIN_CAP (1u << 18)
__device__ __forceinline__ unsigned xb_ld(unsigned* p)              { return __hip_atomic_load(p, __ATOMIC_RELAXED, __HIP_MEMORY_SCOPE_AGENT); }
__device__ __forceinline__ unsigned xb_add(unsigned* p, unsigned v) { return __hip_atomic_fetch_add(p, v, __ATOMIC_RELAXED, __HIP_MEMORY_SCOPE_AGENT); }
__device__ __forceinline__ unsigned xb_xcc_id() { return (unsigned)__builtin_amdgcn_s_getreg((3 << 11) | 20) & 0xFu; }
#define XB_SPIN(cond, bar) do { unsigned _sp = 0; while (cond) { __builtin_amdgcn_s_sleep(1); \
    if ((++_sp & 255u) == 0u) { if (xb_ld(&(bar)[XB_TMO])) break; if (_sp > XB_SPIN_CAP) { atomicAdd(&(bar)[XB_TMO], 1u); break; } } } } while (0)
struct XcdBarrier { unsigned* bar; unsigned x; volatile LAS unsigned* st; };
__device__ __forceinline__ XcdBarrier xcd_barrier_post(unsigned* bar, volatile LAS unsigned* st) {
    XcdBarrier b; b.bar = bar; b.x = xb_xcc_id(); b.st = st;
    if (threadIdx.x == 0) (void)xb_add(&bar[XB_XCNT(b.x)], 1u);
    return b;
}
__device__ __forceinline__ void xcd_barrier_complete(unsigned* bar, unsigned x, unsigned& nloc, unsigned& nx) {
    const unsigned G = gridDim.x * gridDim.y * gridDim.z;
    unsigned sum, cnt, mine, sp = 0u;
    for (;;) {
        sum = 0u; cnt = 0u; mine = 0u;
#pragma unroll
        for (unsigned j = 0; j < 16; ++j) { const unsigned c = xb_ld(&bar[XB_XCNT(j)]); sum += c; cnt += (c > 0u) ? 1u : 0u; mine = (j == x) ? c : mine; }
        if (sum == G) break;
        __builtin_amdgcn_s_sleep(1);
        if ((++sp & 255u) == 0u) { if (xb_ld(&bar[XB_TMO])) break; if (sp > XB_SPIN_CAP) { atomicAdd(&bar[XB_TMO], 1u); break; } }
    }
    nloc = mine > 0u ? mine : 1u; nx = cnt > 0u ? cnt : 1u;
}
__device__ __forceinline__ void xcd_barrier(const XcdBarrier& b, const int wave) {
    asm volatile("s_waitcnt vmcnt(0)" ::: "memory");
    __syncthreads();
    if (wave == 0 && hw_lane() == 0) {
        unsigned* bar = b.bar;
        __builtin_amdgcn_s_waitcnt(0);
        unsigned nloc = b.st[0], nx = b.st[1];
        if (nloc == 0u) { xcd_barrier_complete(bar, b.x, nloc, nx); b.st[0] = nloc; b.st[1] = nx; }
        const unsigned old = xb_add(&bar[XB_XSUB(b.x)], 1u);
        const unsigned gen = old / nloc;
        if (old + 1u == (gen + 1u) * nloc) {
            __builtin_amdgcn_fence(__ATOMIC_RELEASE, "agent");
            asm volatile("s_waitcnt vmcnt(0)" ::: "memory");
            const unsigned og = xb_add(&bar[XB_TOP], 1u);
            const unsigned tg = og / nx;
            if (og + 1u == (tg + 1u) * nx) xb_add(&bar[XB_TOPGEN], 1u);
            else XB_SPIN(xb_ld(&bar[XB_TOPGEN]) == tg, bar);
            __builtin_amdgcn_fence(__ATOMIC_ACQUIRE, "agent");
            xb_add(&bar[XB_XGEN(b.x)], 1u);
            asm volatile("s_waitcnt vmcnt(0)" ::: "memory");
        } else {
            XB_SPIN(xb_ld(&bar[XB_XGEN(b.x)]) == gen, bar);
            __builtin_amdgcn_fence(__ATOMIC_ACQUIRE, "agent");
            asm volatile("s_waitcnt vmcnt(0)" ::: "memory");
        }
    }
    __syncthreads();
}

struct Frame {
    LAS unsigned char* lds;
    volatile LAS unsigned* MISC;
    gu32* ctl;
    int vcu, G, wave;
    const float *x, *norm_w, *w_in, *conv_w, *conv_b, *qw, *kw, *rel_bias, *w_out; float* out;
    bf16 *WinT, *WoutT, *XN, *Q, *K, *V, *ZG, *OP4, *OP16, *Y;
    float *TBG, *LP4, *LP16, *SBT, *SBG;
};
__device__ __forceinline__ float wave_sum(float v) {
#pragma unroll
    for (int o = 1; o < 64; o <<= 1) v += __shfl_xor(v, o);
    return v;
}
__device__ __forceinline__ float wave_max(float v) {
#pragma unroll
    for (int o = 1; o < 64; o <<= 1) v = fmaxf(v, __shfl_xor(v, o));
    return v;
}
__device__ __forceinline__ int win_row(int L) {
    int pn, wc, bj, n, fq, reg;
    if (L < 2048) { const int which = L >> 9, ch = L & 511; pn = ch >> 6; wc = (ch >> 4) & 3; fq = (ch >> 2) & 3; reg = ch & 3; bj = which >> 1; n = which & 1; }
    else { const int Lp = L - 2048, grp = Lp >> 9, head = (Lp >> 6) & 7, e = Lp & 63; pn = 8 + 2 * grp + (head >> 2); wc = head & 3; bj = e >> 5; fq = (e >> 3) & 3; n = (e >> 2) & 1; reg = e & 3; }
    return pn * 256 + 128 * bj + 32 * wc + 16 * n + 4 * fq + reg;
}
template <bool PERMUTE>
__device__ __forceinline__ void p0_transpose_item(const float* W, int K, int N, bf16* WT, LAS float* scr, int item, int lane) {
    const int nblk = N / 32, kb = item / nblk, nb = item % nblk, k0 = 64 * kb, n0 = 32 * nb;
#pragma unroll 8
    for (int i = 0; i < 32; ++i) { const int kk = 2 * i + (lane >> 5); scr[kk * 33 + (lane & 31)] = W[(size_t)(k0 + kk) * N + n0 + (lane & 31)]; }
    LDS_WAIT(); asm volatile("" ::: "memory");
    const int c = lane & 7;
#pragma unroll
    for (int j = 0; j < 4; ++j) { const int n = (lane >> 3) + 8 * j; const LAS float* s = scr + (8 * c) * 33 + n;
        v4u o; o.x = pk2(s[0 * 33], s[1 * 33]); o.y = pk2(s[2 * 33], s[3 * 33]); o.z = pk2(s[4 * 33], s[5 * 33]); o.w = pk2(s[6 * 33], s[7 * 33]);
        const int dr = PERMUTE ? win_row(n0 + n) : (n0 + n);
        *(GAS v4u*)(WT + (size_t)dr * K + k0 + 8 * c) = o; }
    LDS_WAIT(); asm volatile("" ::: "memory");
}
__device__ __forceinline__ int t5_bucket(int rel) {
    const int n = rel < 0 ? -rel : rel; int b = rel > 0 ? 16 : 0;
    if (n < 8) return b + n;
    int large = 8 + (int)(logf((float)n / 8.f) / logf(128.f) * 8.f);
    if (large > 15) large = 15;
    return b + large;
}
__device__ __forceinline__ void p0_prologue(Frame& F) {
    const int lane_l = hw_lane(), wave_l = F.wave, tid_l = wave_l * 64 + lane_l;
    LAS float* scr = (LAS float*)(F.lds + RING_OFF + wave_l * 16384);
    const int gw = F.vcu * NWAVES + wave_l, NGW = F.G * NWAVES;
    constexpr int I_IN = (D_MODEL / 64) * (NPROJ / 32), I_OUT = (D_MODEL / 64) * (D_MODEL / 32);
    for (int it = gw; it < I_IN + I_OUT; it += NGW) {
        if (it < I_IN) p0_transpose_item<true>(F.w_in, D_MODEL, NPROJ, F.WinT, scr, it, lane_l);
        else p0_transpose_item<false>(F.w_out, D_MODEL, D_MODEL, F.WoutT, scr, it - I_IN, lane_l);
    }
    f32x4 nw[4];
#pragma unroll
    for (int j = 0; j < 4; ++j) nw[j] = ((const f32x4*)F.norm_w)[lane_l + 64 * j];
    for (int m = gw; m < M; m += NGW) {
        const GAS f32x4* xr = (const GAS f32x4*)(F.x + (size_t)m * D_MODEL) + lane_l;
        f32x4 v[4]; float s = 0.f;
#pragma unroll
        for (int j = 0; j < 4; ++j) { v[j] = xr[64 * j]; s += (v[j].x * v[j].x + v[j].y * v[j].y) + (v[j].z * v[j].z + v[j].w * v[j].w); }
        const float rstd = 1.f / sqrtf(wave_sum(s) * (1.f / D_MODEL) + 1e-6f);
        GAS unsigned long long* o8 = (GAS unsigned long long*)(F.XN + (size_t)m * D_MODEL) + lane_l;
#pragma unroll
        for (int j = 0; j < 4; ++j) { const f32x4 y = v[j] * rstd * nw[j]; o8[64 * j] = (unsigned long long)pk2(y.x, y.y) | ((unsigned long long)pk2(y.z, y.w) << 32); }
    }
    if (blockIdx.x == 0) {
        const float mq = wave_max(fabsf(F.qw[lane_l])), mk = wave_max(fabsf(F.kw[lane_l]));
        float mb = 0.f;
#pragma unroll
        for (int j = 0; j < 4; ++j) mb = fmaxf(mb, fabsf(F.rel_bias[lane_l + 64 * j]));
        mb = wave_max(mb);
        const float M2 = (8.f * mq * mk + mb) * 1.4426950408889634f;
        for (int i = tid_l; i < 3 * 8 * 192; i += NWAVES * 64) {
            const int jp = i % 192, h = (i / 192) & 7, c = i / (192 * 8), j = jp - 32;
            const int dil = c == 0 ? 1 : (c == 1 ? 4 : 16);
            float v = -1e30f;
            if (j >= 0 && j <= 128) v = F.rel_bias[t5_bucket((j - 64) * dil) * 8 + h] * 1.4426950408889634f - M2;
            F.TBG[i] = v;
        }
    }
}

__device__ __forceinline__ int crow(int r, int hi) { return (r & 3) + 8 * (r >> 2) + 4 * hi; }
__device__ __forceinline__ unsigned cvtpk_s(float lo, float hi) { typedef float f2 __attribute__((ext_vector_type(2))); typedef __bf16 b2 __attribute__((ext_vector_type(2))); f2 v = {lo, hi}; b2 b = __builtin_convertvector(v, b2); return __builtin_bit_cast(unsigned, b); }
typedef short v4i16_t __attribute__((ext_vector_type(4)));
__device__ __forceinline__ s16x4 vtr(LAS const unsigned char* p) { return __builtin_bit_cast(s16x4, __builtin_amdgcn_ds_read_tr16_b64_v4i16((LAS v4i16_t*)p)); }

constexpr int AT_TILE = 8448, AT_KCH = 528, AT_VOFF = 4224, AT_VPC = 1056, AT_NT = 12;
constexpr int AT_OST = AT_NT * AT_TILE;
constexpr int AT_TBL = AT_OST + NWAVES * 4096;
constexpr int AT_LW = AT_TBL + 768;
static_assert(AT_LW + NWAVES * 128 <= LDSCTL_OFF, "attention LDS map");
struct TaskD { int dil, L, i0, hq, c, h, tok0; };
template <bool FINAL>
__device__ __forceinline__ TaskD unit_decode(int vcu, int i) {
    TaskD D; const int x = vcu >> 5, j = vcu & 31;
    int pair, r, blk;
    if (FINAL) { pair = 2 * x + (i >> 1); r = 0; blk = 2 * j + (i & 1); D.c = 0; D.dil = 1; D.L = SEQ; }
    else { pair = 2 * x + (i >> 2); const int k = i & 3;
        if (j < 16) { D.c = 1; D.dil = 4; D.L = SEQ / 4; r = j >> 2; blk = 4 * (j & 3) + k; } else { D.c = 2; D.dil = 16; D.L = SEQ / 16; r = j - 16; blk = k; } }
    D.h = pair & 7; D.hq = D.h * 64; D.tok0 = (pair >> 3) * SEQ + r; D.i0 = blk * 256;
    return D;
}
#define AT_BAR() do { asm volatile("s_waitcnt lgkmcnt(0)" ::: "memory"); __builtin_amdgcn_s_barrier(); asm volatile("" ::: "memory"); } while (0)
template <bool FINAL>
__device__ __forceinline__ void attn_units(Frame& F) {
    constexpr int u0 = 0, u1 = FINAL ? 4 : 8;
    const int lane = hw_lane(), w = F.wave, tid_l = w * 64 + lane, r32 = lane & 31, hi = lane >> 5;
    LAS unsigned char* L0 = F.lds;
    LAS unsigned short* stgb = (LAS unsigned short*)(F.lds + AT_OST + w * 4096);
    LAS float* tbl = (LAS float*)(F.lds + AT_TBL);
    LAS float* lw = (LAS float*)(F.lds + AT_LW) + w * 32;
    const int vaddr = AT_VOFF + ((lane >> 4) & 1) * 32 + (lane & 3) * 8 + (4 * hi + ((lane & 15) >> 2)) * 64;
    const bool isV = w >= 4; const int srow = 8 * (w & 3) + (lane >> 3), sch = lane & 7;
    const int sdst = isV ? (AT_VOFF + (sch >> 2) * (2 * AT_VPC) + (srow >> 4) * AT_VPC + (srow & 15) * 64 + (sch & 3) * 16) : (sch * AT_KCH + srow * 16);
    const bf16* ssrc = isV ? F.V : F.K;
    bf16x8 st[AT_NT], qr[4];
#define STAGE_LOAD(D_) do { _Pragma("unroll") for (int t_ = 0; t_ < AT_NT; ++t_) { int key_ = (D_).i0 - 64 + 32 * t_ + srow; key_ = key_ < 0 ? 0 : (key_ > (D_).L - 1 ? (D_).L - 1 : key_); \
        st[t_] = *(const bf16x8*)(ssrc + (unsigned)(((D_).tok0 + (D_).dil * key_) * AW + (D_).hq + sch * 8)); } } while (0)
#define LOADQN(D_) do { const unsigned qo_ = (unsigned)(((D_).tok0 + (D_).dil * ((D_).i0 + 32 * w + r32)) * AW + (D_).hq + hi * 8); \
        _Pragma("unroll") for (int d0 = 0; d0 < 4; ++d0) qr[d0] = *(const bf16x8*)(F.Q + qo_ + d0 * 16); } while (0)
#define SBAR() __builtin_amdgcn_sched_barrier(0)
#define LDK(kc, KF) do { const LAS unsigned char* tk_ = L0 + (w + (kc)) * AT_TILE + hi * AT_KCH + r32 * 16; \
        _Pragma("unroll") for (int d0 = 0; d0 < 4; ++d0) KF[d0] = *(const LAS bf16x8*)(tk_ + 2 * d0 * AT_KCH); } while (0)
#define LDT(kc, A) do { const int k0_ = i0w - 64 + 32 * (kc);     \
        const LAS float* tp_ = tbl + ((k0_ >= 0 && k0_ < D.L) ? (32 + 32 * (kc) + 4 * hi - r32) : 0); \
        _Pragma("unroll") for (int rr = 0; rr < 16; ++rr) A[rr] = tp_[(rr & 3) + 8 * (rr >> 2)]; } while (0)
#define LDVH(kc, h) do { const LAS unsigned char* vb_ = L0 + (w + (kc)) * AT_TILE + vaddr; \
        _Pragma("unroll") for (int pc = 2 * (h); pc < 2 * (h) + 2; ++pc) { vl[pc] = vtr(vb_ + pc * AT_VPC); vh[pc] = vtr(vb_ + pc * AT_VPC + 512); } } while (0)
#define LDV(kc) do { LDVH(kc, 0); LDVH(kc, 1); } while (0)
#define VFR(pc) (bf16x8){vl[pc][0], vl[pc][1], vl[pc][2], vl[pc][3], vh[pc][0], vh[pc][1], vh[pc][2], vh[pc][3]}
#define SMM(KF, A) do { _Pragma("unroll") for (int d0 = 0; d0 < 4; ++d0) A = __builtin_amdgcn_mfma_f32_32x32x16_bf16(KF[d0], qr[d0], A, 0, 0, 0); } while (0)
#define EXPK(A) do { _Pragma("unroll") for (int rr = 0; rr < 16; ++rr) A[rr] = __builtin_amdgcn_exp2f(A[rr]); \
        ls0 += (A[0] + A[1]) + (A[2] + A[3]); ls1 += (A[4] + A[5]) + (A[6] + A[7]); ls2 += (A[8] + A[9]) + (A[10] + A[11]); ls3 += (A[12] + A[13]) + (A[14] + A[15]); \
        pw0.x = cvtpk_s(A[0], A[1]); pw0.y = cvtpk_s(A[2], A[3]); pw0.z = cvtpk_s(A[4], A[5]); pw0.w = cvtpk_s(A[6], A[7]); \
        pw1.x = cvtpk_s(A[8], A[9]); pw1.y = cvtpk_s(A[10], A[11]); pw1.z = cvtpk_s(A[12], A[13]); pw1.w = cvtpk_s(A[14], A[15]); } while (0)
#define PVM() do { \
        o0 = __builtin_amdgcn_mfma_f32_32x32x16_bf16(__builtin_bit_cast(bf16x8, pw0), VFR(0), o0, 0, 0, 0); \
        o0 = __builtin_amdgcn_mfma_f32_32x32x16_bf16(__builtin_bit_cast(bf16x8, pw1), VFR(1), o0, 0, 0, 0); \
        o1 = __builtin_amdgcn_mfma_f32_32x32x16_bf16(__builtin_bit_cast(bf16x8, pw0), VFR(2), o1, 0, 0, 0); \
        o1 = __builtin_amdgcn_mfma_f32_32x32x16_bf16(__builtin_bit_cast(bf16x8, pw1), VFR(3), o1, 0, 0, 0); } while (0)
#define CHUNK1(kc) do { LDVH(kc, 0); SBAR(); SMM(kf, aA); SBAR(); LDVH(kc, 1); if ((kc) < 4) { LDK((kc) + 1, kf); SBAR(); } else { LOADQN(Dn); SBAR(); } EXPK(aA); SBAR(); if ((kc) < 4) { LDT((kc) + 1, aA); SBAR(); } PVM(); SBAR(); } while (0)
#define CHUNKS() do { LDK(0, kf); LDT(0, aA); SBAR(); CHUNK1(0); CHUNK1(1); CHUNK1(2); CHUNK1(3); CHUNK1(4); } while (0)
    TaskD D = unit_decode<FINAL>(F.vcu, u0);
    STAGE_LOAD(D); LOADQN(D);
    int tb_ch = -1;
    for (int u = u0; u < u1; ++u) {
        const TaskD Dn = unit_decode<FINAL>(F.vcu, u + 1 < u1 ? u + 1 : u);
        AT_BAR();
#pragma unroll
        for (int t_ = 0; t_ < AT_NT; ++t_) *(LAS bf16x8*)(L0 + t_ * AT_TILE + sdst) = st[t_];
        if (tb_ch != D.c * 8 + D.h) { tb_ch = D.c * 8 + D.h; if (tid_l < 192) tbl[tid_l] = F.TBG[tb_ch * 192 + tid_l]; }
        AT_BAR();
        STAGE_LOAD(Dn);
        const int i0w = D.i0 + 32 * w;
        v4u p4[4], p16[4], zg[4]; float l4[4], l16[4];
#define FIN_LOAD(i) do { const int row = (i) * 8 + (lane >> 3), ch = lane & 7; const unsigned tok = (unsigned)(D.tok0 + i0w + row); const unsigned eo = tok * AW + D.hq + ch * 8; \
            p4[i] = *(const v4u*)(F.OP4 + eo); p16[i] = *(const v4u*)(F.OP16 + eo); zg[i] = *(const v4u*)(F.ZG + eo); l4[i] = F.LP4[tok * 8 + D.h]; l16[i] = F.LP16[tok * 8 + D.h]; } while (0)
        if (false) { FIN_LOAD(0); }
        f32x16 o0 = {}, o1 = {}, aA; float ls0 = 0.f, ls1 = 0.f, ls2 = 0.f, ls3 = 0.f; bf16x8 kf[4]; s16x4 vl[4], vh[4]; v4u pw0, pw1;
        CHUNKS();
        float lsum = (ls0 + ls1) + (ls2 + ls3);
        lsum += __shfl_xor(lsum, 32);
#pragma unroll
        for (int rr = 0; rr < 16; rr += 2) {
            const unsigned a01 = cvtpk_s(o0[rr], o0[rr + 1]), b01 = cvtpk_s(o1[rr], o1[rr + 1]);
            const int q0 = crow(rr, hi), q1 = crow(rr + 1, hi);
            stgb[q0 * 64 + r32] = (unsigned short)(a01 & 0xffffu); stgb[q1 * 64 + r32] = (unsigned short)(a01 >> 16);
            stgb[q0 * 64 + 32 + r32] = (unsigned short)(b01 & 0xffffu); stgb[q1 * 64 + 32 + r32] = (unsigned short)(b01 >> 16);
        }
        if (FINAL) { if (hi == 0) lw[r32] = lsum; FIN_LOAD(0); FIN_LOAD(1); FIN_LOAD(2); FIN_LOAD(3); }
        else { if (hi == 0) { float* lp = F.LP4 + (size_t)(D.c - 1) * (size_t)(256u << 10) + (unsigned)((D.tok0 + D.dil * (i0w + r32)) * 8 + D.h); *lp = lsum; } }
#pragma unroll
        for (int i = 0; i < 4; ++i) {
            const int row = i * 8 + (lane >> 3), ch = lane & 7;
            const unsigned tok = (unsigned)(D.tok0 + D.dil * (i0w + row));
            const v4u ov = *(const LAS v4u*)(stgb + row * 64 + ch * 8);
            if (!FINAL) {
                *(v4u*)(F.OP4 + (size_t)(D.c - 1) * (size_t)(16u << 20) + (tok * AW + D.hq + ch * 8)) = ov;
            } else {
                const float inv = 1.f / (lw[row] + l4[i] + l16[i]);
                float y[8];
#define SZ(x) pg8::silu_f(x)
                y[0] = (bflo(ov.x) + bflo(p4[i].x) + bflo(p16[i].x)) * inv * SZ(bflo(zg[i].x)); y[1] = (bfhi(ov.x) + bfhi(p4[i].x) + bfhi(p16[i].x)) * inv * SZ(bfhi(zg[i].x));
                y[2] = (bflo(ov.y) + bflo(p4[i].y) + bflo(p16[i].y)) * inv * SZ(bflo(zg[i].y)); y[3] = (bfhi(ov.y) + bfhi(p4[i].y) + bfhi(p16[i].y)) * inv * SZ(bfhi(zg[i].y));
                y[4] = (bflo(ov.z) + bflo(p4[i].z) + bflo(p16[i].z)) * inv * SZ(bflo(zg[i].z)); y[5] = (bfhi(ov.z) + bfhi(p4[i].z) + bfhi(p16[i].z)) * inv * SZ(bfhi(zg[i].z));
                y[6] = (bflo(ov.w) + bflo(p4[i].w) + bflo(p16[i].w)) * inv * SZ(bflo(zg[i].w)); y[7] = (bfhi(ov.w) + bfhi(p4[i].w) + bfhi(p16[i].w)) * inv * SZ(bfhi(zg[i].w));
#undef SZ
                v4u wv; wv.x = cvtpk_s(y[0], y[1]); wv.y = cvtpk_s(y[2], y[3]); wv.z = cvtpk_s(y[4], y[5]); wv.w = cvtpk_s(y[6], y[7]);
                *(v4u*)(F.Y + (tok * D_MODEL + 512 + D.hq + ch * 8)) = wv;
            }
        }
        D = Dn;
    }
    AT_BAR();
#undef STAGE_LOAD
#undef LOADQN
#undef SBAR
#undef LDK
#undef LDT
#undef LDV
#undef LDVH
#undef VFR
#undef SMM
#undef EXPK
#undef PVM
#undef CHUNK1
#undef CHUNKS
#undef FIN_LOAD
}
__device__ __forceinline__ void conv_fixup_row(Frame& F, int idx, int lane) {
    const int pm = idx >> 1, last = idx & 1;
    const float* tcp = F.SBT + (size_t)(pm * 4 + (last ? 3 : 0)) * 512 + 8 * lane;
    const bool hasp = last || (pm % (SEQ / 256) != 0), hasn = !last || (pm % (SEQ / 256) != SEQ / 256 - 1);
    const float* tpp = last ? F.SBT + (size_t)(pm * 4 + 2) * 512 + 8 * lane : F.SBT + (size_t)((hasp ? pm - 1 : pm) * 4 + 3) * 512 + 8 * lane;
    const float* tnp = last ? F.SBT + (size_t)((hasn ? pm + 1 : pm) * 4 + 0) * 512 + 8 * lane : F.SBT + (size_t)(pm * 4 + 1) * 512 + 8 * lane;
    const float* gp = F.SBG + (size_t)(pm * 2 + last) * 512 + 8 * lane;
    float y[8];
#pragma unroll
    for (int i = 0; i < 8; ++i) {
        const float tp = hasp ? tpp[i] : 0.f, tn = hasn ? tnp[i] : 0.f;
        y[i] = gp[i] * (F.conv_w[8 * lane + i] * tp + F.conv_w[512 + 8 * lane + i] * tcp[i] + F.conv_w[1024 + 8 * lane + i] * tn + F.conv_b[8 * lane + i]);
    }
    v4u w; w.x = cvtpk_s(y[0], y[1]); w.y = cvtpk_s(y[2], y[3]); w.z = cvtpk_s(y[4], y[5]); w.w = cvtpk_s(y[6], y[7]);
    *(v4u*)(F.Y + (size_t)(pm * 256 + (last ? 255 : 0)) * D_MODEL + 8 * lane) = w;
}
__device__ __forceinline__ void attn_pass_a(Frame& F) {
    attn_units<false>(F);
    const int gw = F.vcu * NWAVES + F.wave, NGW = F.G * NWAVES;
    for (int idx = gw; idx < 2 * (M / 256); idx += NGW) conv_fixup_row(F, idx, hw_lane());
}
__device__ __forceinline__ void attn_pass_b(Frame& F) {
    attn_units<true>(F);
}

struct Args { const float* in[9]; float* out; unsigned char* ws; int ph_lo, ph_hi; };
__global__ void __launch_bounds__(NWAVES * 64, 2) mega(Args args) {
    extern __shared__ __attribute__((aligned(16))) unsigned char lds[];
    Frame F;
    F.lds = (LAS unsigned char*)lds;
    F.MISC = (volatile LAS unsigned*)(F.lds + MISC_OFF);
    F.wave = __builtin_amdgcn_readfirstlane((int)threadIdx.x >> 6); F.G = gridDim.x; { const int bx = blockIdx.x; F.vcu = (F.G % 8 == 0) ? (bx % 8) * (F.G / 8) + bx / 8 : bx; }
    unsigned char* ws = args.ws;
    F.ctl = (gu32*)(ws + WS_CTL);
    F.x = args.in[0]; F.norm_w = args.in[1]; F.w_in = args.in[2]; F.conv_w = args.in[3]; F.conv_b = args.in[4]; F.qw = args.in[5]; F.kw = args.in[6]; F.rel_bias = args.in[7]; F.w_out = args.in[8];
    F.out = args.out;
    F.WinT = (bf16*)(ws + WS_WIN); F.WoutT = (bf16*)(ws + WS_WOUT); F.XN = (bf16*)(ws + WS_XN);
    F.SBT = (float*)(ws + WS_SBT); F.SBG = (float*)(ws + WS_SBG); F.Q = (bf16*)(ws + WS_Q); F.K = (bf16*)(ws + WS_K); F.V = (bf16*)(ws + WS_V); F.ZG = (bf16*)(ws + WS_ZG);
    F.OP4 = (bf16*)(ws + WS_OP4); F.OP16 = (bf16*)(ws + WS_OP16); F.Y = (bf16*)(ws + WS_Y);
    F.TBG = (float*)(ws + WS_TBG); F.LP4 = (float*)(ws + WS_LP4); F.LP16 = (float*)(ws + WS_LP16);
    for (int u = threadIdx.x; u < (LDS_BYTES - LDSCTL_OFF) / 4; u += NWAVES * 64) ((LAS unsigned*)(F.lds + LDSCTL_OFF))[u] = 0u;
    __syncthreads();
    const int lo = args.ph_lo, hi = args.ph_hi;
    const bool multi = (hi - lo) > 1;
    XcdBarrier bar; bar.bar = (unsigned*)(F.ctl + CW_BAR); bar.x = 0; bar.st = nullptr;
    if (multi) bar = xcd_barrier_post((unsigned*)(F.ctl + CW_BAR), F.MISC + 8);
#define IN(k) (lo <= (k) && (k) < hi)
#define BOTH(k) (IN(k) && IN((k) + 1))
    if (IN(0)) { p0_prologue(F); if (BOTH(0)) xcd_barrier(bar, F.wave); }
    if (IN(1)) {
        pg8::Gemm g{F.XN, F.WinT, M, NPROJ, D_MODEL}; pg8::StaticOrder S; S.init(M, NPROJ, F.G, (int)blockIdx.x);
        { LAS float* cwl = (LAS float*)(F.lds + XL_OFF + 2048);
          const int tl = F.wave * 64 + hw_lane();
          for (int i = tl; i < 2048; i += NWAVES * 64) cwl[i] = i < 1536 ? F.conv_w[i] : F.conv_b[i - 1536];
          if (tl < 128) cwl[2048 + tl] = tl < 64 ? F.qw[tl] : F.kw[tl - 64];
          __syncthreads(); }
        pg8::EpiProj E{F.Y, F.Q, F.SBT, F.SBG, F.lds + XL_OFF};
        pg8::gemm_phase<pg8::EpiProj, pg8::StaticOrder, true, true>(F.lds + RING_OFF, g, S, E, F.wave);
        if (BOTH(1)) xcd_barrier(bar, F.wave);
    }
    if (IN(2)) { attn_pass_a(F); if (BOTH(2)) xcd_barrier(bar, F.wave); }
    if (IN(3)) { attn_pass_b(F); if (BOTH(3)) xcd_barrier(bar, F.wave); }
    if (IN(4)) {
        pg8::Gemm g{F.Y, F.WoutT, M, D_MODEL, D_MODEL}; pg8::StaticOrder S; S.init(M, D_MODEL, F.G, (int)blockIdx.x);
        pg8::EpiRes E{F.x, F.out, D_MODEL};
        pg8::gemm_phase<pg8::EpiRes, pg8::StaticOrder, true, true>(F.lds + RING_OFF, g, S, E, F.wave);
    }
#undef IN
#undef BOTH
}

extern "C" void kernel_launch(void* const* d_in, const int* in_sizes, int n_in, void* d_out, int out_size, void* d_ws, size_t ws_size, hipStream_t stream) {
    static int grid = 0;
    if (grid == 0) {
        if (n_in != 9 || in_sizes[0] != M * D_MODEL || out_size != M * D_MODEL || ws_size < WS_END) { fprintf(stderr, "kernel_launch: unexpected shapes (n_in %d, in0 %d, out %d, ws %zu)\n", n_in, n_in > 0 ? in_sizes[0] : -1, out_size, ws_size); grid = -1; return; }
        int dev = 0, cus = 0, per_cu = 0;
        if (hipGetDevice(&dev) != hipSuccess || hipDeviceGetAttribute(&cus, hipDeviceAttributeMultiprocessorCount, dev) != hipSuccess) { grid = -1; return; }
        if (hipFuncSetAttribute((const void*)mega, hipFuncAttributeMaxDynamicSharedMemorySize, LDS_BYTES) != hipSuccess) { fprintf(stderr, "kernel_launch: hipFuncSetAttribute failed\n"); grid = -1; return; }
        if (hipOccupancyMaxActiveBlocksPerMultiprocessor(&per_cu, (const void*)mega, NWAVES * 64, LDS_BYTES) != hipSuccess || per_cu < 1) { fprintf(stderr, "kernel_launch: occupancy query says %d blocks per CU\n", per_cu); (void)hipGetLastError(); grid = -1; return; }
        grid = cus;
        if (grid != 256) { fprintf(stderr, "kernel_launch: built for a 256-CU device (got %d CUs)\n", cus); grid = -1; return; }
    }
    if (grid < 0) return;
    (void)hipMemsetAsync((char*)d_ws + WS_CTL, 0, CTL_ZERO_BYTES, stream);
    Args a{};
    for (int i = 0; i < 9; ++i) a.in[i] = (const float*)d_in[i];
    a.out = (float*)d_out; a.ws = (unsigned char*)d_ws;
    unsigned char* ws = (unsigned char*)d_ws;
#if STAGE == 4
    a.ph_lo = 0; a.ph_hi = 5;
    hipLaunchKernelGGL(mega, dim3(grid), dim3(NWAVES * 64), LDS_BYTES, stream, a);
    if (PROBE_PHASE >= 0) { a.ph_lo = PROBE_PHASE; a.ph_hi = PROBE_PHASE + 1; hipLaunchKernelGGL(mega, dim3(grid), dim3(NWAVES * 64), LDS_BYTES, stream, a); }
#else
    const int nper = 5;
    for (int p = 0; p < nper; ++p) { a.ph_lo = p; a.ph_hi = p + 1; hipLaunchKernelGGL(mega, dim3(grid), dim3(NWAVES * 64), LDS_BYTES, stream, a); }
#endif
}
```

```cpp
#include <hip/hip_runtime.h>
#include <cstdio>
#include <cstdint>

#ifndef PROBE_PHASE
#define PROBE_PHASE -1
#endif
#ifndef STAGE
#define STAGE 4
#endif

__device__ __forceinline__ int hw_lane() { return (int)__builtin_amdgcn_mbcnt_hi(~0u, __builtin_amdgcn_mbcnt_lo(~0u, 0u)); }

namespace pg8 {
#define PG8_LAS __attribute__((address_space(3)))
typedef unsigned short bf16_t;
typedef short bf16x8 __attribute__((ext_vector_type(8)));
typedef float f32x4 __attribute__((ext_vector_type(4)));
typedef unsigned u32x4 __attribute__((ext_vector_type(4)));
typedef unsigned u32x2 __attribute__((ext_vector_type(2)));
constexpr int BM = 256, BK = 64, HALF = 128, HTB = HALF * BK * 2, STAGE_BYTES = 8 * HTB, NXCD = 8, WGM = 8;

__host__ __device__ __forceinline__ int lds_byte(int r, int c) { const int st = (r >> 4) * 2 + (c >> 5), rr = r & 15, cc = c & 31, ob = rr * 64 + cc * 2; return st * 1024 + (ob ^ (((ob >> 9) & 1) << 5)); }
__host__ __device__ __forceinline__ void stage_rc(int b, int& R, int& C) { const int st = b / 1024, sb = b % 1024, swz = sb ^ (((sb >> 9) & 1) << 5); R = (st >> 1) * 16 + swz / 64; C = (st & 1) * 32 + (swz % 64) / 2; }

struct Unit { int pm, pn; };
struct Gemm { const bf16_t* A; const bf16_t* Bt; int M, N, K; };

struct StaticOrder {
    int nM, nN, nwg, G, c;
    __host__ __device__ void init(int M, int N, int G_, int c_) { nM = M / BM; nN = N / BM; nwg = nM * nN; G = G_; c = c_; }
    __host__ __device__ bool next(int i, Unit& u) const {
        const long L = (long)i * G + c; if (L >= nwg) return false;
        int wgid = (int)L; { const int q = nwg / NXCD, r = nwg % NXCD, xcd = wgid % NXCD, off = wgid / NXCD; wgid = (xcd < r ? xcd * (q + 1) : r * (q + 1) + (xcd - r) * q) + off; }
        const int nig = WGM * nN, gid = wgid / nig, fm = gid * WGM, gsz = (nM - fm) < WGM ? (nM - fm) : WGM;
        u.pm = fm + ((wgid % nig) % gsz); u.pn = (wgid % nig) / gsz; return true;
    }
};

__device__ __forceinline__ unsigned cvt_pk_bf16(float lo, float hi) { unsigned r; asm volatile("v_cvt_pk_bf16_f32 %0, %1, %2" : "=v"(r) : "v"(lo), "v"(hi)); return r; }
__device__ __forceinline__ float silu_f(float z) { return z * __builtin_amdgcn_rcpf(1.f + __builtin_amdgcn_exp2f(-1.4426950408889634f * z)); }

struct EpiProj {
    static constexpr bool PERM = false, AFTER_DRAIN = false, XPRE = false;
    bf16_t *Y, *QKVZ; float *SBT, *SBG; PG8_LAS unsigned char* xl;
    __device__ __forceinline__ void operator()(const f32x4 (&acc)[2][2][4][2], const Unit& u, int wr, int wc, int fr, int fq) const {
        const int row0 = u.pm * BM + wr * 64 + fr;
        if (u.pn < 8) {
            const int lane = fr + 16 * fq, chl = 16 * wc + 4 * fq, ch0 = 64 * u.pn + chl;
            PG8_LAS float* X = (PG8_LAS float*)xl;
            const PG8_LAS float* CWl = (const PG8_LAS float*)(xl + 2048);
            f32x4 t[2][4], g[2][4];
#pragma unroll
            for (int ai = 0; ai < 2; ++ai)
#pragma unroll
                for (int m = 0; m < 4; ++m) {
                    const f32x4 uu = acc[ai][0][m][0], gb = acc[ai][0][m][1], gc = acc[ai][1][m][0], z = acc[ai][1][m][1];
                    t[ai][m] = gc * uu;
#pragma unroll
                    for (int i = 0; i < 4; ++i) g[ai][m][i] = gb[i] * silu_f(z[i]);
                }
#pragma unroll
            for (int ai = 0; ai < 2; ++ai) { const int grpi = 2 * ai + wr;
                if (fr == 0) *(PG8_LAS f32x4*)(X + (grpi * 2 + 0) * 64 + chl) = t[ai][0];
                if (fr == 15) *(PG8_LAS f32x4*)(X + (grpi * 2 + 1) * 64 + chl) = t[ai][3]; }
            if (wr == 0 && fr < 2) { *(f32x4*)(SBT + ((size_t)(u.pm * 4 + fr) * 512 + ch0)) = t[0][0]; if (fr == 0) *(f32x4*)(SBG + ((size_t)(u.pm * 2 + 0) * 512 + ch0)) = g[0][0]; }
            if (wr == 1 && fr >= 14) { *(f32x4*)(SBT + ((size_t)(u.pm * 4 + fr - 12) * 512 + ch0)) = t[1][3]; if (fr == 15) *(f32x4*)(SBG + ((size_t)(u.pm * 2 + 1) * 512 + ch0)) = g[1][3]; }
            asm volatile("s_waitcnt lgkmcnt(0)" ::: "memory"); __builtin_amdgcn_s_barrier(); asm volatile("" ::: "memory");
            const f32x4 w0 = *(const PG8_LAS f32x4*)(CWl + ch0), w1 = *(const PG8_LAS f32x4*)(CWl + 512 + ch0), w2 = *(const PG8_LAS f32x4*)(CWl + 1024 + ch0), cb = *(const PG8_LAS f32x4*)(CWl + 1536 + ch0);
#pragma unroll
            for (int ai = 0; ai < 2; ++ai) { const int grpi = 2 * ai + wr;
                const f32x4 xprev = *(const PG8_LAS f32x4*)(X + (((grpi + 3) & 3) * 2 + 1) * 64 + chl), xnext = *(const PG8_LAS f32x4*)(X + (((grpi + 1) & 3) * 2 + 0) * 64 + chl);
#pragma unroll
                for (int m = 0; m < 4; ++m) {
                    const f32x4 ps = m > 0 ? t[ai][m - 1] : xprev, ns = m < 3 ? t[ai][m + 1] : xnext, tc = t[ai][m];
                    f32x4 tp, tn;
#pragma unroll
                    for (int i = 0; i < 4; ++i) {
                        tp[i] = __builtin_bit_cast(float, __builtin_amdgcn_update_dpp(0, __builtin_bit_cast(int, fr == 15 ? ps[i] : tc[i]), 0x121, 0xf, 0xf, false));
                        tn[i] = __builtin_bit_cast(float, __builtin_amdgcn_update_dpp(0, __builtin_bit_cast(int, fr == 0 ? ns[i] : tc[i]), 0x12F, 0xf, 0xf, false)); }
                    const f32x4 y = g[ai][m] * (w0 * tp + w1 * tc + w2 * tn + cb);
                    const int rt = 128 * ai + 64 * wr + 16 * m + fr;
                    u32x2 yw; yw.x = cvt_pk_bf16(y[0], y[1]); yw.y = cvt_pk_bf16(y[2], y[3]);
                    if (rt != 0 && rt != 255) *(u32x2*)(Y + (size_t)(u.pm * BM + rt) * 1024 + ch0) = yw;
                }
            }
        } else {
            const int grp = (u.pn - 8) >> 1, head = 4 * ((u.pn - 8) & 1) + wc;
            bf16_t* dst = QKVZ + (size_t)grp * (size_t)(16u << 20);
            const int col0 = head * 64 + 8 * fq;
            f32x4 wv[2][2];
            if (grp < 2) { const PG8_LAS float* w = (const PG8_LAS float*)(xl + 10240) + 64 * grp;
#pragma unroll
                for (int bj = 0; bj < 2; ++bj)
#pragma unroll
                    for (int n = 0; n < 2; ++n) wv[bj][n] = *(const PG8_LAS f32x4*)(w + 32 * bj + 8 * fq + 4 * n); }
            const float sc = grp == 0 ? 0.125f * 1.4426950408889634f : 1.f;
#pragma unroll
            for (int ai = 0; ai < 2; ++ai)
#pragma unroll
                for (int m = 0; m < 4; ++m) {
                    f32x4 v[2][2];
#pragma unroll
                    for (int bj = 0; bj < 2; ++bj)
#pragma unroll
                        for (int n = 0; n < 2; ++n) v[bj][n] = acc[ai][bj][m][n];
                    if (grp < 2) {
                        float ss = 0.f;
#pragma unroll
                        for (int bj = 0; bj < 2; ++bj)
#pragma unroll
                            for (int n = 0; n < 2; ++n) ss += (v[bj][n][0] * v[bj][n][0] + v[bj][n][1] * v[bj][n][1]) + (v[bj][n][2] * v[bj][n][2] + v[bj][n][3] * v[bj][n][3]);
                        ss += __shfl_xor(ss, 16); ss += __shfl_xor(ss, 32);
                        const float rs = __builtin_amdgcn_rsqf(ss * (1.f / 64.f) + 1e-6f) * sc;
#pragma unroll
                        for (int bj = 0; bj < 2; ++bj)
#pragma unroll
                            for (int n = 0; n < 2; ++n) v[bj][n] = v[bj][n] * rs * wv[bj][n];
                    }
                    bf16_t* rowp = dst + (size_t)(row0 + ai * HALF + m * 16) * 512 + col0;
#pragma unroll
                    for (int bj = 0; bj < 2; ++bj) { u32x4 w; w.x = cvt_pk_bf16(v[bj][0][0], v[bj][0][1]); w.y = cvt_pk_bf16(v[bj][0][2], v[bj][0][3]); w.z = cvt_pk_bf16(v[bj][1][0], v[bj][1][1]); w.w = cvt_pk_bf16(v[bj][1][2], v[bj][1][3]);
                        *(u32x4*)(rowp + 32 * bj) = w; }
                }
        }
    }
};
struct EpiRes {
    static constexpr bool PERM = false, AFTER_DRAIN = false, XPRE = true;
    const float* X; float* O; int ldc;
    __device__ __forceinline__ void xissue(const Unit& u, int it, int wr, int wc, int fr, int fq, f32x4 (&xv)[4]) const {
        const int ai = it >> 2, bj = (it >> 1) & 1, m0 = 2 * (it & 1);
        const float* ba = X + ((size_t)(u.pm * BM + ai * HALF + m0 * 16) * ldc + u.pn * BM + bj * HALF);
        const float* bb = ba + (size_t)16 * ldc;
        const unsigned voff = (unsigned)(((wr * 64 + fr) * ldc + wc * 32 + 4 * fq) * 4);
        asm volatile("global_load_dwordx4 %0, %4, %5\n\tglobal_load_dwordx4 %1, %4, %5 offset:64\n\tglobal_load_dwordx4 %2, %4, %6\n\tglobal_load_dwordx4 %3, %4, %6 offset:64"
                     : "=&v"(xv[0]), "=&v"(xv[1]), "=&v"(xv[2]), "=&v"(xv[3]) : "v"(voff), "s"(ba), "s"(bb) : "memory");
    }
    __device__ __forceinline__ void xadd(f32x4 (&acc)[2][2][4][2], int it, f32x4 (&xv)[4]) const {
        asm volatile("" : "+v"(xv[0]), "+v"(xv[1]), "+v"(xv[2]), "+v"(xv[3]));
#define XA(AI, BJ, M0) do { acc[AI][BJ][M0][0] += xv[0]; acc[AI][BJ][M0][1] += xv[1]; acc[AI][BJ][M0 + 1][0] += xv[2]; acc[AI][BJ][M0 + 1][1] += xv[3]; } while (0)
        switch (it) { case 0: XA(0, 0, 0); break; case 1: XA(0, 0, 2); break; case 2: XA(0, 1, 0); break; case 3: XA(0, 1, 2); break;
                      case 4: XA(1, 0, 0); break; case 5: XA(1, 0, 2); break; case 6: XA(1, 1, 0); break; default: XA(1, 1, 2); break; }
#undef XA
    }
    __device__ __forceinline__ void operator()(const f32x4 (&acc)[2][2][4][2], const Unit& u, int wr, int wc, int fr, int fq) const {
        const int row0 = u.pm * BM + wr * 64 + fr, col0 = u.pn * BM + wc * 32 + 4 * fq;
#pragma unroll
        for (int ai = 0; ai < 2; ++ai)
#pragma unroll
            for (int m = 0; m < 4; ++m) { const size_t off = (size_t)(row0 + ai * HALF + m * 16) * ldc + col0;
#pragma unroll
                for (int bj = 0; bj < 2; ++bj)
#pragma unroll
                    for (int n = 0; n < 2; ++n) *(f32x4*)(O + off + bj * HALF + n * 16) = acc[ai][bj][m][n]; }
    }
};

template <class Epi, class Sched, bool ALIGN_EPI = false, bool SP2 = false>
__device__ __forceinline__ void gemm_phase(PG8_LAS unsigned char* lds, const Gemm g, const Sched& S, const Epi& E, const int widx) {
    const int lane = hw_lane(), wid = widx, tid = wid * 64 + lane, wr = wid >> 2, wc = wid & 3, fr = lane & 15, fq = lane >> 4;
    const int K = g.K, nt = K / BK;
    unsigned voffA[2], voffB[2];
#pragma unroll
    for (int i = 0; i < 2; ++i) { int R, C; stage_rc(tid * 16 + i * 8192, R, C);
        voffA[i] = (unsigned)(R * K + C) * 2u; voffB[i] = (unsigned)(R * K + C) * 2u; }
    const size_t kstep = (size_t)(BK * 2);
    const size_t hstep = (size_t)HALF * K * 2;
    const size_t tstep = 2 * hstep;
    const unsigned ldsw = (unsigned)wid * 1024u;
    const int aoff = lds_byte(wr * 64 + fr, fq * 8), boff = lds_byte(wc * 32 + fr, fq * 8);
#define PG8_SA(b, h) (((b) * 2 + (h)) * HTB)
#define PG8_SB(b, h) ((4 + (b) * 2 + (h)) * HTB)
#define PG8_STAGE(bufoff, gbase, voff) do { _Pragma("unroll") for (int _i = 0; _i < 2; ++_i) \
        __builtin_amdgcn_global_load_lds((const unsigned*)((const char*)(gbase) + (voff)[_i]), (PG8_LAS unsigned*)(lds + (bufoff) + ldsw + _i * 8192), 16, 0, 0); } while (0)
#define PG8_LDA(dst, b, h) do { _Pragma("unroll") for (int m = 0; m < 4; ++m) _Pragma("unroll") for (int k = 0; k < 2; ++k) dst[m][k] = *(const PG8_LAS bf16x8*)(lds + PG8_SA(b, h) + aoff + m * 2048 + k * 1024); } while (0)
#define PG8_LDB(dst, b, h) do { _Pragma("unroll") for (int n = 0; n < 2; ++n) _Pragma("unroll") for (int k = 0; k < 2; ++k) dst[n][k] = *(const PG8_LAS bf16x8*)(lds + PG8_SB(b, h) + boff + n * 2048 + k * 1024); } while (0)
#define PG8_MMA(ai, bj, At, Bt) do { __builtin_amdgcn_s_setprio(1); _Pragma("unroll") for (int m = 0; m < 4; ++m) _Pragma("unroll") for (int n = 0; n < 2; ++n) _Pragma("unroll") for (int k = 0; k < 2; ++k) \
        acc[ai][bj][m][n] = __builtin_amdgcn_mfma_f32_16x16x32_bf16(Bt[n][k], At[m][k], acc[ai][bj][m][n], 0, 0, 0); __builtin_amdgcn_s_setprio(0); } while (0)
#define PG8_WAIT_V(n) asm volatile("s_waitcnt vmcnt(" #n ")" ::: "memory")
#define PG8_WAIT_L(n) asm volatile("s_waitcnt lgkmcnt(" #n ")" ::: "memory")
#define PG8_BAR __builtin_amdgcn_s_barrier()
#define PG8_SCHED __builtin_amdgcn_sched_barrier(0)
    Unit cur, nxt; int ui = 0;
    if (!S.next(0, cur)) return;
    f32x4 acc[2][2][4][2];
#pragma unroll
    for (int a = 0; a < 2; ++a)
#pragma unroll
        for (int b = 0; b < 2; ++b)
#pragma unroll
            for (int m = 0; m < 4; ++m)
#pragma unroll
                for (int n = 0; n < 2; ++n) acc[a][b][m][n] = (f32x4){0.f, 0.f, 0.f, 0.f};
    bf16x8 At[4][2], B0[2][2], B1[2][2]; f32x4 xv[4];
    const char* cA = (const char*)g.A + (size_t)cur.pm * tstep; const char* cB = (const char*)g.Bt + (size_t)cur.pn * tstep;
    if constexpr (SP2) {
        PG8_STAGE(PG8_SB(0, 0), cB, voffB); PG8_STAGE(PG8_SB(0, 1), cB + hstep, voffB); PG8_STAGE(PG8_SA(0, 0), cA, voffA); PG8_STAGE(PG8_SA(0, 1), cA + hstep, voffA);
        if (wr == 1) PG8_BAR;
        PG8_WAIT_V(2); PG8_BAR;
        PG8_STAGE(PG8_SB(1, 0), cB + kstep, voffB); PG8_STAGE(PG8_SA(1, 0), cA + kstep, voffA); PG8_STAGE(PG8_SB(1, 1), cB + hstep + kstep, voffB);
        PG8_WAIT_V(6); PG8_BAR;
    } else {
        PG8_STAGE(PG8_SB(0, 0), cB, voffB); PG8_STAGE(PG8_SA(0, 0), cA, voffA); PG8_STAGE(PG8_SB(0, 1), cB + hstep, voffB); PG8_STAGE(PG8_SA(0, 1), cA + hstep, voffA);
        if (wr == 1) PG8_BAR;
        PG8_WAIT_V(4); PG8_BAR;
        PG8_STAGE(PG8_SB(1, 0), cB + kstep, voffB); PG8_STAGE(PG8_SA(1, 0), cA + kstep, voffA); PG8_STAGE(PG8_SB(1, 1), cB + hstep + kstep, voffB);
        PG8_WAIT_V(6); PG8_BAR;
    }
    for (;;) {
        const bool has_next = S.next(ui + 1, nxt);
        const char* nA = has_next ? (const char*)g.A + (size_t)nxt.pm * tstep : cA; const char* nB = has_next ? (const char*)g.Bt + (size_t)nxt.pn * tstep : cB;
        if constexpr (Epi::XPRE) {
#pragma unroll
        for (int t = 0; t < 16; t += 2) {
            const bool last = (t == nt - 2);
            const char* a1 = cA + (size_t)(t + 1) * kstep;
            const char* a2 = last ? nA : cA + (size_t)(t + 2) * kstep; const char* b2 = last ? nB : cB + (size_t)(t + 2) * kstep;
            const char* a3 = a2 + kstep; const char* b3 = b2 + kstep;
            if constexpr (SP2) {
            if constexpr (Epi::XPRE) E.xissue(cur, t >> 1, wr, wc, fr, fq, xv);
            PG8_LDB(B0, 0, 0); PG8_LDB(B1, 0, 1); PG8_SCHED; PG8_LDA(At, 0, 0); PG8_STAGE(PG8_SA(1, 1), a1 + hstep, voffA);
            if constexpr (Epi::XPRE) PG8_WAIT_V(12); else PG8_WAIT_V(8);
            PG8_WAIT_L(0); PG8_BAR; PG8_MMA(0, 0, At, B0); PG8_MMA(0, 1, At, B1); PG8_BAR; PG8_SCHED;
            PG8_LDA(At, 0, 1); PG8_STAGE(PG8_SB(0, 0), b2, voffB); PG8_STAGE(PG8_SB(0, 1), b2 + hstep, voffB); PG8_STAGE(PG8_SA(0, 0), a2, voffA);
            if constexpr (Epi::XPRE) PG8_WAIT_V(12); else PG8_WAIT_V(8);
            PG8_WAIT_L(0); PG8_BAR; PG8_MMA(1, 0, At, B0); PG8_MMA(1, 1, At, B1); PG8_BAR; PG8_SCHED;
            PG8_LDB(B0, 1, 0); PG8_LDB(B1, 1, 1); PG8_SCHED; PG8_LDA(At, 1, 0); PG8_STAGE(PG8_SA(0, 1), a2 + hstep, voffA);
            PG8_WAIT_V(8); PG8_WAIT_L(0); PG8_BAR;
            if constexpr (Epi::XPRE) E.xadd(acc, t >> 1, xv);
            PG8_MMA(0, 0, At, B0); PG8_MMA(0, 1, At, B1); PG8_BAR; PG8_SCHED;
            PG8_LDA(At, 1, 1); PG8_STAGE(PG8_SB(1, 0), b3, voffB); PG8_STAGE(PG8_SB(1, 1), b3 + hstep, voffB); PG8_STAGE(PG8_SA(1, 0), a3, voffA);
            PG8_WAIT_V(8); PG8_WAIT_L(0); PG8_BAR; PG8_MMA(1, 0, At, B0); PG8_MMA(1, 1, At, B1); PG8_BAR; PG8_SCHED;
            } else {
            PG8_LDB(B0, 0, 0); PG8_SCHED; PG8_LDA(At, 0, 0); PG8_STAGE(PG8_SA(1, 1), a1 + hstep, voffA);
            PG8_WAIT_L(8); PG8_BAR; PG8_WAIT_L(0); PG8_MMA(0, 0, At, B0); PG8_BAR; PG8_SCHED;
            PG8_LDB(B1, 0, 1); PG8_STAGE(PG8_SB(0, 0), b2, voffB);
            PG8_BAR; PG8_WAIT_L(0); PG8_MMA(0, 1, At, B1); PG8_BAR;
            PG8_LDA(At, 0, 1); PG8_STAGE(PG8_SA(0, 0), a2, voffA);
            PG8_BAR; PG8_WAIT_L(0); PG8_MMA(1, 0, At, B0); PG8_BAR; PG8_SCHED;
            PG8_STAGE(PG8_SB(0, 1), b2 + hstep, voffB);
            PG8_WAIT_V(6); PG8_BAR; PG8_MMA(1, 1, At, B1); PG8_BAR;
            PG8_LDB(B0, 1, 0); PG8_SCHED; PG8_LDA(At, 1, 0); PG8_STAGE(PG8_SA(0, 1), a2 + hstep, voffA);
            PG8_WAIT_L(8); PG8_BAR; PG8_WAIT_L(0); PG8_MMA(0, 0, At, B0); PG8_BAR; PG8_SCHED;
            PG8_LDB(B1, 1, 1); PG8_STAGE(PG8_SB(1, 0), b3, voffB);
            PG8_BAR; PG8_WAIT_L(0); PG8_MMA(0, 1, At, B1); PG8_BAR;
            PG8_LDA(At, 1, 1); PG8_STAGE(PG8_SA(1, 0), a3, voffA);
            PG8_BAR; PG8_WAIT_L(0); PG8_MMA(1, 0, At, B0); PG8_BAR; PG8_SCHED;
            PG8_STAGE(PG8_SB(1, 1), b3 + hstep, voffB);
            PG8_WAIT_V(6); PG8_BAR; PG8_MMA(1, 1, At, B1); PG8_BAR;
            }
                }
        } else {
        for (int t = 0; t < nt; t += 2) {
            const bool last = (t == nt - 2);
            const char* a1 = cA + (size_t)(t + 1) * kstep;
            const char* a2 = last ? nA : cA + (size_t)(t + 2) * kstep; const char* b2 = last ? nB : cB + (size_t)(t + 2) * kstep;
            const char* a3 = a2 + kstep; const char* b3 = b2 + kstep;
            if constexpr (SP2) {
            if constexpr (Epi::XPRE) E.xissue(cur, t >> 1, wr, wc, fr, fq, xv);
            PG8_LDB(B0, 0, 0); PG8_LDB(B1, 0, 1); PG8_SCHED; PG8_LDA(At, 0, 0); PG8_STAGE(PG8_SA(1, 1), a1 + hstep, voffA);
            if constexpr (Epi::XPRE) PG8_WAIT_V(12); else PG8_WAIT_V(8);
            PG8_WAIT_L(0); PG8_BAR; PG8_MMA(0, 0, At, B0); PG8_MMA(0, 1, At, B1); PG8_BAR; PG8_SCHED;
            PG8_LDA(At, 0, 1); PG8_STAGE(PG8_SB(0, 0), b2, voffB); PG8_STAGE(PG8_SB(0, 1), b2 + hstep, voffB); PG8_STAGE(PG8_SA(0, 0), a2, voffA);
            if constexpr (Epi::XPRE) PG8_WAIT_V(12); else PG8_WAIT_V(8);
            PG8_WAIT_L(0); PG8_BAR; PG8_MMA(1, 0, At, B0); PG8_MMA(1, 1, At, B1); PG8_BAR; PG8_SCHED;
            PG8_LDB(B0, 1, 0); PG8_LDB(B1, 1, 1); PG8_SCHED; PG8_LDA(At, 1, 0); PG8_STAGE(PG8_SA(0, 1), a2 + hstep, voffA);
            PG8_WAIT_V(8); PG8_WAIT_L(0); PG8_BAR;
            if constexpr (Epi::XPRE) E.xadd(acc, t >> 1, xv);
            PG8_MMA(0, 0, At, B0); PG8_MMA(0, 1, At, B1); PG8_BAR; PG8_SCHED;
            PG8_LDA(At, 1, 1); PG8_STAGE(PG8_SB(1, 0), b3, voffB); PG8_STAGE(PG8_SB(1, 1), b3 + hstep, voffB); PG8_STAGE(PG8_SA(1, 0), a3, voffA);
            PG8_WAIT_V(8); PG8_WAIT_L(0); PG8_BAR; PG8_MMA(1, 0, At, B0); PG8_MMA(1, 1, At, B1); PG8_BAR; PG8_SCHED;
            } else {
            PG8_LDB(B0, 0, 0); PG8_SCHED; PG8_LDA(At, 0, 0); PG8_STAGE(PG8_SA(1, 1), a1 + hstep, voffA);
            PG8_WAIT_L(8); PG8_BAR; PG8_WAIT_L(0); PG8_MMA(0, 0, At, B0); PG8_BAR; PG8_SCHED;
            PG8_LDB(B1, 0, 1); PG8_STAGE(PG8_SB(0, 0), b2, voffB);
            PG8_BAR; PG8_WAIT_L(0); PG8_MMA(0, 1, At, B1); PG8_BAR;
            PG8_LDA(At, 0, 1); PG8_STAGE(PG8_SA(0, 0), a2, voffA);
            PG8_BAR; PG8_WAIT_L(0); PG8_MMA(1, 0, At, B0); PG8_BAR; PG8_SCHED;
            PG8_STAGE(PG8_SB(0, 1), b2 + hstep, voffB);
            PG8_WAIT_V(6); PG8_BAR; PG8_MMA(1, 1, At, B1); PG8_BAR;
            PG8_LDB(B0, 1, 0); PG8_SCHED; PG8_LDA(At, 1, 0); PG8_STAGE(PG8_SA(0, 1), a2 + hstep, voffA);
            PG8_WAIT_L(8); PG8_BAR; PG8_WAIT_L(0); PG8_MMA(0, 0, At, B0); PG8_BAR; PG8_SCHED;
            PG8_LDB(B1, 1, 1); PG8_STAGE(PG8_SB(1, 0), b3, voffB);
            PG8_BAR; PG8_WAIT_L(0); PG8_MMA(0, 1, At, B1); PG8_BAR;
            PG8_LDA(At, 1, 1); PG8_STAGE(PG8_SA(1, 0), a3, voffA);
            PG8_BAR; PG8_WAIT_L(0); PG8_MMA(1, 0, At, B0); PG8_BAR; PG8_SCHED;
            PG8_STAGE(PG8_SB(1, 1), b3 + hstep, voffB);
            PG8_WAIT_V(6); PG8_BAR; PG8_MMA(1, 1, At, B1); PG8_BAR;
            }
                }
        }
        if constexpr (ALIGN_EPI) { if (wr == 0) PG8_BAR; }
        E(acc, cur, wr, wc, fr, fq);
        if (!has_next) break;
#pragma unroll
        for (int a = 0; a < 2; ++a)
#pragma unroll
            for (int b = 0; b < 2; ++b)
#pragma unroll
                for (int m = 0; m < 4; ++m)
#pragma unroll
                    for (int n = 0; n < 2; ++n) acc[a][b][m][n] = (f32x4){0.f, 0.f, 0.f, 0.f};
        cur = nxt; cA = nA; cB = nB; ++ui;
        if constexpr (ALIGN_EPI) { if (wr == 1) PG8_BAR; }
    }
    PG8_WAIT_V(0);
    if constexpr (!ALIGN_EPI) { if (wr == 0) PG8_BAR; }
    PG8_BAR;
#undef PG8_SA
#undef PG8_SB
#undef PG8_STAGE
#undef PG8_LDA
#undef PG8_LDB
#undef PG8_MMA
#undef PG8_WAIT_V
#undef PG8_WAIT_L
#undef PG8_BAR
#undef PG8_SCHED
}
}

constexpr int D_MODEL = 1024, BATCH = 2, SEQ = 16384, M = BATCH * SEQ, NPROJ = 4096, AW = 512, NHEAD = 8;
constexpr int NWAVES = 8;
constexpr size_t MiB = 1u << 20;
constexpr size_t WS_CTL = 0, CTL_ZERO_BYTES = 32768;
#ifndef WS_SHIFT_MIB
#define WS_SHIFT_MIB 0
#endif
constexpr size_t WS_SH = (size_t)WS_SHIFT_MIB * MiB;
constexpr size_t WS_TBG = WS_SH + 1 * MiB;
constexpr size_t WS_WIN = WS_SH + 2 * MiB;
constexpr size_t WS_WOUT = WS_SH + 10 * MiB;
constexpr size_t WS_LP4 = WS_SH + 12 * MiB, WS_LP16 = WS_SH + 13 * MiB;
constexpr size_t WS_SBT = WS_SH + 14 * MiB, WS_SBG = WS_SH + 15 * MiB;
constexpr size_t WS_XN = WS_SH + 16 * MiB;
constexpr size_t WS_Q = WS_SH + 80 * MiB, WS_K = WS_SH + 112 * MiB, WS_V = WS_SH + 144 * MiB, WS_ZG = WS_SH + 176 * MiB;
constexpr size_t WS_OP4 = WS_XN, WS_OP16 = WS_XN + 32 * MiB;
constexpr size_t WS_Y = WS_SH + 208 * MiB;
constexpr size_t WS_END = WS_SH + 272 * MiB;
constexpr int CW_BAR = 4096;

constexpr int RING_OFF = 0, RING_BYTES = 131072;
constexpr int LDSCTL_OFF = 146432, MISC_OFF = LDSCTL_OFF + 320;
constexpr int LDS_BYTES = 147456;
constexpr int XL_OFF = 131072;
static_assert(XL_OFF + 10752 <= LDSCTL_OFF, "LDS map");

#define GAS __attribute__((address_space(1)))
#define LAS __attribute__((address_space(3)))
typedef unsigned short bf16;
typedef unsigned v4u __attribute__((ext_vector_type(4)));
typedef float f32x4 __attribute__((ext_vector_type(4)));
typedef float f32x16 __attribute__((ext_vector_type(16)));
typedef short bf16x8 __attribute__((ext_vector_type(8)));
typedef short s16x4 __attribute__((ext_vector_type(4)));
typedef GAS unsigned gu32;
#define RLX_AGENT __ATOMIC_RELAXED, __HIP_MEMORY_SCOPE_AGENT
#define LDS_WAIT() asm volatile("s_waitcnt lgkmcnt(0)" ::: "memory")
__device__ __forceinline__ unsigned f2bf(float f) { unsigned u = __builtin_bit_cast(unsigned, f); return (u + 0x7fffu + ((u >> 16) & 1u)) >> 16; }
__device__ __forceinline__ unsigned pk2(float lo, float hi) { return f2bf(lo) | (f2bf(hi) << 16); }
__device__ __forceinline__ float bf2f(unsigned short b) { return __builtin_bit_cast(float, (unsigned)b << 16); }
__device__ __forceinline__ float bflo(unsigned w) { return __builtin_bit_cast(float, w << 16); }
__device__ __forceinline__ float bfhi(unsigned w) { return __builtin_bit_cast(float, w & 0xffff0000u); }

#define XB_TMO      128
#define XB_XCNT(j)  (256  + 64 * (j))
#define XB_XSUB(j)  (1280 + 64 * (j))
#define XB_XGEN(j)  (2304 + 64 * (j))
#define XB_TOP      3328
#define XB_TOPGEN   3392
#define XCD_BAR_WORDS 3456
#define XB_SPIN_CAP (1u << 18)
__device__ __forceinline__ unsigned xb_ld(unsigned* p)              { return __hip_atomic_load(p, __ATOMIC_RELAXED, __HIP_MEMORY_SCOPE_AGENT); }
__device__ __forceinline__ unsigned xb_add(unsigned* p, unsigned v) { return __hip_atomic_fetch_add(p, v, __ATOMIC_RELAXED, __HIP_MEMORY_SCOPE_AGENT); }
__device__ __forceinline__ unsigned xb_xcc_id() { return (unsigned)__builtin_amdgcn_s_getreg((3 << 11) | 20) & 0xFu; }
#define XB_SPIN(cond, bar) do { unsigned _sp = 0; while (cond) { __builtin_amdgcn_s_sleep(1); \
    if ((++_sp & 255u) == 0u) { if (xb_ld(&(bar)[XB_TMO])) break; if (_sp > XB_SPIN_CAP) { atomicAdd(&(bar)[XB_TMO], 1u); break; } } } } while (0)
struct XcdBarrier { unsigned* bar; unsigned x; volatile LAS unsigned* st; };
__device__ __forceinline__ XcdBarrier xcd_barrier_post(unsigned* bar, volatile LAS unsigned* st) {
    XcdBarrier b; b.bar = bar; b.x = xb_xcc_id(); b.st = st;
    if (threadIdx.x == 0) (void)xb_add(&bar[XB_XCNT(b.x)], 1u);
    return b;
}
__device__ __forceinline__ void xcd_barrier_complete(unsigned* bar, unsigned x, unsigned& nloc, unsigned& nx) {
    const unsigned G = gridDim.x * gridDim.y * gridDim.z;
    unsigned sum, cnt, mine, sp = 0u;
    for (;;) {
        sum = 0u; cnt = 0u; mine = 0u;
#pragma unroll
        for (unsigned j = 0; j < 16; ++j) { const unsigned c = xb_ld(&bar[XB_XCNT(j)]); sum += c; cnt += (c > 0u) ? 1u : 0u; mine = (j == x) ? c : mine; }
        if (sum == G) break;
        __builtin_amdgcn_s_sleep(1);
        if ((++sp & 255u) == 0u) { if (xb_ld(&bar[XB_TMO])) break; if (sp > XB_SPIN_CAP) { atomicAdd(&bar[XB_TMO], 1u); break; } }
    }
    nloc = mine > 0u ? mine : 1u; nx = cnt > 0u ? cnt : 1u;
}
__device__ __forceinline__ void xcd_barrier(const XcdBarrier& b, const int wave) {
    asm volatile("s_waitcnt vmcnt(0)" ::: "memory");
    __syncthreads();
    if (wave == 0 && hw_lane() == 0) {
        unsigned* bar = b.bar;
        __builtin_amdgcn_s_waitcnt(0);
        unsigned nloc = b.st[0], nx = b.st[1];
        if (nloc == 0u) { xcd_barrier_complete(bar, b.x, nloc, nx); b.st[0] = nloc; b.st[1] = nx; }
        const unsigned old = xb_add(&bar[XB_XSUB(b.x)], 1u);
        const unsigned gen = old / nloc;
        if (old + 1u == (gen + 1u) * nloc) {
            __builtin_amdgcn_fence(__ATOMIC_RELEASE, "agent");
            asm volatile("s_waitcnt vmcnt(0)" ::: "memory");
            const unsigned og = xb_add(&bar[XB_TOP], 1u);
            const unsigned tg = og / nx;
            if (og + 1u == (tg + 1u) * nx) xb_add(&bar[XB_TOPGEN], 1u);
            else XB_SPIN(xb_ld(&bar[XB_TOPGEN]) == tg, bar);
            __builtin_amdgcn_fence(__ATOMIC_ACQUIRE, "agent");
            xb_add(&bar[XB_XGEN(b.x)], 1u);
            asm volatile("s_waitcnt vmcnt(0)" ::: "memory");
        } else {
            XB_SPIN(xb_ld(&bar[XB_XGEN(b.x)]) == gen, bar);
            __builtin_amdgcn_fence(__ATOMIC_ACQUIRE, "agent");
            asm volatile("s_waitcnt vmcnt(0)" ::: "memory");
        }
    }
    __syncthreads();
}

struct Frame {
    LAS unsigned char* lds;
    volatile LAS unsigned* MISC;
    gu32* ctl;
    int vcu, G, wave;
    const float *x, *norm_w, *w_in, *conv_w, *conv_b, *qw, *kw, *rel_bias, *w_out; float* out;
    bf16 *WinT, *WoutT, *XN, *Q, *K, *V, *ZG, *OP4, *OP16, *Y;
    float *TBG, *LP4, *LP16, *SBT, *SBG;
};
__device__ __forceinline__ float wave_sum(float v) {
#pragma unroll
    for (int o = 1; o < 64; o <<= 1) v += __shfl_xor(v, o);
    return v;
}
__device__ __forceinline__ float wave_max(float v) {
#pragma unroll
    for (int o = 1; o < 64; o <<= 1) v = fmaxf(v, __shfl_xor(v, o));
    return v;
}
__device__ __forceinline__ int win_row(int L) {
    int pn, wc, bj, n, fq, reg;
    if (L < 2048) { const int which = L >> 9, ch = L & 511; pn = ch >> 6; wc = (ch >> 4) & 3; fq = (ch >> 2) & 3; reg = ch & 3; bj = which >> 1; n = which & 1; }
    else { const int Lp = L - 2048, grp = Lp >> 9, head = (Lp >> 6) & 7, e = Lp & 63; pn = 8 + 2 * grp + (head >> 2); wc = head & 3; bj = e >> 5; fq = (e >> 3) & 3; n = (e >> 2) & 1; reg = e & 3; }
    return pn * 256 + 128 * bj + 32 * wc + 16 * n + 4 * fq + reg;
}
template <bool PERMUTE>
__device__ __forceinline__ void p0_transpose_item(const float* W, int K, int N, bf16* WT, LAS float* scr, int item, int lane) {
    const int nblk = N / 32, kb = item / nblk, nb = item % nblk, k0 = 64 * kb, n0 = 32 * nb;
#pragma unroll 8
    for (int i = 0; i < 32; ++i) { const int kk = 2 * i + (lane >> 5); scr[kk * 33 + (lane & 31)] = W[(size_t)(k0 + kk) * N + n0 + (lane & 31)]; }
    LDS_WAIT(); asm volatile("" ::: "memory");
    const int c = lane & 7;
#pragma unroll
    for (int j = 0; j < 4; ++j) { const int n = (lane >> 3) + 8 * j; const LAS float* s = scr + (8 * c) * 33 + n;
        v4u o; o.x = pk2(s[0 * 33], s[1 * 33]); o.y = pk2(s[2 * 33], s[3 * 33]); o.z = pk2(s[4 * 33], s[5 * 33]); o.w = pk2(s[6 * 33], s[7 * 33]);
        const int dr = PERMUTE ? win_row(n0 + n) : (n0 + n);
        *(GAS v4u*)(WT + (size_t)dr * K + k0 + 8 * c) = o; }
    LDS_WAIT(); asm volatile("" ::: "memory");
}
__device__ __forceinline__ int t5_bucket(int rel) {
    const int n = rel < 0 ? -rel : rel; int b = rel > 0 ? 16 : 0;
    if (n < 8) return b + n;
    int large = 8 + (int)(logf((float)n / 8.f) / logf(128.f) * 8.f);
    if (large > 15) large = 15;
    return b + large;
}
__device__ __forceinline__ void p0_prologue(Frame& F) {
    const int lane_l = hw_lane(), wave_l = F.wave, tid_l = wave_l * 64 + lane_l;
    LAS float* scr = (LAS float*)(F.lds + RING_OFF + wave_l * 16384);
    const int gw = F.vcu * NWAVES + wave_l, NGW = F.G * NWAVES;
    constexpr int I_IN = (D_MODEL / 64) * (NPROJ / 32), I_OUT = (D_MODEL / 64) * (D_MODEL / 32);
    for (int it = gw; it < I_IN + I_OUT; it += NGW) {
        if (it < I_IN) p0_transpose_item<true>(F.w_in, D_MODEL, NPROJ, F.WinT, scr, it, lane_l);
        else p0_transpose_item<false>(F.w_out, D_MODEL, D_MODEL, F.WoutT, scr, it - I_IN, lane_l);
    }
    f32x4 nw[4];
#pragma unroll
    for (int j = 0; j < 4; ++j) nw[j] = ((const f32x4*)F.norm_w)[lane_l + 64 * j];
    for (int m = gw; m < M; m += NGW) {
        const GAS f32x4* xr = (const GAS f32x4*)(F.x + (size_t)m * D_MODEL) + lane_l;
        f32x4 v[4]; float s = 0.f;
#pragma unroll
        for (int j = 0; j < 4; ++j) { v[j] = xr[64 * j]; s += (v[j].x * v[j].x + v[j].y * v[j].y) + (v[j].z * v[j].z + v[j].w * v[j].w); }
        const float rstd = 1.f / sqrtf(wave_sum(s) * (1.f / D_MODEL) + 1e-6f);
        GAS unsigned long long* o8 = (GAS unsigned long long*)(F.XN + (size_t)m * D_MODEL) + lane_l;
#pragma unroll
        for (int j = 0; j < 4; ++j) { const f32x4 y = v[j] * rstd * nw[j]; o8[64 * j] = (unsigned long long)pk2(y.x, y.y) | ((unsigned long long)pk2(y.z, y.w) << 32); }
    }
    if (blockIdx.x == 0) {
        const float mq = wave_max(fabsf(F.qw[lane_l])), mk = wave_max(fabsf(F.kw[lane_l]));
        float mb = 0.f;
#pragma unroll
        for (int j = 0; j < 4; ++j) mb = fmaxf(mb, fabsf(F.rel_bias[lane_l + 64 * j]));
        mb = wave_max(mb);
        const float M2 = (8.f * mq * mk + mb) * 1.4426950408889634f;
        for (int i = tid_l; i < 3 * 8 * 192; i += NWAVES * 64) {
            const int jp = i % 192, h = (i / 192) & 7, c = i / (192 * 8), j = jp - 32;
            const int dil = c == 0 ? 1 : (c == 1 ? 4 : 16);
            float v = -1e30f;
            if (j >= 0 && j <= 128) v = F.rel_bias[t5_bucket((j - 64) * dil) * 8 + h] * 1.4426950408889634f - M2;
            F.TBG[i] = v;
        }
    }
}

__device__ __forceinline__ int crow(int r, int hi) { return (r & 3) + 8 * (r >> 2) + 4 * hi; }
__device__ __forceinline__ unsigned cvtpk_s(float lo, float hi) { typedef float f2 __attribute__((ext_vector_type(2))); typedef __bf16 b2 __attribute__((ext_vector_type(2))); f2 v = {lo, hi}; b2 b = __builtin_convertvector(v, b2); return __builtin_bit_cast(unsigned, b); }
typedef short v4i16_t __attribute__((ext_vector_type(4)));
__device__ __forceinline__ s16x4 vtr(LAS const unsigned char* p) { return __builtin_bit_cast(s16x4, __builtin_amdgcn_ds_read_tr16_b64_v4i16((LAS v4i16_t*)p)); }

__device__ __forceinline__ void conv_fixup_item(Frame& F, int idx, int lane) {
    const int ridx = idx >> 3, ch = (idx & 7) * 64 + lane, pm = ridx >> 1, last = ridx & 1;
    const bool hasp = last || (pm % (SEQ / 256) != 0), hasn = !last || (pm % (SEQ / 256) != SEQ / 256 - 1);
    const float tc = F.SBT[(size_t)(pm * 4 + (last ? 3 : 0)) * 512 + ch];
    const float tp = last ? F.SBT[(size_t)(pm * 4 + 2) * 512 + ch] : F.SBT[(size_t)((hasp ? pm - 1 : pm) * 4 + 3) * 512 + ch];
    const float tn = last ? F.SBT[(size_t)((hasn ? pm + 1 : pm) * 4 + 0) * 512 + ch] : F.SBT[(size_t)(pm * 4 + 1) * 512 + ch];
    const float g = F.SBG[(size_t)(pm * 2 + last) * 512 + ch];
    const float y = g * (F.conv_w[ch] * (hasp ? tp : 0.f) + F.conv_w[512 + ch] * tc + F.conv_w[1024 + ch] * (hasn ? tn : 0.f) + F.conv_b[ch]);
    F.Y[(size_t)(pm * 256 + (last ? 255 : 0)) * D_MODEL + ch] = (bf16)f2bf(y);
}
constexpr int AT_TILE = 8448, AT_KCH = 528, AT_VOFF = 4224, AT_VPC = 1056, AT_NT = 12;
constexpr int AT_OST = AT_NT * AT_TILE;
constexpr int AT_TBL = AT_OST + NWAVES * 4096;
constexpr int AT_LW = AT_TBL + 768;
static_assert(AT_LW + NWAVES * 128 <= LDSCTL_OFF, "attention LDS map");
struct TaskD { int dil, L, i0, hq, c, h, tok0; };
template <bool FINAL>
__device__ __forceinline__ TaskD unit_decode(int vcu, int i) {
    TaskD D; const int x = vcu >> 5, j = vcu & 31;
    int pair, r, blk;
    if (FINAL) { pair = 2 * x + (i >> 1); r = 0; blk = 2 * j + (i & 1); D.c = 0; D.dil = 1; D.L = SEQ; }
    else { pair = 2 * x + (i >> 2); const int k = i & 3;
        if (j < 16) { D.c = 1; D.dil = 4; D.L = SEQ / 4; r = j >> 2; blk = 4 * (j & 3) + k; } else { D.c = 2; D.dil = 16; D.L = SEQ / 16; r = j - 16; blk = k; } }
    D.h = pair & 7; D.hq = D.h * 64; D.tok0 = (pair >> 3) * SEQ + r; D.i0 = blk * 256;
    return D;
}
#define AT_BAR() do { asm volatile("s_waitcnt lgkmcnt(0)" ::: "memory"); __builtin_amdgcn_s_barrier(); asm volatile("" ::: "memory"); } while (0)
template <bool FINAL>
__device__ __forceinline__ void attn_units(Frame& F) {
    constexpr int u0 = 0, u1 = FINAL ? 4 : 8;
    const int lane = hw_lane(), w = F.wave, tid_l = w * 64 + lane, r32 = lane & 31, hi = lane >> 5;
    LAS unsigned char* L0 = F.lds;
    LAS unsigned short* stgb = (LAS unsigned short*)(F.lds + AT_OST + w * 4096);
    LAS float* tbl = (LAS float*)(F.lds + AT_TBL);
    LAS float* lw = (LAS float*)(F.lds + AT_LW) + w * 32;
    const int vaddr = AT_VOFF + ((lane >> 4) & 1) * 32 + (lane & 3) * 8 + (4 * hi + ((lane & 15) >> 2)) * 64;
    const bool isV = w >= 4; const int srow = 8 * (w & 3) + (lane >> 3), sch = lane & 7;
    const int sdst = isV ? (AT_VOFF + (sch >> 2) * (2 * AT_VPC) + (srow >> 4) * AT_VPC + (srow & 15) * 64 + (sch & 3) * 16) : (sch * AT_KCH + srow * 16);
    const bf16* ssrc = isV ? F.V : F.K;
    bf16x8 st[AT_NT], qr[4];
#define STAGE_LOAD(D_) do { _Pragma("unroll") for (int t_ = 0; t_ < AT_NT; ++t_) { int key_ = (D_).i0 - 64 + 32 * t_ + srow; key_ = key_ < 0 ? 0 : (key_ > (D_).L - 1 ? (D_).L - 1 : key_); \
        st[t_] = *(const bf16x8*)(ssrc + (unsigned)(((D_).tok0 + (D_).dil * key_) * AW + (D_).hq + sch * 8)); } } while (0)
#define LOADQN(D_) do { const unsigned qo_ = (unsigned)(((D_).tok0 + (D_).dil * ((D_).i0 + 32 * w + r32)) * AW + (D_).hq + hi * 8); \
        _Pragma("unroll") for (int d0 = 0; d0 < 4; ++d0) qr[d0] = *(const bf16x8*)(F.Q + qo_ + d0 * 16); } while (0)
#define SBAR() __builtin_amdgcn_sched_barrier(0)
#define LDK(kc, KF) do { const LAS unsigned char* tk_ = L0 + (w + (kc)) * AT_TILE + hi * AT_KCH + r32 * 16; \
        _Pragma("unroll") for (int d0 = 0; d0 < 4; ++d0) KF[d0] = *(const LAS bf16x8*)(tk_ + 2 * d0 * AT_KCH); } while (0)
#define LDT(kc, A) do { const int k0_ = i0w - 64 + 32 * (kc);     \
        const LAS float* tp_ = tbl + ((k0_ >= 0 && k0_ < D.L) ? (32 + 32 * (kc) + 4 * hi - r32) : 0); \
        _Pragma("unroll") for (int rr = 0; rr < 16; ++rr) A[rr] = tp_[(rr & 3) + 8 * (rr >> 2)]; } while (0)
#define LDVH(kc, h) do { const LAS unsigned char* vb_ = L0 + (w + (kc)) * AT_TILE + vaddr; \
        _Pragma("unroll") for (int pc = 2 * (h); pc < 2 * (h) + 2; ++pc) { vl[pc] = vtr(vb_ + pc * AT_VPC); vh[pc] = vtr(vb_ + pc * AT_VPC + 512); } } while (0)
#define LDV(kc) do { LDVH(kc, 0); LDVH(kc, 1); } while (0)
#define VFR(pc) (bf16x8){vl[pc][0], vl[pc][1], vl[pc][2], vl[pc][3], vh[pc][0], vh[pc][1], vh[pc][2], vh[pc][3]}
#define SMM(KF, A) do { _Pragma("unroll") for (int d0 = 0; d0 < 4; ++d0) A = __builtin_amdgcn_mfma_f32_32x32x16_bf16(KF[d0], qr[d0], A, 0, 0, 0); } while (0)
#define EXPK(A) do { _Pragma("unroll") for (int rr = 0; rr < 16; ++rr) A[rr] = __builtin_amdgcn_exp2f(A[rr]); \
        ls0 += (A[0] + A[1]) + (A[2] + A[3]); ls1 += (A[4] + A[5]) + (A[6] + A[7]); ls2 += (A[8] + A[9]) + (A[10] + A[11]); ls3 += (A[12] + A[13]) + (A[14] + A[15]); \
        pw0.x = cvtpk_s(A[0], A[1]); pw0.y = cvtpk_s(A[2], A[3]); pw0.z = cvtpk_s(A[4], A[5]); pw0.w = cvtpk_s(A[6], A[7]); \
        pw1.x = cvtpk_s(A[8], A[9]); pw1.y = cvtpk_s(A[10], A[11]); pw1.z = cvtpk_s(A[12], A[13]); pw1.w = cvtpk_s(A[14], A[15]); } while (0)
#define PVM() do { \
        o0 = __builtin_amdgcn_mfma_f32_32x32x16_bf16(__builtin_bit_cast(bf16x8, pw0), VFR(0), o0, 0, 0, 0); \
        o0 = __builtin_amdgcn_mfma_f32_32x32x16_bf16(__builtin_bit_cast(bf16x8, pw1), VFR(1), o0, 0, 0, 0); \
        o1 = __builtin_amdgcn_mfma_f32_32x32x16_bf16(__builtin_bit_cast(bf16x8, pw0), VFR(2), o1, 0, 0, 0); \
        o1 = __builtin_amdgcn_mfma_f32_32x32x16_bf16(__builtin_bit_cast(bf16x8, pw1), VFR(3), o1, 0, 0, 0); } while (0)
#define CHUNK1(kc) do { LDVH(kc, 0); SBAR(); SMM(kf, aA); SBAR(); LDVH(kc, 1); if ((kc) < 4) { LDK((kc) + 1, kf); SBAR(); } else { LOADQN(Dn); SBAR(); } EXPK(aA); SBAR(); if ((kc) < 4) { LDT((kc) + 1, aA); SBAR(); } PVM(); SBAR(); } while (0)
#define CHUNKS() do { LDK(0, kf); LDT(0, aA); SBAR(); CHUNK1(0); CHUNK1(1); CHUNK1(2); CHUNK1(3); CHUNK1(4); } while (0)
    TaskD D = unit_decode<FINAL>(F.vcu, u0);
    STAGE_LOAD(D); LOADQN(D);
    if (!FINAL) { for (int idx = F.vcu * NWAVES + w; idx < 8 * 2 * (M / 256); idx += F.G * NWAVES) conv_fixup_item(F, idx, lane); }
    int tb_ch = -1;
    for (int u = u0; u < u1; ++u) {
        const TaskD Dn = unit_decode<FINAL>(F.vcu, u + 1 < u1 ? u + 1 : u);
        AT_BAR();
#pragma unroll
        for (int t_ = 0; t_ < AT_NT; ++t_) *(LAS bf16x8*)(L0 + t_ * AT_TILE + sdst) = st[t_];
        if (tb_ch != D.c * 8 + D.h) { tb_ch = D.c * 8 + D.h; if (tid_l < 192) tbl[tid_l] = F.TBG[tb_ch * 192 + tid_l]; }
        AT_BAR();
        STAGE_LOAD(Dn);
        const int i0w = D.i0 + 32 * w;
        v4u p4[4], p16[4], zg[4]; float l4[4], l16[4];
#define FIN_LOAD(i) do { const int row = (i) * 8 + (lane >> 3), ch = lane & 7; const unsigned tok = (unsigned)(D.tok0 + i0w + row); const unsigned eo = tok * AW + D.hq + ch * 8; \
            p4[i] = *(const v4u*)(F.OP4 + eo); p16[i] = *(const v4u*)(F.OP16 + eo); zg[i] = *(const v4u*)(F.ZG + eo); l4[i] = F.LP4[tok * 8 + D.h]; l16[i] = F.LP16[tok * 8 + D.h]; } while (0)
        if (false) { FIN_LOAD(0); }
        f32x16 o0 = {}, o1 = {}, aA; float ls0 = 0.f, ls1 = 0.f, ls2 = 0.f, ls3 = 0.f; bf16x8 kf[4]; s16x4 vl[4], vh[4]; v4u pw0, pw1;
        CHUNKS();
        float lsum = (ls0 + ls1) + (ls2 + ls3);
        lsum += __shfl_xor(lsum, 32);
#pragma unroll
        for (int rr = 0; rr < 16; rr += 2) {
            const unsigned a01 = cvtpk_s(o0[rr], o0[rr + 1]), b01 = cvtpk_s(o1[rr], o1[rr + 1]);
            const int q0 = crow(rr, hi), q1 = crow(rr + 1, hi);
            stgb[q0 * 64 + r32] = (unsigned short)(a01 & 0xffffu); stgb[q1 * 64 + r32] = (unsigned short)(a01 >> 16);
            stgb[q0 * 64 + 32 + r32] = (unsigned short)(b01 & 0xffffu); stgb[q1 * 64 + 32 + r32] = (unsigned short)(b01 >> 16);
        }
        if (FINAL) { if (hi == 0) lw[r32] = lsum; FIN_LOAD(0); FIN_LOAD(1); FIN_LOAD(2); FIN_LOAD(3); }
        else { if (hi == 0) { float* lp = F.LP4 + (size_t)(D.c - 1) * (size_t)(256u << 10) + (unsigned)((D.tok0 + D.dil * (i0w + r32)) * 8 + D.h); *lp = lsum; } }
#pragma unroll
        for (int i = 0; i < 4; ++i) {
            const int row = i * 8 + (lane >> 3), ch = lane & 7;
            const unsigned tok = (unsigned)(D.tok0 + D.dil * (i0w + row));
            const v4u ov = *(const LAS v4u*)(stgb + row * 64 + ch * 8);
            if (!FINAL) {
                *(v4u*)(F.OP4 + (size_t)(D.c - 1) * (size_t)(16u << 20) + (tok * AW + D.hq + ch * 8)) = ov;
            } else {
                const float inv = 1.f / (lw[row] + l4[i] + l16[i]);
                float y[8];
#define SZ(x) pg8::silu_f(x)
                y[0] = (bflo(ov.x) + bflo(p4[i].x) + bflo(p16[i].x)) * inv * SZ(bflo(zg[i].x)); y[1] = (bfhi(ov.x) + bfhi(p4[i].x) + bfhi(p16[i].x)) * inv * SZ(bfhi(zg[i].x));
                y[2] = (bflo(ov.y) + bflo(p4[i].y) + bflo(p16[i].y)) * inv * SZ(bflo(zg[i].y)); y[3] = (bfhi(ov.y) + bfhi(p4[i].y) + bfhi(p16[i].y)) * inv * SZ(bfhi(zg[i].y));
                y[4] = (bflo(ov.z) + bflo(p4[i].z) + bflo(p16[i].z)) * inv * SZ(bflo(zg[i].z)); y[5] = (bfhi(ov.z) + bfhi(p4[i].z) + bfhi(p16[i].z)) * inv * SZ(bfhi(zg[i].z));
                y[6] = (bflo(ov.w) + bflo(p4[i].w) + bflo(p16[i].w)) * inv * SZ(bflo(zg[i].w)); y[7] = (bfhi(ov.w) + bfhi(p4[i].w) + bfhi(p16[i].w)) * inv * SZ(bfhi(zg[i].w));
#undef SZ
                v4u wv; wv.x = cvtpk_s(y[0], y[1]); wv.y = cvtpk_s(y[2], y[3]); wv.z = cvtpk_s(y[4], y[5]); wv.w = cvtpk_s(y[6], y[7]);
                *(v4u*)(F.Y + (tok * D_MODEL + 512 + D.hq + ch * 8)) = wv;
            }
        }
        D = Dn;
    }
    AT_BAR();
#undef STAGE_LOAD
#undef LOADQN
#undef SBAR
#undef LDK
#undef LDT
#undef LDV
#undef LDVH
#undef VFR
#undef SMM
#undef EXPK
#undef PVM
#undef CHUNK1
#undef CHUNKS
#undef FIN_LOAD
}
__device__ __forceinline__ void attn_pass_a(Frame& F) {
    attn_units<false>(F);
}
__device__ __forceinline__ void attn_pass_b(Frame& F) {
    attn_units<true>(F);
}

struct Args { const float* in[9]; float* out; unsigned char* ws; int ph_lo, ph_hi; };
__global__ void __launch_bounds__(NWAVES * 64, 2) mega(Args args) {
    extern __shared__ __attribute__((aligned(16))) unsigned char lds[];
    Frame F;
    F.lds = (LAS unsigned char*)lds;
    F.MISC = (volatile LAS unsigned*)(F.lds + MISC_OFF);
    F.wave = __builtin_amdgcn_readfirstlane((int)threadIdx.x >> 6); F.G = gridDim.x; { const int bx = blockIdx.x; F.vcu = (F.G % 8 == 0) ? (bx % 8) * (F.G / 8) + bx / 8 : bx; }
    unsigned char* ws = args.ws;
    F.ctl = (gu32*)(ws + WS_CTL);
    F.x = args.in[0]; F.norm_w = args.in[1]; F.w_in = args.in[2]; F.conv_w = args.in[3]; F.conv_b = args.in[4]; F.qw = args.in[5]; F.kw = args.in[6]; F.rel_bias = args.in[7]; F.w_out = args.in[8];
    F.out = args.out;
    F.WinT = (bf16*)(ws + WS_WIN); F.WoutT = (bf16*)(ws + WS_WOUT); F.XN = (bf16*)(ws + WS_XN);
    F.SBT = (float*)(ws + WS_SBT); F.SBG = (float*)(ws + WS_SBG); F.Q = (bf16*)(ws + WS_Q); F.K = (bf16*)(ws + WS_K); F.V = (bf16*)(ws + WS_V); F.ZG = (bf16*)(ws + WS_ZG);
    F.OP4 = (bf16*)(ws + WS_OP4); F.OP16 = (bf16*)(ws + WS_OP16); F.Y = (bf16*)(ws + WS_Y);
    F.TBG = (float*)(ws + WS_TBG); F.LP4 = (float*)(ws + WS_LP4); F.LP16 = (float*)(ws + WS_LP16);
    for (int u = threadIdx.x; u < (LDS_BYTES - LDSCTL_OFF) / 4; u += NWAVES * 64) ((LAS unsigned*)(F.lds + LDSCTL_OFF))[u] = 0u;
    __syncthreads();
    const int lo = args.ph_lo, hi = args.ph_hi;
    const bool multi = (hi - lo) > 1;
    XcdBarrier bar; bar.bar = (unsigned*)(F.ctl + CW_BAR); bar.x = 0; bar.st = nullptr;
    if (multi) bar = xcd_barrier_post((unsigned*)(F.ctl + CW_BAR), F.MISC + 8);
#define IN(k) (lo <= (k) && (k) < hi)
#define BOTH(k) (IN(k) && IN((k) + 1))
    if (IN(0)) { p0_prologue(F); if (BOTH(0)) xcd_barrier(bar, F.wave); }
    if (IN(1)) {
        pg8::Gemm g{F.XN, F.WinT, M, NPROJ, D_MODEL}; pg8::StaticOrder S; S.init(M, NPROJ, F.G, (int)blockIdx.x);
        { LAS float* cwl = (LAS float*)(F.lds + XL_OFF + 2048);
          const int tl = F.wave * 64 + hw_lane();
          for (int i = tl; i < 2048; i += NWAVES * 64) cwl[i] = i < 1536 ? F.conv_w[i] : F.conv_b[i - 1536];
          if (tl < 128) cwl[2048 + tl] = tl < 64 ? F.qw[tl] : F.kw[tl - 64];
          __syncthreads(); }
        pg8::EpiProj E{F.Y, F.Q, F.SBT, F.SBG, F.lds + XL_OFF};
        pg8::gemm_phase<pg8::EpiProj, pg8::StaticOrder, true, true>(F.lds + RING_OFF, g, S, E, F.wave);
        if (BOTH(1)) xcd_barrier(bar, F.wave);
    }
    if (IN(2)) { attn_pass_a(F); if (BOTH(2)) xcd_barrier(bar, F.wave); }
    if (IN(3)) { attn_pass_b(F); if (BOTH(3)) xcd_barrier(bar, F.wave); }
    if (IN(4)) {
        pg8::Gemm g{F.Y, F.WoutT, M, D_MODEL, D_MODEL}; pg8::StaticOrder S; S.init(M, D_MODEL, F.G, (int)blockIdx.x);
        pg8::EpiRes E{F.x, F.out, D_MODEL};
        pg8::gemm_phase<pg8::EpiRes, pg8::StaticOrder, true, true>(F.lds + RING_OFF, g, S, E, F.wave);
    }
#undef IN
#undef BOTH
}

extern "C" void kernel_launch(void* const* d_in, const int* in_sizes, int n_in, void* d_out, int out_size, void* d_ws, size_t ws_size, hipStream_t stream) {
    static int grid = 0;
    if (grid == 0) {
        if (n_in != 9 || in_sizes[0] != M * D_MODEL || out_size != M * D_MODEL || ws_size < WS_END) { fprintf(stderr, "kernel_launch: unexpected shapes (n_in %d, in0 %d, out %d, ws %zu)\n", n_in, n_in > 0 ? in_sizes[0] : -1, out_size, ws_size); grid = -1; return; }
        int dev = 0, cus = 0, per_cu = 0;
        if (hipGetDevice(&dev) != hipSuccess || hipDeviceGetAttribute(&cus, hipDeviceAttributeMultiprocessorCount, dev) != hipSuccess) { grid = -1; return; }
        if (hipFuncSetAttribute((const void*)mega, hipFuncAttributeMaxDynamicSharedMemorySize, LDS_BYTES) != hipSuccess) { fprintf(stderr, "kernel_launch: hipFuncSetAttribute failed\n"); grid = -1; return; }
        if (hipOccupancyMaxActiveBlocksPerMultiprocessor(&per_cu, (const void*)mega, NWAVES * 64, LDS_BYTES) != hipSuccess || per_cu < 1) { fprintf(stderr, "kernel_launch: occupancy query says %d blocks per CU\n", per_cu); (void)hipGetLastError(); grid = -1; return; }
        grid = cus;
        if (grid != 256) { fprintf(stderr, "kernel_launch: built for a 256-CU device (got %d CUs)\n", cus); grid = -1; return; }
    }
    if (grid < 0) return;
    (void)hipMemsetAsync((char*)d_ws + WS_CTL, 0, CTL_ZERO_BYTES, stream);
    Args a{};
    for (int i = 0; i < 9; ++i) a.in[i] = (const float*)d_in[i];
    a.out = (float*)d_out; a.ws = (unsigned char*)d_ws;
    unsigned char* ws = (unsigned char*)d_ws;
#if STAGE == 4
    a.ph_lo = 0; a.ph_hi = 5;
    hipLaunchKernelGGL(mega, dim3(grid), dim3(NWAVES * 64), LDS_BYTES, stream, a);
    if (PROBE_PHASE >= 0) { a.ph_lo = PROBE_PHASE; a.ph_hi = PROBE_PHASE + 1; hipLaunchKernelGGL(mega, dim3(grid), dim3(NWAVES * 64), LDS_BYTES, stream, a); }
#else
    const int nper = 5;
    for (int p = 0; p < nper; ++p) { a.ph_lo = p; a.ph_hi = p + 1; hipLaunchKernelGGL(mega, dim3(grid), dim3(NWAVES * 64), LDS_BYTES, stream, a); }
#endif
}
```

```cpp
#include <hip/hip_runtime.h>
#include <cstdio>
#include <cstdint>

#ifndef PROBE_PHASE
#define PROBE_PHASE -1
#endif
#ifndef STAGE
#define STAGE 4
#endif

__device__ __forceinline__ int hw_lane() { return (int)__builtin_amdgcn_mbcnt_hi(~0u, __builtin_amdgcn_mbcnt_lo(~0u, 0u)); }

namespace pg8 {
#define PG8_LAS __attribute__((address_space(3)))
typedef unsigned short bf16_t;
typedef short bf16x8 __attribute__((ext_vector_type(8)));
typedef float f32x4 __attribute__((ext_vector_type(4)));
typedef unsigned u32x4 __attribute__((ext_vector_type(4)));
typedef unsigned u32x2 __attribute__((ext_vector_type(2)));
constexpr int BM = 256, BK = 64, HALF = 128, HTB = HALF * BK * 2, STAGE_BYTES = 8 * HTB, NXCD = 8, WGM = 8;

__host__ __device__ __forceinline__ int lds_byte(int r, int c) { const int st = (r >> 4) * 2 + (c >> 5), rr = r & 15, cc = c & 31, ob = rr * 64 + cc * 2; return st * 1024 + (ob ^ (((ob >> 9) & 1) << 5)); }
__host__ __device__ __forceinline__ void stage_rc(int b, int& R, int& C) { const int st = b / 1024, sb = b % 1024, swz = sb ^ (((sb >> 9) & 1) << 5); R = (st >> 1) * 16 + swz / 64; C = (st & 1) * 32 + (swz % 64) / 2; }

struct Unit { int pm, pn; };
struct Gemm { const bf16_t* A; const bf16_t* Bt; int M, N, K; };

struct StaticOrder {
    int nM, nN, nwg, G, c;
    __host__ __device__ void init(int M, int N, int G_, int c_) { nM = M / BM; nN = N / BM; nwg = nM * nN; G = G_; c = c_; }
    __host__ __device__ bool next(int i, Unit& u) const {
        const long L = (long)i * G + c; if (L >= nwg) return false;
        int wgid = (int)L; { const int q = nwg / NXCD, r = nwg % NXCD, xcd = wgid % NXCD, off = wgid / NXCD; wgid = (xcd < r ? xcd * (q + 1) : r * (q + 1) + (xcd - r) * q) + off; }
        const int nig = WGM * nN, gid = wgid / nig, fm = gid * WGM, gsz = (nM - fm) < WGM ? (nM - fm) : WGM;
        u.pm = fm + ((wgid % nig) % gsz); u.pn = (wgid % nig) / gsz; return true;
    }
};

__device__ __forceinline__ unsigned cvt_pk_bf16(float lo, float hi) { unsigned r; asm volatile("v_cvt_pk_bf16_f32 %0, %1, %2" : "=v"(r) : "v"(lo), "v"(hi)); return r; }
__device__ __forceinline__ float silu_f(float z) { return z * __builtin_amdgcn_rcpf(1.f + __builtin_amdgcn_exp2f(-1.4426950408889634f * z)); }

struct EpiProj {
    static constexpr bool PERM = false, AFTER_DRAIN = false, XPRE = false;
    bf16_t *Y, *QKVZ; float *SBT, *SBG; PG8_LAS unsigned char* xl;
    __device__ __forceinline__ void operator()(const f32x4 (&acc)[2][2][4][2], const Unit& u, int wr, int wc, int fr, int fq) const {
        const int row0 = u.pm * BM + wr * 64 + fr;
        if (u.pn < 8) {
            const int lane = fr + 16 * fq, chl = 16 * wc + 4 * fq, ch0 = 64 * u.pn + chl;
            PG8_LAS float* X = (PG8_LAS float*)xl;
            const PG8_LAS float* CWl = (const PG8_LAS float*)(xl + 2048);
            f32x4 t[2][4], g[2][4];
#pragma unroll
            for (int ai = 0; ai < 2; ++ai)
#pragma unroll
                for (int m = 0; m < 4; ++m) {
                    const f32x4 uu = acc[ai][0][m][0], gb = acc[ai][0][m][1], gc = acc[ai][1][m][0], z = acc[ai][1][m][1];
                    t[ai][m] = gc * uu;
#pragma unroll
                    for (int i = 0; i < 4; ++i) g[ai][m][i] = gb[i] * silu_f(z[i]);
                }
#pragma unroll
            for (int ai = 0; ai < 2; ++ai) { const int grpi = 2 * ai + wr;
                if (fr == 0) *(PG8_LAS f32x4*)(X + (grpi * 2 + 0) * 64 + chl) = t[ai][0];
                if (fr == 15) *(PG8_LAS f32x4*)(X + (grpi * 2 + 1) * 64 + chl) = t[ai][3]; }
            if (wr == 0 && fr < 2) { *(f32x4*)(SBT + ((size_t)(u.pm * 4 + fr) * 512 + ch0)) = t[0][0]; if (fr == 0) *(f32x4*)(SBG + ((size_t)(u.pm * 2 + 0) * 512 + ch0)) = g[0][0]; }
            if (wr == 1 && fr >= 14) { *(f32x4*)(SBT + ((size_t)(u.pm * 4 + fr - 12) * 512 + ch0)) = t[1][3]; if (fr == 15) *(f32x4*)(SBG + ((size_t)(u.pm * 2 + 1) * 512 + ch0)) = g[1][3]; }
            asm volatile("s_waitcnt lgkmcnt(0)" ::: "memory"); __builtin_amdgcn_s_barrier(); asm volatile("" ::: "memory");
            const f32x4 w0 = *(const PG8_LAS f32x4*)(CWl + ch0), w1 = *(const PG8_LAS f32x4*)(CWl + 512 + ch0), w2 = *(const PG8_LAS f32x4*)(CWl + 1024 + ch0), cb = *(const PG8_LAS f32x4*)(CWl + 1536 + ch0);
#pragma unroll
            for (int ai = 0; ai < 2; ++ai) { const int grpi = 2 * ai + wr;
                const f32x4 xprev = *(const PG8_LAS f32x4*)(X + (((grpi + 3) & 3) * 2 + 1) * 64 + chl), xnext = *(const PG8_LAS f32x4*)(X + (((grpi + 1) & 3) * 2 + 0) * 64 + chl);
#pragma unroll
                for (int m = 0; m < 4; ++m) {
                    const f32x4 ps = m > 0 ? t[ai][m - 1] : xprev, ns = m < 3 ? t[ai][m + 1] : xnext, tc = t[ai][m];
                    f32x4 tp, tn;
#pragma unroll
                    for (int i = 0; i < 4; ++i) {
                        tp[i] = __builtin_bit_cast(float, __builtin_amdgcn_update_dpp(0, __builtin_bit_cast(int, fr == 15 ? ps[i] : tc[i]), 0x121, 0xf, 0xf, false));
                        tn[i] = __builtin_bit_cast(float, __builtin_amdgcn_update_dpp(0, __builtin_bit_cast(int, fr == 0 ? ns[i] : tc[i]), 0x12F, 0xf, 0xf, false)); }
                    const f32x4 y = g[ai][m] * (w0 * tp + w1 * tc + w2 * tn + cb);
                    const int rt = 128 * ai + 64 * wr + 16 * m + fr;
                    u32x2 yw; yw.x = cvt_pk_bf16(y[0], y[1]); yw.y = cvt_pk_bf16(y[2], y[3]);
                    if (rt != 0 && rt != 255) *(u32x2*)(Y + (size_t)(u.pm * BM + rt) * 1024 + ch0) = yw;
                }
            }
        } else {
            const int grp = (u.pn - 8) >> 1, head = 4 * ((u.pn - 8) & 1) + wc;
            bf16_t* dst = QKVZ + (size_t)grp * (size_t)(16u << 20);
            const int col0 = head * 64 + 8 * fq;
            f32x4 wv[2][2];
            if (grp < 2) { const PG8_LAS float* w = (const PG8_LAS float*)(xl + 10240) + 64 * grp;
#pragma unroll
                for (int bj = 0; bj < 2; ++bj)
#pragma unroll
                    for (int n = 0; n < 2; ++n) wv[bj][n] = *(const PG8_LAS f32x4*)(w + 32 * bj + 8 * fq + 4 * n); }
            const float sc = grp == 0 ? 0.125f * 1.4426950408889634f : 1.f;
#pragma unroll
            for (int ai = 0; ai < 2; ++ai)
#pragma unroll
                for (int m = 0; m < 4; ++m) {
                    f32x4 v[2][2];
#pragma unroll
                    for (int bj = 0; bj < 2; ++bj)
#pragma unroll
                        for (int n = 0; n < 2; ++n) v[bj][n] = acc[ai][bj][m][n];
                    if (grp < 2) {
                        float ss = 0.f;
#pragma unroll
                        for (int bj = 0; bj < 2; ++bj)
#pragma unroll
                            for (int n = 0; n < 2; ++n) ss += (v[bj][n][0] * v[bj][n][0] + v[bj][n][1] * v[bj][n][1]) + (v[bj][n][2] * v[bj][n][2] + v[bj][n][3] * v[bj][n][3]);
                        ss += __shfl_xor(ss, 16); ss += __shfl_xor(ss, 32);
                        const float rs = __builtin_amdgcn_rsqf(ss * (1.f / 64.f) + 1e-6f) * sc;
#pragma unroll
                        for (int bj = 0; bj < 2; ++bj)
#pragma unroll
                            for (int n = 0; n < 2; ++n) v[bj][n] = v[bj][n] * rs * wv[bj][n];
                    }
                    bf16_t* rowp = dst + (size_t)(row0 + ai * HALF + m * 16) * 512 + col0;
#pragma unroll
                    for (int bj = 0; bj < 2; ++bj) { u32x4 w; w.x = cvt_pk_bf16(v[bj][0][0], v[bj][0][1]); w.y = cvt_pk_bf16(v[bj][0][2], v[bj][0][3]); w.z = cvt_pk_bf16(v[bj][1][0], v[bj][1][1]); w.w = cvt_pk_bf16(v[bj][1][2], v[bj][1][3]);
                        *(u32x4*)(rowp + 32 * bj) = w; }
                }
        }
    }
};
struct EpiRes {
    static constexpr bool PERM = false, AFTER_DRAIN = false, XPRE = true;
    const float* X; float* O; int ldc;
    __device__ __forceinline__ void xissue(const Unit& u, int it, int wr, int wc, int fr, int fq, f32x4 (&xv)[4]) const {
        const int ai = it >> 2, bj = (it >> 1) & 1, m0 = 2 * (it & 1);
        const float* ba = X + ((size_t)(u.pm * BM + ai * HALF + m0 * 16) * ldc + u.pn * BM + bj * HALF);
        const float* bb = ba + (size_t)16 * ldc;
        const unsigned voff = (unsigned)(((wr * 64 + fr) * ldc + wc * 32 + 4 * fq) * 4);
        asm volatile("global_load_dwordx4 %0, %4, %5\n\tglobal_load_dwordx4 %1, %4, %5 offset:64\n\tglobal_load_dwordx4 %2, %4, %6\n\tglobal_load_dwordx4 %3, %4, %6 offset:64"
                     : "=&v"(xv[0]), "=&v"(xv[1]), "=&v"(xv[2]), "=&v"(xv[3]) : "v"(voff), "s"(ba), "s"(bb) : "memory");
    }
    __device__ __forceinline__ void xadd(f32x4 (&acc)[2][2][4][2], int it, f32x4 (&xv)[4]) const {
        asm volatile("" : "+v"(xv[0]), "+v"(xv[1]), "+v"(xv[2]), "+v"(xv[3]));
#define XA(AI, BJ, M0) do { acc[AI][BJ][M0][0] += xv[0]; acc[AI][BJ][M0][1] += xv[1]; acc[AI][BJ][M0 + 1][0] += xv[2]; acc[AI][BJ][M0 + 1][1] += xv[3]; } while (0)
        switch (it) { case 0: XA(0, 0, 0); break; case 1: XA(0, 0, 2); break; case 2: XA(0, 1, 0); break; case 3: XA(0, 1, 2); break;
                      case 4: XA(1, 0, 0); break; case 5: XA(1, 0, 2); break; case 6: XA(1, 1, 0); break; default: XA(1, 1, 2); break; }
#undef XA
    }
    __device__ __forceinline__ void operator()(const f32x4 (&acc)[2][2][4][2], const Unit& u, int wr, int wc, int fr, int fq) const {
        const int row0 = u.pm * BM + wr * 64 + fr, col0 = u.pn * BM + wc * 32 + 4 * fq;
#pragma unroll
        for (int ai = 0; ai < 2; ++ai)
#pragma unroll
            for (int m = 0; m < 4; ++m) { const size_t off = (size_t)(row0 + ai * HALF + m * 16) * ldc + col0;
#pragma unroll
                for (int bj = 0; bj < 2; ++bj)
#pragma unroll
                    for (int n = 0; n < 2; ++n) *(f32x4*)(O + off + bj * HALF + n * 16) = acc[ai][bj][m][n]; }
    }
};

template <class Epi, class Sched, bool ALIGN_EPI = false, bool SP2 = false>
__device__ __forceinline__ void gemm_phase(PG8_LAS unsigned char* lds, const Gemm g, const Sched& S, const Epi& E, const int widx) {
    const int lane = hw_lane(), wid = widx, tid = wid * 64 + lane, wr = wid >> 2, wc = wid & 3, fr = lane & 15, fq = lane >> 4;
    const int K = g.K, nt = K / BK;
    unsigned voffA[2], voffB[2];
#pragma unroll
    for (int i = 0; i < 2; ++i) { int R, C; stage_rc(tid * 16 + i * 8192, R, C);
        voffA[i] = (unsigned)(R * K + C) * 2u; voffB[i] = (unsigned)(R * K + C) * 2u; }
    const size_t kstep = (size_t)(BK * 2);
    const size_t hstep = (size_t)HALF * K * 2;
    const size_t tstep = 2 * hstep;
    const unsigned ldsw = (unsigned)wid * 1024u;
    const int aoff = lds_byte(wr * 64 + fr, fq * 8), boff = lds_byte(wc * 32 + fr, fq * 8);
#define PG8_SA(b, h) (((b) * 2 + (h)) * HTB)
#define PG8_SB(b, h) ((4 + (b) * 2 + (h)) * HTB)
#define PG8_STAGE(bufoff, gbase, voff) do { _Pragma("unroll") for (int _i = 0; _i < 2; ++_i) \
        __builtin_amdgcn_global_load_lds((const unsigned*)((const char*)(gbase) + (voff)[_i]), (PG8_LAS unsigned*)(lds + (bufoff) + ldsw + _i * 8192), 16, 0, 0); } while (0)
#define PG8_LDA(dst, b, h) do { _Pragma("unroll") for (int m = 0; m < 4; ++m) _Pragma("unroll") for (int k = 0; k < 2; ++k) dst[m][k] = *(const PG8_LAS bf16x8*)(lds + PG8_SA(b, h) + aoff + m * 2048 + k * 1024); } while (0)
#define PG8_LDB(dst, b, h) do { _Pragma("unroll") for (int n = 0; n < 2; ++n) _Pragma("unroll") for (int k = 0; k < 2; ++k) dst[n][k] = *(const PG8_LAS bf16x8*)(lds + PG8_SB(b, h) + boff + n * 2048 + k * 1024); } while (0)
#define PG8_MMA(ai, bj, At, Bt) do { __builtin_amdgcn_s_setprio(1); _Pragma("unroll") for (int m = 0; m < 4; ++m) _Pragma("unroll") for (int n = 0; n < 2; ++n) _Pragma("unroll") for (int k = 0; k < 2; ++k) \
        acc[ai][bj][m][n] = __builtin_amdgcn_mfma_f32_16x16x32_bf16(Bt[n][k], At[m][k], acc[ai][bj][m][n], 0, 0, 0); __builtin_amdgcn_s_setprio(0); } while (0)
#define PG8_WAIT_V(n) asm volatile("s_waitcnt vmcnt(" #n ")" ::: "memory")
#define PG8_WAIT_L(n) asm volatile("s_waitcnt lgkmcnt(" #n ")" ::: "memory")
#define PG8_BAR __builtin_amdgcn_s_barrier()
#define PG8_SCHED __builtin_amdgcn_sched_barrier(0)
    Unit cur, nxt; int ui = 0;
    if (!S.next(0, cur)) return;
    f32x4 acc[2][2][4][2];
#pragma unroll
    for (int a = 0; a < 2; ++a)
#pragma unroll
        for (int b = 0; b < 2; ++b)
#pragma unroll
            for (int m = 0; m < 4; ++m)
#pragma unroll
                for (int n = 0; n < 2; ++n) acc[a][b][m][n] = (f32x4){0.f, 0.f, 0.f, 0.f};
    bf16x8 At[4][2], B0[2][2], B1[2][2]; f32x4 xv[4];
    const char* cA = (const char*)g.A + (size_t)cur.pm * tstep; const char* cB = (const char*)g.Bt + (size_t)cur.pn * tstep;
    if constexpr (SP2) {
        PG8_STAGE(PG8_SB(0, 0), cB, voffB); PG8_STAGE(PG8_SB(0, 1), cB + hstep, voffB); PG8_STAGE(PG8_SA(0, 0), cA, voffA); PG8_STAGE(PG8_SA(0, 1), cA + hstep, voffA);
        if (wr == 1) PG8_BAR;
        PG8_WAIT_V(2); PG8_BAR;
        PG8_STAGE(PG8_SB(1, 0), cB + kstep, voffB); PG8_STAGE(PG8_SA(1, 0), cA + kstep, voffA); PG8_STAGE(PG8_SB(1, 1), cB + hstep + kstep, voffB);
        PG8_WAIT_V(6); PG8_BAR;
    } else {
        PG8_STAGE(PG8_SB(0, 0), cB, voffB); PG8_STAGE(PG8_SA(0, 0), cA, voffA); PG8_STAGE(PG8_SB(0, 1), cB + hstep, voffB); PG8_STAGE(PG8_SA(0, 1), cA + hstep, voffA);
        if (wr == 1) PG8_BAR;
        PG8_WAIT_V(4); PG8_BAR;
        PG8_STAGE(PG8_SB(1, 0), cB + kstep, voffB); PG8_STAGE(PG8_SA(1, 0), cA + kstep, voffA); PG8_STAGE(PG8_SB(1, 1), cB + hstep + kstep, voffB);
        PG8_WAIT_V(6); PG8_BAR;
    }
    for (;;) {
        const bool has_next = S.next(ui + 1, nxt);
        const char* nA = has_next ? (const char*)g.A + (size_t)nxt.pm * tstep : cA; const char* nB = has_next ? (const char*)g.Bt + (size_t)nxt.pn * tstep : cB;
        if constexpr (Epi::XPRE) {
#pragma unroll
        for (int t = 0; t < 16; t += 2) {
            const bool last = (t == nt - 2);
            const char* a1 = cA + (size_t)(t + 1) * kstep;
            const char* a2 = last ? nA : cA + (size_t)(t + 2) * kstep; const char* b2 = last ? nB : cB + (size_t)(t + 2) * kstep;
            const char* a3 = a2 + kstep; const char* b3 = b2 + kstep;
            if constexpr (SP2) {
            if constexpr (Epi::XPRE) E.xissue(cur, t >> 1, wr, wc, fr, fq, xv);
            PG8_LDB(B0, 0, 0); PG8_LDB(B1, 0, 1); PG8_SCHED; PG8_LDA(At, 0, 0); PG8_STAGE(PG8_SA(1, 1), a1 + hstep, voffA);
            if constexpr (Epi::XPRE) PG8_WAIT_V(12); else PG8_WAIT_V(8);
            PG8_WAIT_L(0); PG8_BAR; PG8_MMA(0, 0, At, B0); PG8_MMA(0, 1, At, B1); PG8_BAR; PG8_SCHED;
            PG8_LDA(At, 0, 1); PG8_STAGE(PG8_SB(0, 0), b2, voffB); PG8_STAGE(PG8_SB(0, 1), b2 + hstep, voffB); PG8_STAGE(PG8_SA(0, 0), a2, voffA);
            if constexpr (Epi::XPRE) PG8_WAIT_V(12); else PG8_WAIT_V(8);
            PG8_WAIT_L(0); PG8_BAR; PG8_MMA(1, 0, At, B0); PG8_MMA(1, 1, At, B1); PG8_BAR; PG8_SCHED;
            PG8_LDB(B0, 1, 0); PG8_LDB(B1, 1, 1); PG8_SCHED; PG8_LDA(At, 1, 0); PG8_STAGE(PG8_SA(0, 1), a2 + hstep, voffA);
            PG8_WAIT_V(8); PG8_WAIT_L(0); PG8_BAR;
            if constexpr (Epi::XPRE) E.xadd(acc, t >> 1, xv);
            PG8_MMA(0, 0, At, B0); PG8_MMA(0, 1, At, B1); PG8_BAR; PG8_SCHED;
            PG8_LDA(At, 1, 1); PG8_STAGE(PG8_SB(1, 0), b3, voffB); PG8_STAGE(PG8_SB(1, 1), b3 + hstep, voffB); PG8_STAGE(PG8_SA(1, 0), a3, voffA);
            PG8_WAIT_V(8); PG8_WAIT_L(0); PG8_BAR; PG8_MMA(1, 0, At, B0); PG8_MMA(1, 1, At, B1); PG8_BAR; PG8_SCHED;
            } else {
            PG8_LDB(B0, 0, 0); PG8_SCHED; PG8_LDA(At, 0, 0); PG8_STAGE(PG8_SA(1, 1), a1 + hstep, voffA);
            PG8_WAIT_L(8); PG8_BAR; PG8_WAIT_L(0); PG8_MMA(0, 0, At, B0); PG8_BAR; PG8_SCHED;
            PG8_LDB(B1, 0, 1); PG8_STAGE(PG8_SB(0, 0), b2, voffB);
            PG8_BAR; PG8_WAIT_L(0); PG8_MMA(0, 1, At, B1); PG8_BAR;
            PG8_LDA(At, 0, 1); PG8_STAGE(PG8_SA(0, 0), a2, voffA);
            PG8_BAR; PG8_WAIT_L(0); PG8_MMA(1, 0, At, B0); PG8_BAR; PG8_SCHED;
            PG8_STAGE(PG8_SB(0, 1), b2 + hstep, voffB);
            PG8_WAIT_V(6); PG8_BAR; PG8_MMA(1, 1, At, B1); PG8_BAR;
            PG8_LDB(B0, 1, 0); PG8_SCHED; PG8_LDA(At, 1, 0); PG8_STAGE(PG8_SA(0, 1), a2 + hstep, voffA);
            PG8_WAIT_L(8); PG8_BAR; PG8_WAIT_L(0); PG8_MMA(0, 0, At, B0); PG8_BAR; PG8_SCHED;
            PG8_LDB(B1, 1, 1); PG8_STAGE(PG8_SB(1, 0), b3, voffB);
            PG8_BAR; PG8_WAIT_L(0); PG8_MMA(0, 1, At, B1); PG8_BAR;
            PG8_LDA(At, 1, 1); PG8_STAGE(PG8_SA(1, 0), a3, voffA);
            PG8_BAR; PG8_WAIT_L(0); PG8_MMA(1, 0, At, B0); PG8_BAR; PG8_SCHED;
            PG8_STAGE(PG8_SB(1, 1), b3 + hstep, voffB);
            PG8_WAIT_V(6); PG8_BAR; PG8_MMA(1, 1, At, B1); PG8_BAR;
            }
                }
        } else {
        for (int t = 0; t < nt; t += 2) {
            const bool last = (t == nt - 2);
            const char* a1 = cA + (size_t)(t + 1) * kstep;
            const char* a2 = last ? nA : cA + (size_t)(t + 2) * kstep; const char* b2 = last ? nB : cB + (size_t)(t + 2) * kstep;
            const char* a3 = a2 + kstep; const char* b3 = b2 + kstep;
            if constexpr (SP2) {
            if constexpr (Epi::XPRE) E.xissue(cur, t >> 1, wr, wc, fr, fq, xv);
            PG8_LDB(B0, 0, 0); PG8_LDB(B1, 0, 1); PG8_SCHED; PG8_LDA(At, 0, 0); PG8_STAGE(PG8_SA(1, 1), a1 + hstep, voffA);
            if constexpr (Epi::XPRE) PG8_WAIT_V(12); else PG8_WAIT_V(8);
            PG8_WAIT_L(0); PG8_BAR; PG8_MMA(0, 0, At, B0); PG8_MMA(0, 1, At, B1); PG8_BAR; PG8_SCHED;
            PG8_LDA(At, 0, 1); PG8_STAGE(PG8_SB(0, 0), b2, voffB); PG8_STAGE(PG8_SB(0, 1), b2 + hstep, voffB); PG8_STAGE(PG8_SA(0, 0), a2, voffA);
            if constexpr (Epi::XPRE) PG8_WAIT_V(12); else PG8_WAIT_V(8);
            PG8_WAIT_L(0); PG8_BAR; PG8_MMA(1, 0, At, B0); PG8_MMA(1, 1, At, B1); PG8_BAR; PG8_SCHED;
            PG8_LDB(B0, 1, 0); PG8_LDB(B1, 1, 1); PG8_SCHED; PG8_LDA(At, 1, 0); PG8_STAGE(PG8_SA(0, 1), a2 + hstep, voffA);
            PG8_WAIT_V(8); PG8_WAIT_L(0); PG8_BAR;
            if constexpr (Epi::XPRE) E.xadd(acc, t >> 1, xv);
            PG8_MMA(0, 0, At, B0); PG8_MMA(0, 1, At, B1); PG8_BAR; PG8_SCHED;
            PG8_LDA(At, 1, 1); PG8_STAGE(PG8_SB(1, 0), b3, voffB); PG8_STAGE(PG8_SB(1, 1), b3 + hstep, voffB); PG8_STAGE(PG8_SA(1, 0), a3, voffA);
            PG8_WAIT_V(8); PG8_WAIT_L(0); PG8_BAR; PG8_MMA(1, 0, At, B0); PG8_MMA(1, 1, At, B1); PG8_BAR; PG8_SCHED;
            } else {
            PG8_LDB(B0, 0, 0); PG8_SCHED; PG8_LDA(At, 0, 0); PG8_STAGE(PG8_SA(1, 1), a1 + hstep, voffA);
            PG8_WAIT_L(8); PG8_BAR; PG8_WAIT_L(0); PG8_MMA(0, 0, At, B0); PG8_BAR; PG8_SCHED;
            PG8_LDB(B1, 0, 1); PG8_STAGE(PG8_SB(0, 0), b2, voffB);
            PG8_BAR; PG8_WAIT_L(0); PG8_MMA(0, 1, At, B1); PG8_BAR;
            PG8_LDA(At, 0, 1); PG8_STAGE(PG8_SA(0, 0), a2, voffA);
            PG8_BAR; PG8_WAIT_L(0); PG8_MMA(1, 0, At, B0); PG8_BAR; PG8_SCHED;
            PG8_STAGE(PG8_SB(0, 1), b2 + hstep, voffB);
            PG8_WAIT_V(6); PG8_BAR; PG8_MMA(1, 1, At, B1); PG8_BAR;
            PG8_LDB(B0, 1, 0); PG8_SCHED; PG8_LDA(At, 1, 0); PG8_STAGE(PG8_SA(0, 1), a2 + hstep, voffA);
            PG8_WAIT_L(8); PG8_BAR; PG8_WAIT_L(0); PG8_MMA(0, 0, At, B0); PG8_BAR; PG8_SCHED;
            PG8_LDB(B1, 1, 1); PG8_STAGE(PG8_SB(1, 0), b3, voffB);
            PG8_BAR; PG8_WAIT_L(0); PG8_MMA(0, 1, At, B1); PG8_BAR;
            PG8_LDA(At, 1, 1); PG8_STAGE(PG8_SA(1, 0), a3, voffA);
            PG8_BAR; PG8_WAIT_L(0); PG8_MMA(1, 0, At, B0); PG8_BAR; PG8_SCHED;
            PG8_STAGE(PG8_SB(1, 1), b3 + hstep, voffB);
            PG8_WAIT_V(6); PG8_BAR; PG8_MMA(1, 1, At, B1); PG8_BAR;
            }
                }
        }
        if constexpr (ALIGN_EPI) { if (wr == 0) PG8_BAR; }
        E(acc, cur, wr, wc, fr, fq);
        if (!has_next) break;
#pragma unroll
        for (int a = 0; a < 2; ++a)
#pragma unroll
            for (int b = 0; b < 2; ++b)
#pragma unroll
                for (int m = 0; m < 4; ++m)
#pragma unroll
                    for (int n = 0; n < 2; ++n) acc[a][b][m][n] = (f32x4){0.f, 0.f, 0.f, 0.f};
        cur = nxt; cA = nA; cB = nB; ++ui;
        if constexpr (ALIGN_EPI) { if (wr == 1) PG8_BAR; }
    }
    PG8_WAIT_V(0);
    if constexpr (!ALIGN_EPI) { if (wr == 0) PG8_BAR; }
    PG8_BAR;
#undef PG8_SA
#undef PG8_SB
#undef PG8_STAGE
#undef PG8_LDA
#undef PG8_LDB
#undef PG8_MMA
#undef PG8_WAIT_V
#undef PG8_WAIT_L
#undef PG8_BAR
#undef PG8_SCHED
}
}

constexpr int D_MODEL = 1024, BATCH = 2, SEQ = 16384, M = BATCH * SEQ, NPROJ = 4096, AW = 512, NHEAD = 8;
constexpr int NWAVES = 8;
constexpr size_t MiB = 1u << 20;
constexpr size_t WS_CTL = 0, CTL_ZERO_BYTES = 32768;
#ifndef WS_SHIFT_MIB
#define WS_SHIFT_MIB 0
#endif
constexpr size_t WS_SH = (size_t)WS_SHIFT_MIB * MiB;
constexpr size_t WS_TBG = WS_SH + 1 * MiB;
constexpr size_t WS_WIN = WS_SH + 2 * MiB;
constexpr size_t WS_WOUT = WS_SH + 10 * MiB;
constexpr size_t WS_LP4 = WS_SH + 12 * MiB, WS_LP16 = WS_SH + 13 * MiB;
constexpr size_t WS_SBT = WS_SH + 14 * MiB, WS_SBG = WS_SH + 15 * MiB;
constexpr size_t WS_XN = WS_SH + 16 * MiB;
constexpr size_t WS_Q = WS_SH + 80 * MiB, WS_K = WS_SH + 112 * MiB, WS_V = WS_SH + 144 * MiB, WS_ZG = WS_SH + 176 * MiB;
constexpr size_t WS_OP4 = WS_XN, WS_OP16 = WS_XN + 32 * MiB;
constexpr size_t WS_Y = WS_SH + 208 * MiB;
constexpr size_t WS_END = WS_SH + 272 * MiB;
constexpr int CW_BAR = 4096;

constexpr int RING_OFF = 0, RING_BYTES = 131072;
constexpr int LDSCTL_OFF = 146432, MISC_OFF = LDSCTL_OFF + 320;
constexpr int LDS_BYTES = 147456;
constexpr int XL_OFF = 131072;
static_assert(XL_OFF + 10752 <= LDSCTL_OFF, "LDS map");

#define GAS __attribute__((address_space(1)))
#define LAS __attribute__((address_space(3)))
typedef unsigned short bf16;
typedef unsigned v4u __attribute__((ext_vector_type(4)));
typedef float f32x4 __attribute__((ext_vector_type(4)));
typedef float f32x16 __attribute__((ext_vector_type(16)));
typedef short bf16x8 __attribute__((ext_vector_type(8)));
typedef short s16x4 __attribute__((ext_vector_type(4)));
typedef GAS unsigned gu32;
#define RLX_AGENT __ATOMIC_RELAXED, __HIP_MEMORY_SCOPE_AGENT
#define LDS_WAIT() asm volatile("s_waitcnt lgkmcnt(0)" ::: "memory")
__device__ __forceinline__ unsigned f2bf(float f) { unsigned u = __builtin_bit_cast(unsigned, f); return (u + 0x7fffu + ((u >> 16) & 1u)) >> 16; }
__device__ __forceinline__ unsigned pk2(float lo, float hi) { return f2bf(lo) | (f2bf(hi) << 16); }
__device__ __forceinline__ float bf2f(unsigned short b) { return __builtin_bit_cast(float, (unsigned)b << 16); }
__device__ __forceinline__ float bflo(unsigned w) { return __builtin_bit_cast(float, w << 16); }
__device__ __forceinline__ float bfhi(unsigned w) { return __builtin_bit_cast(float, w & 0xffff0000u); }

#define XB_TMO      128
#define XB_XCNT(j)  (256  + 64 * (j))
#define XB_XSUB(j)  (1280 + 64 * (j))
#define XB_XGEN(j)  (2304 + 64 * (j))
#define XB_TOP      3328
#define XB_TOPGEN   3392
#define XCD_BAR_WORDS 3456
#define XB_SPIN_CAP (1u << 18)
__device__ __forceinline__ unsigned xb_ld(unsigned* p)              { return __hip_atomic_load(p, __ATOMIC_RELAXED, __HIP_MEMORY_SCOPE_AGENT); }
__device__ __forceinline__ unsigned xb_add(unsigned* p, unsigned v) { return __hip_atomic_fetch_add(p, v, __ATOMIC_RELAXED, __HIP_MEMORY_SCOPE_AGENT); }
__device__ __forceinline__ unsigned xb_xcc_id() { return (unsigned)__builtin_amdgcn_s_getreg((3 << 11) | 20) & 0xFu; }
#define XB_SPIN(cond, bar) do { unsigned _sp = 0; while (cond) { __builtin_amdgcn_s_sleep(1); \
    if ((++_sp & 255u) == 0u) { if (xb_ld(&(bar)[XB_TMO])) break; if (_sp > XB_SPIN_CAP) { atomicAdd(&(bar)[XB_TMO], 1u); break; } } } } while (0)
struct XcdBarrier { unsigned* bar; unsigned x; volatile LAS unsigned* st; };
__device__ __forceinline__ XcdBarrier xcd_barrier_post(unsigned* bar, volatile LAS unsigned* st) {
    XcdBarrier b; b.bar = bar; b.x = xb_xcc_id(); b.st = st;
    if (threadIdx.x == 0) (void)xb_add(&bar[XB_XCNT(b.x)], 1u);
    return b;
}
__device__ __forceinline__ void xcd_barrier_complete(unsigned* bar, unsigned x, unsigned& nloc, unsigned& nx) {
    const unsigned G = gridDim.x * gridDim.y * gridDim.z;
    unsigned sum, cnt, mine, sp = 0u;
    for (;;) {
        sum = 0u; cnt = 0u; mine = 0u;
#pragma unroll
        for (unsigned j = 0; j < 16; ++j) { const unsigned c = xb_ld(&bar[XB_XCNT(j)]); sum += c; cnt += (c > 0u) ? 1u : 0u; mine = (j == x) ? c : mine; }
        if (sum == G) break;
        __builtin_amdgcn_s_sleep(1);
        if ((++sp & 255u) == 0u) { if (xb_ld(&bar[XB_TMO])) break; if (sp > XB_SPIN_CAP) { atomicAdd(&bar[XB_TMO], 1u); break; } }
    }
    nloc = mine > 0u ? mine : 1u; nx = cnt > 0u ? cnt : 1u;
}
__device__ __forceinline__ void xcd_barrier(const XcdBarrier& b, const int wave) {
    asm volatile("s_waitcnt vmcnt(0)" ::: "memory");
    __syncthreads();
    if (wave == 0 && hw_lane() == 0) {
        unsigned* bar = b.bar;
        __builtin_amdgcn_s_waitcnt(0);
        unsigned nloc = b.st[0], nx = b.st[1];
        if (nloc == 0u) { xcd_barrier_complete(bar, b.x, nloc, nx); b.st[0] = nloc; b.st[1] = nx; }
        const unsigned old = xb_add(&bar[XB_XSUB(b.x)], 1u);
        const unsigned gen = old / nloc;
        if (old + 1u == (gen + 1u) * nloc) {
            __builtin_amdgcn_fence(__ATOMIC_RELEASE, "agent");
            asm volatile("s_waitcnt vmcnt(0)" ::: "memory");
            const unsigned og = xb_add(&bar[XB_TOP], 1u);
            const unsigned tg = og / nx;
            if (og + 1u == (tg + 1u) * nx) xb_add(&bar[XB_TOPGEN], 1u);
            else XB_SPIN(xb_ld(&bar[XB_TOPGEN]) == tg, bar);
            __builtin_amdgcn_fence(__ATOMIC_ACQUIRE, "agent");
            xb_add(&bar[XB_XGEN(b.x)], 1u);
            asm volatile("s_waitcnt vmcnt(0)" ::: "memory");
        } else {
            XB_SPIN(xb_ld(&bar[XB_XGEN(b.x)]) == gen, bar);
            __builtin_amdgcn_fence(__ATOMIC_ACQUIRE, "agent");
            asm volatile("s_waitcnt vmcnt(0)" ::: "memory");
        }
    }
    __syncthreads();
}

struct Frame {
    LAS unsigned char* lds;
    volatile LAS unsigned* MISC;
    gu32* ctl;
    int vcu, G, wave;
    const float *x, *norm_w, *w_in, *conv_w, *conv_b, *qw, *kw, *rel_bias, *w_out; float* out;
    bf16 *WinT, *WoutT, *XN, *Q, *K, *V, *ZG, *OP4, *OP16, *Y;
    float *TBG, *LP4, *LP16, *SBT, *SBG;
};
__device__ __forceinline__ float wave_sum(float v) {
#pragma unroll
    for (int o = 1; o < 64; o <<= 1) v += __shfl_xor(v, o);
    return v;
}
__device__ __forceinline__ float wave_max(float v) {
#pragma unroll
    for (int o = 1; o < 64; o <<= 1) v = fmaxf(v, __shfl_xor(v, o));
    return v;
}
__device__ __forceinline__ int win_row(int L) {
    int pn, wc, bj, n, fq, reg;
    if (L < 2048) { const int which = L >> 9, ch = L & 511; pn = ch >> 6; wc = (ch >> 4) & 3; fq = (ch >> 2) & 3; reg = ch & 3; bj = which >> 1; n = which & 1; }
    else { const int Lp = L - 2048, grp = Lp >> 9, head = (Lp >> 6) & 7, e = Lp & 63; pn = 8 + 2 * grp + (head >> 2); wc = head & 3; bj = e >> 5; fq = (e >> 3) & 3; n = (e >> 2) & 1; reg = e & 3; }
    return pn * 256 + 128 * bj + 32 * wc + 16 * n + 4 * fq + reg;
}
template <bool PERMUTE>
__device__ __forceinline__ void p0_transpose_item(const float* W, int K, int N, bf16* WT, LAS float* scr, int item, int lane) {
    const int nblk = N / 32, kb = item / nblk, nb = item % nblk, k0 = 64 * kb, n0 = 32 * nb;
#pragma unroll 8
    for (int i = 0; i < 32; ++i) { const int kk = 2 * i + (lane >> 5); scr[kk * 33 + (lane & 31)] = W[(size_t)(k0 + kk) * N + n0 + (lane & 31)]; }
    LDS_WAIT(); asm volatile("" ::: "memory");
    const int c = lane & 7;
#pragma unroll
    for (int j = 0; j < 4; ++j) { const int n = (lane >> 3) + 8 * j; const LAS float* s = scr + (8 * c) * 33 + n;
        v4u o; o.x = pk2(s[0 * 33], s[1 * 33]); o.y = pk2(s[2 * 33], s[3 * 33]); o.z = pk2(s[4 * 33], s[5 * 33]); o.w = pk2(s[6 * 33], s[7 * 33]);
        const int dr = PERMUTE ? win_row(n0 + n) : (n0 + n);
        *(GAS v4u*)(WT + (size_t)dr * K + k0 + 8 * c) = o; }
    LDS_WAIT(); asm volatile("" ::: "memory");
}
__device__ __forceinline__ int t5_bucket(int rel) {
    const int n = rel < 0 ? -rel : rel; int b = rel > 0 ? 16 : 0;
    if (n < 8) return b + n;
    int large = 8 + (int)(logf((float)n / 8.f) / logf(128.f) * 8.f);
    if (large > 15) large = 15;
    return b + large;
}
__device__ __forceinline__ void p0_prologue(Frame& F) {
    const int lane_l = hw_lane(), wave_l = F.wave, tid_l = wave_l * 64 + lane_l;
    LAS float* scr = (LAS float*)(F.lds + RING_OFF + wave_l * 16384);
    const int gw = F.vcu * NWAVES + wave_l, NGW = F.G * NWAVES;
    constexpr int I_IN = (D_MODEL / 64) * (NPROJ / 32), I_OUT = (D_MODEL / 64) * (D_MODEL / 32);
    for (int it = gw; it < I_IN + I_OUT; it += NGW) {
        if (it < I_IN) p0_transpose_item<true>(F.w_in, D_MODEL, NPROJ, F.WinT, scr, it, lane_l);
        else p0_transpose_item<false>(F.w_out, D_MODEL, D_MODEL, F.WoutT, scr, it - I_IN, lane_l);
    }
    f32x4 nw[4];
#pragma unroll
    for (int j = 0; j < 4; ++j) nw[j] = ((const f32x4*)F.norm_w)[lane_l + 64 * j];
    for (int m = gw; m < M; m += NGW) {
        const GAS f32x4* xr = (const GAS f32x4*)(F.x + (size_t)m * D_MODEL) + lane_l;
        f32x4 v[4]; float s = 0.f;
#pragma unroll
        for (int j = 0; j < 4; ++j) { v[j] = xr[64 * j]; s += (v[j].x * v[j].x + v[j].y * v[j].y) + (v[j].z * v[j].z + v[j].w * v[j].w); }
        const float rstd = 1.f / sqrtf(wave_sum(s) * (1.f / D_MODEL) + 1e-6f);
        GAS unsigned long long* o8 = (GAS unsigned long long*)(F.XN + (size_t)m * D_MODEL) + lane_l;
#pragma unroll
        for (int j = 0; j < 4; ++j) { const f32x4 y = v[j] * rstd * nw[j]; o8[64 * j] = (unsigned long long)pk2(y.x, y.y) | ((unsigned long long)pk2(y.z, y.w) << 32); }
    }
    if (blockIdx.x == 0) {
        const float mq = wave_max(fabsf(F.qw[lane_l])), mk = wave_max(fabsf(F.kw[lane_l]));
        float mb = 0.f;
#pragma unroll
        for (int j = 0; j < 4; ++j) mb = fmaxf(mb, fabsf(F.rel_bias[lane_l + 64 * j]));
        mb = wave_max(mb);
        const float M2 = (8.f * mq * mk + mb) * 1.4426950408889634f;
        for (int i = tid_l; i < 3 * 8 * 192; i += NWAVES * 64) {
            const int jp = i % 192, h = (i / 192) & 7, c = i / (192 * 8), j = jp - 32;
            const int dil = c == 0 ? 1 : (c == 1 ? 4 : 16);
            float v = -1e30f;
            if (j >= 0 && j <= 128) v = F.rel_bias[t5_bucket((j - 64) * dil) * 8 + h] * 1.4426950408889634f - M2;
            F.TBG[i] = v;
        }
    }
}

__device__ __forceinline__ int crow(int r, int hi) { return (r & 3) + 8 * (r >> 2) + 4 * hi; }
__device__ __forceinline__ unsigned cvtpk_s(float lo, float hi) { typedef float f2 __attribute__((ext_vector_type(2))); typedef __bf16 b2 __attribute__((ext_vector_type(2))); f2 v = {lo, hi}; b2 b = __builtin_convertvector(v, b2); return __builtin_bit_cast(unsigned, b); }
typedef short v4i16_t __attribute__((ext_vector_type(4)));
__device__ __forceinline__ s16x4 vtr(LAS const unsigned char* p) { return __builtin_bit_cast(s16x4, __builtin_amdgcn_ds_read_tr16_b64_v4i16((LAS v4i16_t*)p)); }

__device__ __forceinline__ void conv_fixup_item(Frame& F, int idx, int lane) {
    const int ridx = idx >> 3, ch = (idx & 7) * 64 + lane, pm = ridx >> 1, last = ridx & 1;
    const bool hasp = last || (pm % (SEQ / 256) != 0), hasn = !last || (pm % (SEQ / 256) != SEQ / 256 - 1);
    const float tc = F.SBT[(size_t)(pm * 4 + (last ? 3 : 0)) * 512 + ch];
    const float tp = last ? F.SBT[(size_t)(pm * 4 + 2) * 512 + ch] : F.SBT[(size_t)((hasp ? pm - 1 : pm) * 4 + 3) * 512 + ch];
    const float tn = last ? F.SBT[(size_t)((hasn ? pm + 1 : pm) * 4 + 0) * 512 + ch] : F.SBT[(size_t)(pm * 4 + 1) * 512 + ch];
    const float g = F.SBG[(size_t)(pm * 2 + last) * 512 + ch];
    const float y = g * (F.conv_w[ch] * (hasp ? tp : 0.f) + F.conv_w[512 + ch] * tc + F.conv_w[1024 + ch] * (hasn ? tn : 0.f) + F.conv_b[ch]);
    F.Y[(size_t)(pm * 256 + (last ? 255 : 0)) * D_MODEL + ch] = (bf16)f2bf(y);
}
constexpr int AT_TILE = 8448, AT_KCH = 528, AT_VOFF = 4224, AT_VPC = 1056, AT_NT = 12;
constexpr int AT_OST = AT_NT * AT_TILE;
constexpr int AT_TBL = AT_OST + NWAVES * 4096;
constexpr int AT_LW = AT_TBL + 768;
static_assert(AT_LW + NWAVES * 128 <= LDSCTL_OFF, "attention LDS map");
struct TaskD { int dil, L, i0, hq, c, h, tok0; };
template <bool FINAL>
__device__ __forceinline__ TaskD unit_decode(int vcu, int i) {
    TaskD D; const int x = vcu >> 5, j = vcu & 31;
    int pair, r, blk;
    if (FINAL) { pair = 2 * x + 1 - (i >> 1);     r = 0; blk = 2 * j + (i & 1); D.c = 0; D.dil = 1; D.L = SEQ; }
    else { pair = 2 * x + (i >> 2); const int k = i & 3;
        if (j < 16) { D.c = 1; D.dil = 4; D.L = SEQ / 4; r = j >> 2; blk = 4 * (j & 3) + k; } else { D.c = 2; D.dil = 16; D.L = SEQ / 16; r = j - 16; blk = k; } }
    D.h = pair & 7; D.hq = D.h * 64; D.tok0 = (pair >> 3) * SEQ + r; D.i0 = blk * 256;
    return D;
}
#define AT_BAR() do { asm volatile("s_waitcnt lgkmcnt(0)" ::: "memory"); __builtin_amdgcn_s_barrier(); asm volatile("" ::: "memory"); } while (0)
template <bool FINAL>
__device__ __forceinline__ void attn_units(Frame& F) {
    constexpr int u0 = 0, u1 = FINAL ? 4 : 8;
    const int lane = hw_lane(), w = F.wave, tid_l = w * 64 + lane, r32 = lane & 31, hi = lane >> 5;
    LAS unsigned char* L0 = F.lds;
    LAS unsigned short* stgb = (LAS unsigned short*)(F.lds + AT_OST + w * 4096);
    LAS float* tbl = (LAS float*)(F.lds + AT_TBL);
    LAS float* lw = (LAS float*)(F.lds + AT_LW) + w * 32;
    const int vaddr = AT_VOFF + ((lane >> 4) & 1) * 32 + (lane & 3) * 8 + (4 * hi + ((lane & 15) >> 2)) * 64;
    const bool isV = w >= 4; const int srow = 8 * (w & 3) + (lane >> 3), sch = lane & 7;
    const int sdst = isV ? (AT_VOFF + (sch >> 2) * (2 * AT_VPC) + (srow >> 4) * AT_VPC + (srow & 15) * 64 + (sch & 3) * 16) : (sch * AT_KCH + srow * 16);
    const bf16* ssrc = isV ? F.V : F.K;
    bf16x8 st[AT_NT], qr[4];
#define STAGE_LOAD(D_) do { _Pragma("unroll") for (int t_ = 0; t_ < AT_NT; ++t_) { int key_ = (D_).i0 - 64 + 32 * t_ + srow; key_ = key_ < 0 ? 0 : (key_ > (D_).L - 1 ? (D_).L - 1 : key_); \
        st[t_] = *(const bf16x8*)(ssrc + (unsigned)(((D_).tok0 + (D_).dil * key_) * AW + (D_).hq + sch * 8)); } } while (0)
#define LOADQN(D_) do { const unsigned qo_ = (unsigned)(((D_).tok0 + (D_).dil * ((D_).i0 + 32 * w + r32)) * AW + (D_).hq + hi * 8); \
        _Pragma("unroll") for (int d0 = 0; d0 < 4; ++d0) qr[d0] = *(const bf16x8*)(F.Q + qo_ + d0 * 16); } while (0)
#define SBAR() __builtin_amdgcn_sched_barrier(0)
#define LDK(kc, KF) do { const LAS unsigned char* tk_ = L0 + (w + (kc)) * AT_TILE + hi * AT_KCH + r32 * 16; \
        _Pragma("unroll") for (int d0 = 0; d0 < 4; ++d0) KF[d0] = *(const LAS bf16x8*)(tk_ + 2 * d0 * AT_KCH); } while (0)
#define LDT(kc, A) do { const int k0_ = i0w - 64 + 32 * (kc);     \
        const LAS float* tp_ = tbl + ((k0_ >= 0 && k0_ < D.L) ? (32 + 32 * (kc) + 4 * hi - r32) : 0); \
        _Pragma("unroll") for (int rr = 0; rr < 16; ++rr) A[rr] = tp_[(rr & 3) + 8 * (rr >> 2)]; } while (0)
#define LDVH(kc, h) do { const LAS unsigned char* vb_ = L0 + (w + (kc)) * AT_TILE + vaddr; \
        _Pragma("unroll") for (int pc = 2 * (h); pc < 2 * (h) + 2; ++pc) { vl[pc] = vtr(vb_ + pc * AT_VPC); vh[pc] = vtr(vb_ + pc * AT_VPC + 512); } } while (0)
#define LDV(kc) do { LDVH(kc, 0); LDVH(kc, 1); } while (0)
#define VFR(pc) (bf16x8){vl[pc][0], vl[pc][1], vl[pc][2], vl[pc][3], vh[pc][0], vh[pc][1], vh[pc][2], vh[pc][3]}
#define SMM(KF, A) do { _Pragma("unroll") for (int d0 = 0; d0 < 4; ++d0) A = __builtin_amdgcn_mfma_f32_32x32x16_bf16(KF[d0], qr[d0], A, 0, 0, 0); } while (0)
#define EXPK(A) do { _Pragma("unroll") for (int rr = 0; rr < 16; ++rr) A[rr] = __builtin_amdgcn_exp2f(A[rr]); \
        ls0 += (A[0] + A[1]) + (A[2] + A[3]); ls1 += (A[4] + A[5]) + (A[6] + A[7]); ls2 += (A[8] + A[9]) + (A[10] + A[11]); ls3 += (A[12] + A[13]) + (A[14] + A[15]); \
        pw0.x = cvtpk_s(A[0], A[1]); pw0.y = cvtpk_s(A[2], A[3]); pw0.z = cvtpk_s(A[4], A[5]); pw0.w = cvtpk_s(A[6], A[7]); \
        pw1.x = cvtpk_s(A[8], A[9]); pw1.y = cvtpk_s(A[10], A[11]); pw1.z = cvtpk_s(A[12], A[13]); pw1.w = cvtpk_s(A[14], A[15]); } while (0)
#define PVM() do { \
        o0 = __builtin_amdgcn_mfma_f32_32x32x16_bf16(__builtin_bit_cast(bf16x8, pw0), VFR(0), o0, 0, 0, 0); \
        o0 = __builtin_amdgcn_mfma_f32_32x32x16_bf16(__builtin_bit_cast(bf16x8, pw1), VFR(1), o0, 0, 0, 0); \
        o1 = __builtin_amdgcn_mfma_f32_32x32x16_bf16(__builtin_bit_cast(bf16x8, pw0), VFR(2), o1, 0, 0, 0); \
        o1 = __builtin_amdgcn_mfma_f32_32x32x16_bf16(__builtin_bit_cast(bf16x8, pw1), VFR(3), o1, 0, 0, 0); } while (0)
#define CHUNK1(kc) do { LDVH(kc, 0); SBAR(); SMM(kf, aA); SBAR(); LDVH(kc, 1); if ((kc) < 4) { LDK((kc) + 1, kf); SBAR(); } else { LOADQN(Dn); SBAR(); } EXPK(aA); SBAR(); if ((kc) < 4) { LDT((kc) + 1, aA); SBAR(); } PVM(); SBAR(); } while (0)
#define CHUNKS() do { LDK(0, kf); LDT(0, aA); SBAR(); CHUNK1(0); CHUNK1(1); CHUNK1(2); CHUNK1(3); CHUNK1(4); } while (0)
    TaskD D = unit_decode<FINAL>(F.vcu, u0);
    STAGE_LOAD(D); LOADQN(D);
    if (!FINAL) { for (int idx = F.vcu * NWAVES + w; idx < 8 * 2 * (M / 256); idx += F.G * NWAVES) conv_fixup_item(F, idx, lane); }
    int tb_ch = -1;
    for (int u = u0; u < u1; ++u) {
        const TaskD Dn = unit_decode<FINAL>(F.vcu, u + 1 < u1 ? u + 1 : u);
        AT_BAR();
#pragma unroll
        for (int t_ = 0; t_ < AT_NT; ++t_) *(LAS bf16x8*)(L0 + t_ * AT_TILE + sdst) = st[t_];
        if (tb_ch != D.c * 8 + D.h) { tb_ch = D.c * 8 + D.h; if (tid_l < 192) tbl[tid_l] = F.TBG[tb_ch * 192 + tid_l]; }
        AT_BAR();
        STAGE_LOAD(Dn);
        const int i0w = D.i0 + 32 * w;
        v4u p4[4], p16[4], zg[4]; float l4[4], l16[4];
#define FIN_LOAD(i) do { const int row = (i) * 8 + (lane >> 3), ch = lane & 7; const unsigned tok = (unsigned)(D.tok0 + i0w + row); const unsigned eo = tok * AW + D.hq + ch * 8; \
            p4[i] = *(const v4u*)(F.OP4 + eo); p16[i] = *(const v4u*)(F.OP16 + eo); zg[i] = *(const v4u*)(F.ZG + eo); l4[i] = F.LP4[tok + (7 * (D.tok0 / SEQ) + D.h) * SEQ]; l16[i] = F.LP16[tok + (7 * (D.tok0 / SEQ) + D.h) * SEQ]; } while (0)
        if (false) { FIN_LOAD(0); }
        f32x16 o0 = {}, o1 = {}, aA; float ls0 = 0.f, ls1 = 0.f, ls2 = 0.f, ls3 = 0.f; bf16x8 kf[4]; s16x4 vl[4], vh[4]; v4u pw0, pw1;
        CHUNKS();
        float lsum = (ls0 + ls1) + (ls2 + ls3);
        lsum += __shfl_xor(lsum, 32);
#pragma unroll
        for (int rr = 0; rr < 16; rr += 2) {
            const unsigned a01 = cvtpk_s(o0[rr], o0[rr + 1]), b01 = cvtpk_s(o1[rr], o1[rr + 1]);
            const int q0 = crow(rr, hi), q1 = crow(rr + 1, hi);
            stgb[q0 * 64 + r32] = (unsigned short)(a01 & 0xffffu); stgb[q1 * 64 + r32] = (unsigned short)(a01 >> 16);
            stgb[q0 * 64 + 32 + r32] = (unsigned short)(b01 & 0xffffu); stgb[q1 * 64 + 32 + r32] = (unsigned short)(b01 >> 16);
        }
        if (FINAL) { if (hi == 0) lw[r32] = lsum; FIN_LOAD(0); FIN_LOAD(1); FIN_LOAD(2); FIN_LOAD(3); }
        else { if (hi == 0) { float* lp = F.LP4 + (size_t)(D.c - 1) * (size_t)(256u << 10) + (unsigned)((D.tok0 + D.dil * (i0w + r32)) + (7 * (D.tok0 / SEQ) + D.h) * SEQ); *lp = lsum;     } }
#pragma unroll
        for (int i = 0; i < 4; ++i) {
            const int row = i * 8 + (lane >> 3), ch = lane & 7;
            const unsigned tok = (unsigned)(D.tok0 + D.dil * (i0w + row));
            const v4u ov = *(const LAS v4u*)(stgb + row * 64 + ch * 8);
            if (!FINAL) {
                *(v4u*)(F.OP4 + (size_t)(D.c - 1) * (size_t)(16u << 20) + (tok * AW + D.hq + ch * 8)) = ov;
            } else {
                const float inv = 1.f / (lw[row] + l4[i] + l16[i]);
                float y[8];
#define SZ(x) pg8::silu_f(x)
                y[0] = (bflo(ov.x) + bflo(p4[i].x) + bflo(p16[i].x)) * inv * SZ(bflo(zg[i].x)); y[1] = (bfhi(ov.x) + bfhi(p4[i].x) + bfhi(p16[i].x)) * inv * SZ(bfhi(zg[i].x));
                y[2] = (bflo(ov.y) + bflo(p4[i].y) + bflo(p16[i].y)) * inv * SZ(bflo(zg[i].y)); y[3] = (bfhi(ov.y) + bfhi(p4[i].y) + bfhi(p16[i].y)) * inv * SZ(bfhi(zg[i].y));
                y[4] = (bflo(ov.z) + bflo(p4[i].z) + bflo(p16[i].z)) * inv * SZ(bflo(zg[i].z)); y[5] = (bfhi(ov.z) + bfhi(p4[i].z) + bfhi(p16[i].z)) * inv * SZ(bfhi(zg[i].z));
                y[6] = (bflo(ov.w) + bflo(p4[i].w) + bflo(p16[i].w)) * inv * SZ(bflo(zg[i].w)); y[7] = (bfhi(ov.w) + bfhi(p4[i].w) + bfhi(p16[i].w)) * inv * SZ(bfhi(zg[i].w));
#undef SZ
                v4u wv; wv.x = cvtpk_s(y[0], y[1]); wv.y = cvtpk_s(y[2], y[3]); wv.z = cvtpk_s(y[4], y[5]); wv.w = cvtpk_s(y[6], y[7]);
                *(v4u*)(F.Y + (tok * D_MODEL + 512 + D.hq + ch * 8)) = wv;
            }
        }
        D = Dn;
    }
    AT_BAR();
#undef STAGE_LOAD
#undef LOADQN
#undef SBAR
#undef LDK
#undef LDT
#undef LDV
#undef LDVH
#undef VFR
#undef SMM
#undef EXPK
#undef PVM
#undef CHUNK1
#undef CHUNKS
#undef FIN_LOAD
}
__device__ __forceinline__ void attn_pass_a(Frame& F) {
    attn_units<false>(F);
}
__device__ __forceinline__ void attn_pass_b(Frame& F) {
    attn_units<true>(F);
}

struct Args { const float* in[9]; float* out; unsigned char* ws; int ph_lo, ph_hi; };
__global__ void __launch_bounds__(NWAVES * 64, 2) mega(Args args) {
    extern __shared__ __attribute__((aligned(16))) unsigned char lds[];
    Frame F;
    F.lds = (LAS unsigned char*)lds;
    F.MISC = (volatile LAS unsigned*)(F.lds + MISC_OFF);
    F.wave = __builtin_amdgcn_readfirstlane((int)threadIdx.x >> 6); F.G = gridDim.x; { const int bx = blockIdx.x; F.vcu = (F.G % 8 == 0) ? (bx % 8) * (F.G / 8) + bx / 8 : bx; }
    unsigned char* ws = args.ws;
    F.ctl = (gu32*)(ws + WS_CTL);
    F.x = args.in[0]; F.norm_w = args.in[1]; F.w_in = args.in[2]; F.conv_w = args.in[3]; F.conv_b = args.in[4]; F.qw = args.in[5]; F.kw = args.in[6]; F.rel_bias = args.in[7]; F.w_out = args.in[8];
    F.out = args.out;
    F.WinT = (bf16*)(ws + WS_WIN); F.WoutT = (bf16*)(ws + WS_WOUT); F.XN = (bf16*)(ws + WS_XN);
    F.SBT = (float*)(ws + WS_SBT); F.SBG = (float*)(ws + WS_SBG); F.Q = (bf16*)(ws + WS_Q); F.K = (bf16*)(ws + WS_K); F.V = (bf16*)(ws + WS_V); F.ZG = (bf16*)(ws + WS_ZG);
    F.OP4 = (bf16*)(ws + WS_OP4); F.OP16 = (bf16*)(ws + WS_OP16); F.Y = (bf16*)(ws + WS_Y);
    F.TBG = (float*)(ws + WS_TBG); F.LP4 = (float*)(ws + WS_LP4); F.LP16 = (float*)(ws + WS_LP16);
    for (int u = threadIdx.x; u < (LDS_BYTES - LDSCTL_OFF) / 4; u += NWAVES * 64) ((LAS unsigned*)(F.lds + LDSCTL_OFF))[u] = 0u;
    __syncthreads();
    const int lo = args.ph_lo, hi = args.ph_hi;
    const bool multi = (hi - lo) > 1;
    XcdBarrier bar; bar.bar = (unsigned*)(F.ctl + CW_BAR); bar.x = 0; bar.st = nullptr;
    if (multi) bar = xcd_barrier_post((unsigned*)(F.ctl + CW_BAR), F.MISC + 8);
#define IN(k) (lo <= (k) && (k) < hi)
#define BOTH(k) (IN(k) && IN((k) + 1))
    if (IN(0)) { p0_prologue(F); if (BOTH(0)) xcd_barrier(bar, F.wave); }
    if (IN(1)) {
        pg8::Gemm g{F.XN, F.WinT, M, NPROJ, D_MODEL}; pg8::StaticOrder S; S.init(M, NPROJ, F.G, (int)blockIdx.x);
        { LAS float* cwl = (LAS float*)(F.lds + XL_OFF + 2048);
          const int tl = F.wave * 64 + hw_lane();
          for (int i = tl; i < 2048; i += NWAVES * 64) cwl[i] = i < 1536 ? F.conv_w[i] : F.conv_b[i - 1536];
          if (tl < 128) cwl[2048 + tl] = tl < 64 ? F.qw[tl] : F.kw[tl - 64];
          __syncthreads(); }
        pg8::EpiProj E{F.Y, F.Q, F.SBT, F.SBG, F.lds + XL_OFF};
        pg8::gemm_phase<pg8::EpiProj, pg8::StaticOrder, true, true>(F.lds + RING_OFF, g, S, E, F.wave);
        if (BOTH(1)) xcd_barrier(bar, F.wave);
    }
    if (IN(2)) { attn_pass_a(F); if (BOTH(2)) xcd_barrier(bar, F.wave); }
    if (IN(3)) { attn_pass_b(F); if (BOTH(3)) xcd_barrier(bar, F.wave); }
    if (IN(4)) {
        pg8::Gemm g{F.Y, F.WoutT, M, D_MODEL, D_MODEL}; pg8::StaticOrder S; S.init(M, D_MODEL, F.G, (int)blockIdx.x);
        pg8::EpiRes E{F.x, F.out, D_MODEL};
        pg8::gemm_phase<pg8::EpiRes, pg8::StaticOrder, true, true>(F.lds + RING_OFF, g, S, E, F.wave);
    }
#undef IN
#undef BOTH
}

extern "C" void kernel_launch(void* const* d_in, const int* in_sizes, int n_in, void* d_out, int out_size, void* d_ws, size_t ws_size, hipStream_t stream) {
    static int grid = 0;
    if (grid == 0) {
        if (n_in != 9 || in_sizes[0] != M * D_MODEL || out_size != M * D_MODEL || ws_size < WS_END) { fprintf(stderr, "kernel_launch: unexpected shapes (n_in %d, in0 %d, out %d, ws %zu)\n", n_in, n_in > 0 ? in_sizes[0] : -1, out_size, ws_size); grid = -1; return; }
        int dev = 0, cus = 0, per_cu = 0;
        if (hipGetDevice(&dev) != hipSuccess || hipDeviceGetAttribute(&cus, hipDeviceAttributeMultiprocessorCount, dev) != hipSuccess) { grid = -1; return; }
        if (hipFuncSetAttribute((const void*)mega, hipFuncAttributeMaxDynamicSharedMemorySize, LDS_BYTES) != hipSuccess) { fprintf(stderr, "kernel_launch: hipFuncSetAttribute failed\n"); grid = -1; return; }
        if (hipOccupancyMaxActiveBlocksPerMultiprocessor(&per_cu, (const void*)mega, NWAVES * 64, LDS_BYTES) != hipSuccess || per_cu < 1) { fprintf(stderr, "kernel_launch: occupancy query says %d blocks per CU\n", per_cu); (void)hipGetLastError(); grid = -1; return; }
        grid = cus;
        if (grid != 256) { fprintf(stderr, "kernel_launch: built for a 256-CU device (got %d CUs)\n", cus); grid = -1; return; }
    }
    if (grid < 0) return;
    (void)hipMemsetAsync((char*)d_ws + WS_CTL, 0, CTL_ZERO_BYTES, stream);
    Args a{};
    for (int i = 0; i < 9; ++i) a.in[i] = (const float*)d_in[i];
    a.out = (float*)d_out; a.ws = (unsigned char*)d_ws;
    unsigned char* ws = (unsigned char*)d_ws;
#if STAGE == 4
    a.ph_lo = 0; a.ph_hi = 5;
    hipLaunchKernelGGL(mega, dim3(grid), dim3(NWAVES * 64), LDS_BYTES, stream, a);
    if (PROBE_PHASE >= 0) { a.ph_lo = PROBE_PHASE; a.ph_hi = PROBE_PHASE + 1; hipLaunchKernelGGL(mega, dim3(grid), dim3(NWAVES * 64), LDS_BYTES, stream, a); }
#else
    const int nper = 5;
    for (int p = 0; p < nper; ++p) { a.ph_lo = p; a.ph_hi = p + 1; hipLaunchKernelGGL(mega, dim3(grid), dim3(NWAVES * 64), LDS_BYTES, stream, a); }
#endif
}
```

```cpp
#include <hip/hip_runtime.h>
#include <cstdio>
#include <cstdint>

#ifndef PROBE_PHASE
#define PROBE_PHASE -1
#endif
#ifndef STAGE
#define STAGE 4
#endif

__device__ __forceinline__ int hw_lane() { return (int)__builtin_amdgcn_mbcnt_hi(~0u, __builtin_amdgcn_mbcnt_lo(~0u, 0u)); }

namespace pg8 {
#define PG8_LAS __attribute__((address_space(3)))
typedef unsigned short bf16_t;
typedef short bf16x8 __attribute__((ext_vector_type(8)));
typedef float f32x4 __attribute__((ext_vector_type(4)));
typedef unsigned u32x4 __attribute__((ext_vector_type(4)));
typedef unsigned u32x2 __attribute__((ext_vector_type(2)));
constexpr int BM = 256, BK = 64, HALF = 128, HTB = HALF * BK * 2, STAGE_BYTES = 8 * HTB, NXCD = 8, WGM = 8;

__host__ __device__ __forceinline__ int lds_byte(int r, int c) { const int st = (r >> 4) * 2 + (c >> 5), rr = r & 15, cc = c & 31, ob = rr * 64 + cc * 2; return st * 1024 + (ob ^ (((ob >> 9) & 1) << 5)); }
__host__ __device__ __forceinline__ void stage_rc(int b, int& R, int& C) { const int st = b / 1024, sb = b % 1024, swz = sb ^ (((sb >> 9) & 1) << 5); R = (st >> 1) * 16 + swz / 64; C = (st & 1) * 32 + (swz % 64) / 2; }

struct Unit { int pm, pn; };
struct Gemm { const bf16_t* A; const bf16_t* Bt; int M, N, K; };

struct StaticOrder {
    int nM, nN, nwg, G, c;
    __host__ __device__ void init(int M, int N, int G_, int c_) { nM = M / BM; nN = N / BM; nwg = nM * nN; G = G_; c = c_; }
    __host__ __device__ bool next(int i, Unit& u) const {
        const long L = (long)i * G + c; if (L >= nwg) return false;
        int wgid = (int)L; { const int q = nwg / NXCD, r = nwg % NXCD, xcd = wgid % NXCD, off = wgid / NXCD; wgid = (xcd < r ? xcd * (q + 1) : r * (q + 1) + (xcd - r) * q) + off; }
        const int nig = WGM * nN, gid = wgid / nig, fm = gid * WGM, gsz = (nM - fm) < WGM ? (nM - fm) : WGM;
        u.pm = fm + ((wgid % nig) % gsz); u.pn = (wgid % nig) / gsz; return true;
    }
};

__device__ __forceinline__ unsigned cvt_pk_bf16(float lo, float hi) { unsigned r; asm volatile("v_cvt_pk_bf16_f32 %0, %1, %2" : "=v"(r) : "v"(lo), "v"(hi)); return r; }
__device__ __forceinline__ float silu_f(float z) { return z * __builtin_amdgcn_rcpf(1.f + __builtin_amdgcn_exp2f(-1.4426950408889634f * z)); }

struct EpiProj {
    static constexpr bool PERM = false, AFTER_DRAIN = false, XPRE = false;
    bf16_t *Y, *QKVZ; float *SBT, *SBG; PG8_LAS unsigned char* xl;
    __device__ __forceinline__ void operator()(const f32x4 (&acc)[2][2][4][2], const Unit& u, int wr, int wc, int fr, int fq) const {
        const int row0 = u.pm * BM + wr * 64 + fr;
        if (u.pn < 8) {
            const int lane = fr + 16 * fq, chl = 16 * wc + 4 * fq, ch0 = 64 * u.pn + chl;
            PG8_LAS float* X = (PG8_LAS float*)xl;
            const PG8_LAS float* CWl = (const PG8_LAS float*)(xl + 2048);
            f32x4 t[2][4], g[2][4];
#pragma unroll
            for (int ai = 0; ai < 2; ++ai)
#pragma unroll
                for (int m = 0; m < 4; ++m) {
                    const f32x4 uu = acc[ai][0][m][0], gb = acc[ai][0][m][1], gc = acc[ai][1][m][0], z = acc[ai][1][m][1];
                    t[ai][m] = gc * uu;
#pragma unroll
                    for (int i = 0; i < 4; ++i) g[ai][m][i] = gb[i] * silu_f(z[i]);
                }
#pragma unroll
            for (int ai = 0; ai < 2; ++ai) { const int grpi = 2 * ai + wr;
                if (fr == 0) *(PG8_LAS f32x4*)(X + (grpi * 2 + 0) * 64 + chl) = t[ai][0];
                if (fr == 15) *(PG8_LAS f32x4*)(X + (grpi * 2 + 1) * 64 + chl) = t[ai][3]; }
            if (wr == 0 && fr < 2) { *(f32x4*)(SBT + ((size_t)(u.pm * 4 + fr) * 512 + ch0)) = t[0][0]; if (fr == 0) *(f32x4*)(SBG + ((size_t)(u.pm * 2 + 0) * 512 + ch0)) = g[0][0]; }
            if (wr == 1 && fr >= 14) { *(f32x4*)(SBT + ((size_t)(u.pm * 4 + fr - 12) * 512 + ch0)) = t[1][3]; if (fr == 15) *(f32x4*)(SBG + ((size_t)(u.pm * 2 + 1) * 512 + ch0)) = g[1][3]; }
            asm volatile("s_waitcnt lgkmcnt(0)" ::: "memory"); __builtin_amdgcn_s_barrier(); asm volatile("" ::: "memory");
            const f32x4 w0 = *(const PG8_LAS f32x4*)(CWl + ch0), w1 = *(const PG8_LAS f32x4*)(CWl + 512 + ch0), w2 = *(const PG8_LAS f32x4*)(CWl + 1024 + ch0), cb = *(const PG8_LAS f32x4*)(CWl + 1536 + ch0);
#pragma unroll
            for (int ai = 0; ai < 2; ++ai) { const int grpi = 2 * ai + wr;
                const f32x4 xprev = *(const PG8_LAS f32x4*)(X + (((grpi + 3) & 3) * 2 + 1) * 64 + chl), xnext = *(const PG8_LAS f32x4*)(X + (((grpi + 1) & 3) * 2 + 0) * 64 + chl);
#pragma unroll
                for (int m = 0; m < 4; ++m) {
                    const f32x4 ps = m > 0 ? t[ai][m - 1] : xprev, ns = m < 3 ? t[ai][m + 1] : xnext, tc = t[ai][m];
                    f32x4 tp, tn;
#pragma unroll
                    for (int i = 0; i < 4; ++i) {
                        tp[i] = __builtin_bit_cast(float, __builtin_amdgcn_update_dpp(0, __builtin_bit_cast(int, fr == 15 ? ps[i] : tc[i]), 0x121, 0xf, 0xf, false));
                        tn[i] = __builtin_bit_cast(float, __builtin_amdgcn_update_dpp(0, __builtin_bit_cast(int, fr == 0 ? ns[i] : tc[i]), 0x12F, 0xf, 0xf, false)); }
                    const f32x4 y = g[ai][m] * (w0 * tp + w1 * tc + w2 * tn + cb);
                    const int rt = 128 * ai + 64 * wr + 16 * m + fr;
                    u32x2 yw; yw.x = cvt_pk_bf16(y[0], y[1]); yw.y = cvt_pk_bf16(y[2], y[3]);
                    if (rt != 0 && rt != 255) *(u32x2*)(Y + (size_t)(u.pm * BM + rt) * 1024 + ch0) = yw;
                }
            }
        } else {
            const int grp = (u.pn - 8) >> 1, head = 4 * ((u.pn - 8) & 1) + wc;
            bf16_t* dst = QKVZ + (size_t)grp * (size_t)(16u << 20);
            const int col0 = head * 64 + 8 * fq;
            f32x4 wv[2][2];
            if (grp < 2) { const PG8_LAS float* w = (const PG8_LAS float*)(xl + 10240) + 64 * grp;
#pragma unroll
                for (int bj = 0; bj < 2; ++bj)
#pragma unroll
                    for (int n = 0; n < 2; ++n) wv[bj][n] = *(const PG8_LAS f32x4*)(w + 32 * bj + 8 * fq + 4 * n); }
            const float sc = grp == 0 ? 0.125f * 1.4426950408889634f : 1.f;
#pragma unroll
            for (int ai = 0; ai < 2; ++ai)
#pragma unroll
                for (int m = 0; m < 4; ++m) {
                    f32x4 v[2][2];
#pragma unroll
                    for (int bj = 0; bj < 2; ++bj)
#pragma unroll
                        for (int n = 0; n < 2; ++n) v[bj][n] = acc[ai][bj][m][n];
                    if (grp < 2) {
                        float ss = 0.f;
#pragma unroll
                        for (int bj = 0; bj < 2; ++bj)
#pragma unroll
                            for (int n = 0; n < 2; ++n) ss += (v[bj][n][0] * v[bj][n][0] + v[bj][n][1] * v[bj][n][1]) + (v[bj][n][2] * v[bj][n][2] + v[bj][n][3] * v[bj][n][3]);
                        ss += __shfl_xor(ss, 16); ss += __shfl_xor(ss, 32);
                        const float rs = __builtin_amdgcn_rsqf(ss * (1.f / 64.f) + 1e-6f) * sc;
#pragma unroll
                        for (int bj = 0; bj < 2; ++bj)
#pragma unroll
                            for (int n = 0; n < 2; ++n) v[bj][n] = v[bj][n] * rs * wv[bj][n];
                    }
                    bf16_t* rowp = dst + (size_t)(row0 + ai * HALF + m * 16) * 512 + col0;
#pragma unroll
                    for (int bj = 0; bj < 2; ++bj) { u32x4 w; w.x = cvt_pk_bf16(v[bj][0][0], v[bj][0][1]); w.y = cvt_pk_bf16(v[bj][0][2], v[bj][0][3]); w.z = cvt_pk_bf16(v[bj][1][0], v[bj][1][1]); w.w = cvt_pk_bf16(v[bj][1][2], v[bj][1][3]);
                        *(u32x4*)(rowp + 32 * bj) = w; }
                }
        }
    }
};
struct EpiRes {
    static constexpr bool PERM = false, AFTER_DRAIN = false, XPRE = true;
    const float* X; float* O; int ldc;
    __device__ __forceinline__ void xissue(const Unit& u, int it, int wr, int wc, int fr, int fq, f32x4 (&xv)[4]) const {
        const int ai = it >> 2, bj = (it >> 1) & 1, m0 = 2 * (it & 1);
        const float* ba = X + ((size_t)(u.pm * BM + ai * HALF + m0 * 16) * ldc + u.pn * BM + bj * HALF);
        const float* bb = ba + (size_t)16 * ldc;
        const unsigned voff = (unsigned)(((wr * 64 + fr) * ldc + wc * 32 + 4 * fq) * 4);
        asm volatile("global_load_dwordx4 %0, %4, %5\n\tglobal_load_dwordx4 %1, %4, %5 offset:64\n\tglobal_load_dwordx4 %2, %4, %6\n\tglobal_load_dwordx4 %3, %4, %6 offset:64"
                     : "=&v"(xv[0]), "=&v"(xv[1]), "=&v"(xv[2]), "=&v"(xv[3]) : "v"(voff), "s"(ba), "s"(bb) : "memory");
    }
    __device__ __forceinline__ void xadd(f32x4 (&acc)[2][2][4][2], int it, f32x4 (&xv)[4]) const {
        asm volatile("" : "+v"(xv[0]), "+v"(xv[1]), "+v"(xv[2]), "+v"(xv[3]));
#define XA(AI, BJ, M0) do { acc[AI][BJ][M0][0] += xv[0]; acc[AI][BJ][M0][1] += xv[1]; acc[AI][BJ][M0 + 1][0] += xv[2]; acc[AI][BJ][M0 + 1][1] += xv[3]; } while (0)
        switch (it) { case 0: XA(0, 0, 0); break; case 1: XA(0, 0, 2); break; case 2: XA(0, 1, 0); break; case 3: XA(0, 1, 2); break;
                      case 4: XA(1, 0, 0); break; case 5: XA(1, 0, 2); break; case 6: XA(1, 1, 0); break; default: XA(1, 1, 2); break; }
#undef XA
    }
    __device__ __forceinline__ void operator()(const f32x4 (&acc)[2][2][4][2], const Unit& u, int wr, int wc, int fr, int fq) const {
        const int row0 = u.pm * BM + wr * 64 + fr, col0 = u.pn * BM + wc * 32 + 4 * fq;
#pragma unroll
        for (int ai = 0; ai < 2; ++ai)
#pragma unroll
            for (int m = 0; m < 4; ++m) { const size_t off = (size_t)(row0 + ai * HALF + m * 16) * ldc + col0;
#pragma unroll
                for (int bj = 0; bj < 2; ++bj)
#pragma unroll
                    for (int n = 0; n < 2; ++n) *(f32x4*)(O + off + bj * HALF + n * 16) = acc[ai][bj][m][n]; }
    }
};

template <class Epi, class Sched, bool ALIGN_EPI = false, bool SP2 = false>
__device__ __forceinline__ void gemm_phase(PG8_LAS unsigned char* lds, const Gemm g, const Sched& S, const Epi& E, const int widx) {
    const int lane = hw_lane(), wid = widx, tid = wid * 64 + lane, wr = wid >> 2, wc = wid & 3, fr = lane & 15, fq = lane >> 4;
    const int K = g.K, nt = K / BK;
    unsigned voffA[2], voffB[2];
#pragma unroll
    for (int i = 0; i < 2; ++i) { int R, C; stage_rc(tid * 16 + i * 8192, R, C);
        voffA[i] = (unsigned)(R * K + C) * 2u; voffB[i] = (unsigned)(R * K + C) * 2u; }
    const size_t kstep = (size_t)(BK * 2);
    const size_t hstep = (size_t)HALF * K * 2;
    const size_t tstep = 2 * hstep;
    const unsigned ldsw = (unsigned)wid * 1024u;
    const int aoff = lds_byte(wr * 64 + fr, fq * 8), boff = lds_byte(wc * 32 + fr, fq * 8);
#define PG8_SA(b, h) (((b) * 2 + (h)) * HTB)
#define PG8_SB(b, h) ((4 + (b) * 2 + (h)) * HTB)
#define PG8_STAGE(bufoff, gbase, voff) do { _Pragma("unroll") for (int _i = 0; _i < 2; ++_i) \
        __builtin_amdgcn_global_load_lds((const unsigned*)((const char*)(gbase) + (voff)[_i]), (PG8_LAS unsigned*)(lds + (bufoff) + ldsw + _i * 8192), 16, 0, 0); } while (0)
#define PG8_LDA(dst, b, h) do { _Pragma("unroll") for (int m = 0; m < 4; ++m) _Pragma("unroll") for (int k = 0; k < 2; ++k) dst[m][k] = *(const PG8_LAS bf16x8*)(lds + PG8_SA(b, h) + aoff + m * 2048 + k * 1024); } while (0)
#define PG8_LDB(dst, b, h) do { _Pragma("unroll") for (int n = 0; n < 2; ++n) _Pragma("unroll") for (int k = 0; k < 2; ++k) dst[n][k] = *(const PG8_LAS bf16x8*)(lds + PG8_SB(b, h) + boff + n * 2048 + k * 1024); } while (0)
#define PG8_MMA(ai, bj, At, Bt) do { __builtin_amdgcn_s_setprio(1); _Pragma("unroll") for (int m = 0; m < 4; ++m) _Pragma("unroll") for (int n = 0; n < 2; ++n) _Pragma("unroll") for (int k = 0; k < 2; ++k) \
        acc[ai][bj][m][n] = __builtin_amdgcn_mfma_f32_16x16x32_bf16(Bt[n][k], At[m][k], acc[ai][bj][m][n], 0, 0, 0); __builtin_amdgcn_s_setprio(0); } while (0)
#define PG8_WAIT_V(n) asm volatile("s_waitcnt vmcnt(" #n ")" ::: "memory")
#define PG8_WAIT_L(n) asm volatile("s_waitcnt lgkmcnt(" #n ")" ::: "memory")
#define PG8_BAR __builtin_amdgcn_s_barrier()
#define PG8_SCHED __builtin_amdgcn_sched_barrier(0)
    Unit cur, nxt; int ui = 0;
    if (!S.next(0, cur)) return;
    f32x4 acc[2][2][4][2];
#pragma unroll
    for (int a = 0; a < 2; ++a)
#pragma unroll
        for (int b = 0; b < 2; ++b)
#pragma unroll
            for (int m = 0; m < 4; ++m)
#pragma unroll
                for (int n = 0; n < 2; ++n) acc[a][b][m][n] = (f32x4){0.f, 0.f, 0.f, 0.f};
    bf16x8 At[4][2], B0[2][2], B1[2][2]; f32x4 xv[4];
    const char* cA = (const char*)g.A + (size_t)cur.pm * tstep; const char* cB = (const char*)g.Bt + (size_t)cur.pn * tstep;
    if constexpr (SP2) {
        PG8_STAGE(PG8_SB(0, 0), cB, voffB); PG8_STAGE(PG8_SB(0, 1), cB + hstep, voffB); PG8_STAGE(PG8_SA(0, 0), cA, voffA); PG8_STAGE(PG8_SA(0, 1), cA + hstep, voffA);
        if (wr == 1) PG8_BAR;
        PG8_WAIT_V(2); PG8_BAR;
        PG8_STAGE(PG8_SB(1, 0), cB + kstep, voffB); PG8_STAGE(PG8_SA(1, 0), cA + kstep, voffA); PG8_STAGE(PG8_SB(1, 1), cB + hstep + kstep, voffB);
        PG8_WAIT_V(6); PG8_BAR;
    } else {
        PG8_STAGE(PG8_SB(0, 0), cB, voffB); PG8_STAGE(PG8_SA(0, 0), cA, voffA); PG8_STAGE(PG8_SB(0, 1), cB + hstep, voffB); PG8_STAGE(PG8_SA(0, 1), cA + hstep, voffA);
        if (wr == 1) PG8_BAR;
        PG8_WAIT_V(4); PG8_BAR;
        PG8_STAGE(PG8_SB(1, 0), cB + kstep, voffB); PG8_STAGE(PG8_SA(1, 0), cA + kstep, voffA); PG8_STAGE(PG8_SB(1, 1), cB + hstep + kstep, voffB);
        PG8_WAIT_V(6); PG8_BAR;
    }
    for (;;) {
        const bool has_next = S.next(ui + 1, nxt);
        const char* nA = has_next ? (const char*)g.A + (size_t)nxt.pm * tstep : cA; const char* nB = has_next ? (const char*)g.Bt + (size_t)nxt.pn * tstep : cB;
        if constexpr (Epi::XPRE) {
#pragma unroll
        for (int t = 0; t < 16; t += 2) {
            const bool last = (t == nt - 2);
            const char* a1 = cA + (size_t)(t + 1) * kstep;
            const char* a2 = last ? nA : cA + (size_t)(t + 2) * kstep; const char* b2 = last ? nB : cB + (size_t)(t + 2) * kstep;
            const char* a3 = a2 + kstep; const char* b3 = b2 + kstep;
            if constexpr (SP2) {
            if constexpr (Epi::XPRE) E.xissue(cur, t >> 1, wr, wc, fr, fq, xv);
            PG8_LDB(B0, 0, 0); PG8_LDB(B1, 0, 1); PG8_SCHED; PG8_LDA(At, 0, 0); PG8_STAGE(PG8_SA(1, 1), a1 + hstep, voffA);
            if constexpr (Epi::XPRE) PG8_WAIT_V(12); else PG8_WAIT_V(8);
            PG8_WAIT_L(0); PG8_BAR; PG8_MMA(0, 0, At, B0); PG8_MMA(0, 1, At, B1); PG8_BAR; PG8_SCHED;
            PG8_LDA(At, 0, 1); PG8_STAGE(PG8_SB(0, 0), b2, voffB); PG8_STAGE(PG8_SB(0, 1), b2 + hstep, voffB); PG8_STAGE(PG8_SA(0, 0), a2, voffA);
            if constexpr (Epi::XPRE) PG8_WAIT_V(12); else PG8_WAIT_V(8);
            PG8_WAIT_L(0); PG8_BAR; PG8_MMA(1, 0, At, B0); PG8_MMA(1, 1, At, B1); PG8_BAR; PG8_SCHED;
            PG8_LDB(B0, 1, 0); PG8_LDB(B1, 1, 1); PG8_SCHED; PG8_LDA(At, 1, 0); PG8_STAGE(PG8_SA(0, 1), a2 + hstep, voffA);
            PG8_WAIT_V(8); PG8_WAIT_L(0); PG8_BAR;
            if constexpr (Epi::XPRE) E.xadd(acc, t >> 1, xv);
            PG8_MMA(0, 0, At, B0); PG8_MMA(0, 1, At, B1); PG8_BAR; PG8_SCHED;
            PG8_LDA(At, 1, 1); PG8_STAGE(PG8_SB(1, 0), b3, voffB); PG8_STAGE(PG8_SB(1, 1), b3 + hstep, voffB); PG8_STAGE(PG8_SA(1, 0), a3, voffA);
            PG8_WAIT_V(8); PG8_WAIT_L(0); PG8_BAR; PG8_MMA(1, 0, At, B0); PG8_MMA(1, 1, At, B1); PG8_BAR; PG8_SCHED;
            } else {
            PG8_LDB(B0, 0, 0); PG8_SCHED; PG8_LDA(At, 0, 0); PG8_STAGE(PG8_SA(1, 1), a1 + hstep, voffA);
            PG8_WAIT_L(8); PG8_BAR; PG8_WAIT_L(0); PG8_MMA(0, 0, At, B0); PG8_BAR; PG8_SCHED;
            PG8_LDB(B1, 0, 1); PG8_STAGE(PG8_SB(0, 0), b2, voffB);
            PG8_BAR; PG8_WAIT_L(0); PG8_MMA(0, 1, At, B1); PG8_BAR;
            PG8_LDA(At, 0, 1); PG8_STAGE(PG8_SA(0, 0), a2, voffA);
            PG8_BAR; PG8_WAIT_L(0); PG8_MMA(1, 0, At, B0); PG8_BAR; PG8_SCHED;
            PG8_STAGE(PG8_SB(0, 1), b2 + hstep, voffB);
            PG8_WAIT_V(6); PG8_BAR; PG8_MMA(1, 1, At, B1); PG8_BAR;
            PG8_LDB(B0, 1, 0); PG8_SCHED; PG8_LDA(At, 1, 0); PG8_STAGE(PG8_SA(0, 1), a2 + hstep, voffA);
            PG8_WAIT_L(8); PG8_BAR; PG8_WAIT_L(0); PG8_MMA(0, 0, At, B0); PG8_BAR; PG8_SCHED;
            PG8_LDB(B1, 1, 1); PG8_STAGE(PG8_SB(1, 0), b3, voffB);
            PG8_BAR; PG8_WAIT_L(0); PG8_MMA(0, 1, At, B1); PG8_BAR;
            PG8_LDA(At, 1, 1); PG8_STAGE(PG8_SA(1, 0), a3, voffA);
            PG8_BAR; PG8_WAIT_L(0); PG8_MMA(1, 0, At, B0); PG8_BAR; PG8_SCHED;
            PG8_STAGE(PG8_SB(1, 1), b3 + hstep, voffB);
            PG8_WAIT_V(6); PG8_BAR; PG8_MMA(1, 1, At, B1); PG8_BAR;
            }
                }
        } else {
        for (int t = 0; t < nt; t += 2) {
            const bool last = (t == nt - 2);
            const char* a1 = cA + (size_t)(t + 1) * kstep;
            const char* a2 = last ? nA : cA + (size_t)(t + 2) * kstep; const char* b2 = last ? nB : cB + (size_t)(t + 2) * kstep;
            const char* a3 = a2 + kstep; const char* b3 = b2 + kstep;
            if constexpr (SP2) {
            if constexpr (Epi::XPRE) E.xissue(cur, t >> 1, wr, wc, fr, fq, xv);
            PG8_LDB(B0, 0, 0); PG8_LDB(B1, 0, 1); PG8_SCHED; PG8_LDA(At, 0, 0); PG8_STAGE(PG8_SA(1, 1), a1 + hstep, voffA);
            if constexpr (Epi::XPRE) PG8_WAIT_V(12); else PG8_WAIT_V(8);
            PG8_WAIT_L(0); PG8_BAR; PG8_MMA(0, 0, At, B0); PG8_MMA(0, 1, At, B1); PG8_BAR; PG8_SCHED;
            PG8_LDA(At, 0, 1); PG8_STAGE(PG8_SB(0, 0), b2, voffB); PG8_STAGE(PG8_SB(0, 1), b2 + hstep, voffB); PG8_STAGE(PG8_SA(0, 0), a2, voffA);
            if constexpr (Epi::XPRE) PG8_WAIT_V(12); else PG8_WAIT_V(8);
            PG8_WAIT_L(0); PG8_BAR; PG8_MMA(1, 0, At, B0); PG8_MMA(1, 1, At, B1); PG8_BAR; PG8_SCHED;
            PG8_LDB(B0, 1, 0); PG8_LDB(B1, 1, 1); PG8_SCHED; PG8_LDA(At, 1, 0); PG8_STAGE(PG8_SA(0, 1), a2 + hstep, voffA);
            PG8_WAIT_V(8); PG8_WAIT_L(0); PG8_BAR;
            if constexpr (Epi::XPRE) E.xadd(acc, t >> 1, xv);
            PG8_MMA(0, 0, At, B0); PG8_MMA(0, 1, At, B1); PG8_BAR; PG8_SCHED;
            PG8_LDA(At, 1, 1); PG8_STAGE(PG8_SB(1, 0), b3, voffB); PG8_STAGE(PG8_SB(1, 1), b3 + hstep, voffB); PG8_STAGE(PG8_SA(1, 0), a3, voffA);
            PG8_WAIT_V(8); PG8_WAIT_L(0); PG8_BAR; PG8_MMA(1, 0, At, B0); PG8_MMA(1, 1, At, B1); PG8_BAR; PG8_SCHED;
            } else {
            PG8_LDB(B0, 0, 0); PG8_SCHED; PG8_LDA(At, 0, 0); PG8_STAGE(PG8_SA(1, 1), a1 + hstep, voffA);
            PG8_WAIT_L(8); PG8_BAR; PG8_WAIT_L(0); PG8_MMA(0, 0, At, B0); PG8_BAR; PG8_SCHED;
            PG8_LDB(B1, 0, 1); PG8_STAGE(PG8_SB(0, 0), b2, voffB);
            PG8_BAR; PG8_WAIT_L(0); PG8_MMA(0, 1, At, B1); PG8_BAR;
            PG8_LDA(At, 0, 1); PG8_STAGE(PG8_SA(0, 0), a2, voffA);
            PG8_BAR; PG8_WAIT_L(0); PG8_MMA(1, 0, At, B0); PG8_BAR; PG8_SCHED;
            PG8_STAGE(PG8_SB(0, 1), b2 + hstep, voffB);
            PG8_WAIT_V(6); PG8_BAR; PG8_MMA(1, 1, At, B1); PG8_BAR;
            PG8_LDB(B0, 1, 0); PG8_SCHED; PG8_LDA(At, 1, 0); PG8_STAGE(PG8_SA(0, 1), a2 + hstep, voffA);
            PG8_WAIT_L(8); PG8_BAR; PG8_WAIT_L(0); PG8_MMA(0, 0, At, B0); PG8_BAR; PG8_SCHED;
            PG8_LDB(B1, 1, 1); PG8_STAGE(PG8_SB(1, 0), b3, voffB);
            PG8_BAR; PG8_WAIT_L(0); PG8_MMA(0, 1, At, B1); PG8_BAR;
            PG8_LDA(At, 1, 1); PG8_STAGE(PG8_SA(1, 0), a3, voffA);
            PG8_BAR; PG8_WAIT_L(0); PG8_MMA(1, 0, At, B0); PG8_BAR; PG8_SCHED;
            PG8_STAGE(PG8_SB(1, 1), b3 + hstep, voffB);
            PG8_WAIT_V(6); PG8_BAR; PG8_MMA(1, 1, At, B1); PG8_BAR;
            }
                }
        }
        if constexpr (ALIGN_EPI) { if (wr == 0) PG8_BAR; }
        E(acc, cur, wr, wc, fr, fq);
        if (!has_next) break;
#pragma unroll
        for (int a = 0; a < 2; ++a)
#pragma unroll
            for (int b = 0; b < 2; ++b)
#pragma unroll
                for (int m = 0; m < 4; ++m)
#pragma unroll
                    for (int n = 0; n < 2; ++n) acc[a][b][m][n] = (f32x4){0.f, 0.f, 0.f, 0.f};
        cur = nxt; cA = nA; cB = nB; ++ui;
        if constexpr (ALIGN_EPI) { if (wr == 1) PG8_BAR; }
    }
    PG8_WAIT_V(0);
    if constexpr (!ALIGN_EPI) { if (wr == 0) PG8_BAR; }
    PG8_BAR;
#undef PG8_SA
#undef PG8_SB
#undef PG8_STAGE
#undef PG8_LDA
#undef PG8_LDB
#undef PG8_MMA
#undef PG8_WAIT_V
#undef PG8_WAIT_L
#undef PG8_BAR
#undef PG8_SCHED
}
}

constexpr int D_MODEL = 1024, BATCH = 2, SEQ = 16384, M = BATCH * SEQ, NPROJ = 4096, AW = 512, NHEAD = 8;
constexpr int NWAVES = 8;
constexpr size_t MiB = 1u << 20;
constexpr size_t WS_CTL = 0, CTL_ZERO_BYTES = 32768;
#ifndef WS_SHIFT_MIB
#define WS_SHIFT_MIB 0
#endif
constexpr size_t WS_SH = (size_t)WS_SHIFT_MIB * MiB;
constexpr size_t WS_TBG = WS_SH + 1 * MiB;
constexpr size_t WS_WIN = WS_SH + 2 * MiB;
constexpr size_t WS_WOUT = WS_SH + 10 * MiB;
constexpr size_t WS_LP4 = WS_SH + 12 * MiB, WS_LP16 = WS_SH + 13 * MiB;
constexpr size_t WS_SBT = WS_SH + 14 * MiB, WS_SBG = WS_SH + 15 * MiB;
constexpr size_t WS_XN = WS_SH + 16 * MiB;
constexpr size_t WS_Q = WS_SH + 80 * MiB, WS_K = WS_SH + 112 * MiB, WS_V = WS_SH + 144 * MiB, WS_ZG = WS_SH + 176 * MiB;
constexpr size_t WS_OP4 = WS_XN, WS_OP16 = WS_XN + 32 * MiB;
constexpr size_t WS_Y = WS_SH + 208 * MiB;
constexpr size_t WS_END = WS_SH + 272 * MiB;
constexpr int CW_BAR = 4096;

constexpr int RING_OFF = 0, RING_BYTES = 131072;
constexpr int LDSCTL_OFF = 146432, MISC_OFF = LDSCTL_OFF + 320;
constexpr int LDS_BYTES = 147456;
constexpr int XL_OFF = 131072;
static_assert(XL_OFF + 10752 <= LDSCTL_OFF, "LDS map");

#define GAS __attribute__((address_space(1)))
#define LAS __attribute__((address_space(3)))
typedef unsigned short bf16;
typedef unsigned v4u __attribute__((ext_vector_type(4)));
typedef float f32x4 __attribute__((ext_vector_type(4)));
typedef float f32x16 __attribute__((ext_vector_type(16)));
typedef short bf16x8 __attribute__((ext_vector_type(8)));
typedef short s16x4 __attribute__((ext_vector_type(4)));
typedef GAS unsigned gu32;
#define RLX_AGENT __ATOMIC_RELAXED, __HIP_MEMORY_SCOPE_AGENT
#define LDS_WAIT() asm volatile("s_waitcnt lgkmcnt(0)" ::: "memory")
__device__ __forceinline__ unsigned f2bf(float f) { unsigned u = __builtin_bit_cast(unsigned, f); return (u + 0x7fffu + ((u >> 16) & 1u)) >> 16; }
__device__ __forceinline__ unsigned pk2(float lo, float hi) { return f2bf(lo) | (f2bf(hi) << 16); }
__device__ __forceinline__ float bf2f(unsigned short b) { return __builtin_bit_cast(float, (unsigned)b << 16); }
__device__ __forceinline__ float bflo(unsigned w) { return __builtin_bit_cast(float, w << 16); }
__device__ __forceinline__ float bfhi(unsigned w) { return __builtin_bit_cast(float, w & 0xffff0000u); }

#define XB_TMO      128
#define XB_XCNT(j)  (256  + 64 * (j))
#define XB_XSUB(j)  (1280 + 64 * (j))
#define XB_XGEN(j)  (2304 + 64 * (j))
#define XB_TOP      3328
#define XB_TOPGEN   3392
#define XCD_BAR_WORDS 3456
#define XB_SPIN_CAP (1u << 18)
__device__ __forceinline__ unsigned xb_ld(unsigned* p)              { return __hip_atomic_load(p, __ATOMIC_RELAXED, __HIP_MEMORY_SCOPE_AGENT); }
__device__ __forceinline__ unsigned xb_add(unsigned* p, unsigned v) { return __hip_atomic_fetch_add(p, v, __ATOMIC_RELAXED, __HIP_MEMORY_SCOPE_AGENT); }
__device__ __forceinline__ unsigned xb_xcc_id() { return (unsigned)__builtin_amdgcn_s_getreg((3 << 11) | 20) & 0xFu; }
#define XB_SPIN(cond, bar) do { unsigned _sp = 0; while (cond) { __builtin_amdgcn_s_sleep(1); \
    if ((++_sp & 255u) == 0u) { if (xb_ld(&(bar)[XB_TMO])) break; if (_sp > XB_SPIN_CAP) { atomicAdd(&(bar)[XB_TMO], 1u); break; } } } } while (0)
struct XcdBarrier { unsigned* bar; unsigned x; volatile LAS unsigned* st; };
__device__ __forceinline__ XcdBarrier xcd_barrier_post(unsigned* bar, volatile LAS unsigned* st) {
    XcdBarrier b; b.bar = bar; b.x = xb_xcc_id(); b.st = st;
    if (threadIdx.x == 0) (void)xb_add(&bar[XB_XCNT(b.x)], 1u);
    return b;
}
__device__ __forceinline__ void xcd_barrier_complete(unsigned* bar, unsigned x, unsigned& nloc, unsigned& nx) {
    const unsigned G = gridDim.x * gridDim.y * gridDim.z;
    unsigned sum, cnt, mine, sp = 0u;
    for (;;) {
        sum = 0u; cnt = 0u; mine = 0u;
#pragma unroll
        for (unsigned j = 0; j < 16; ++j) { const unsigned c = xb_ld(&bar[XB_XCNT(j)]); sum += c; cnt += (c > 0u) ? 1u : 0u; mine = (j == x) ? c : mine; }
        if (sum == G) break;
        __builtin_amdgcn_s_sleep(1);
        if ((++sp & 255u) == 0u) { if (xb_ld(&bar[XB_TMO])) break; if (sp > XB_SPIN_CAP) { atomicAdd(&bar[XB_TMO], 1u); break; } }
    }
    nloc = mine > 0u ? mine : 1u; nx = cnt > 0u ? cnt : 1u;
}
__device__ __forceinline__ void xcd_barrier(const XcdBarrier& b, const int wave) {
    asm volatile("s_waitcnt vmcnt(0)" ::: "memory");
    __syncthreads();
    if (wave == 0 && hw_lane() == 0) {
        unsigned* bar = b.bar;
        __builtin_amdgcn_s_waitcnt(0);
        unsigned nloc = b.st[0], nx = b.st[1];
        if (nloc == 0u) { xcd_barrier_complete(bar, b.x, nloc, nx); b.st[0] = nloc; b.st[1] = nx; }
        const unsigned old = xb_add(&bar[XB_XSUB(b.x)], 1u);
        const unsigned gen = old / nloc;
        if (old + 1u == (gen + 1u) * nloc) {
            __builtin_amdgcn_fence(__ATOMIC_RELEASE, "agent");
            asm volatile("s_waitcnt vmcnt(0)" ::: "memory");
            const unsigned og = xb_add(&bar[XB_TOP], 1u);
            const unsigned tg = og / nx;
            if (og + 1u == (tg + 1u) * nx) xb_add(&bar[XB_TOPGEN], 1u);
            else XB_SPIN(xb_ld(&bar[XB_TOPGEN]) == tg, bar);
            __builtin_amdgcn_fence(__ATOMIC_ACQUIRE, "agent");
            xb_add(&bar[XB_XGEN(b.x)], 1u);
            asm volatile("s_waitcnt vmcnt(0)" ::: "memory");
        } else {
            XB_SPIN(xb_ld(&bar[XB_XGEN(b.x)]) == gen, bar);
            __builtin_amdgcn_fence(__ATOMIC_ACQUIRE, "agent");
            asm volatile("s_waitcnt vmcnt(0)" ::: "memory");
        }
    }
    __syncthreads();
}

struct Frame {
    LAS unsigned char* lds;
    volatile LAS unsigned* MISC;
    gu32* ctl;
    int vcu, G, wave;
    const float *x, *norm_w, *w_in, *conv_w, *conv_b, *qw, *kw, *rel_bias, *w_out; float* out;
    bf16 *WinT, *WoutT, *XN, *Q, *K, *V, *ZG, *OP4, *OP16, *Y;
    float *TBG, *LP4, *LP16, *SBT, *SBG;
};
__device__ __forceinline__ float wave_sum(float v) {
#pragma unroll
    for (int o = 1; o < 64; o <<= 1) v += __shfl_xor(v, o);
    return v;
}
__device__ __forceinline__ float wave_max(float v) {
#pragma unroll
    for (int o = 1; o < 64; o <<= 1) v = fmaxf(v, __shfl_xor(v, o));
    return v;
}
__device__ __forceinline__ int win_row(int L) {
    int pn, wc, bj, n, fq, reg;
    if (L < 2048) { const int which = L >> 9, ch = L & 511; pn = ch >> 6; wc = (ch >> 4) & 3; fq = (ch >> 2) & 3; reg = ch & 3; bj = which >> 1; n = which & 1; }
    else { const int Lp = L - 2048, grp = Lp >> 9, head = (Lp >> 6) & 7, e = Lp & 63; pn = 8 + 2 * grp + (head >> 2); wc = head & 3; bj = e >> 5; fq = (e >> 3) & 3; n = (e >> 2) & 1; reg = e & 3; }
    return pn * 256 + 128 * bj + 32 * wc + 16 * n + 4 * fq + reg;
}
template <bool PERMUTE>
__device__ __forceinline__ void p0_transpose_item(const float* W, int K, int N, bf16* WT, LAS float* scr, int item, int lane) {
    const int nblk = N / 32, kb = item / nblk, nb = item % nblk, k0 = 64 * kb, n0 = 32 * nb;
#pragma unroll 8
    for (int i = 0; i < 32; ++i) { const int kk = 2 * i + (lane >> 5); scr[kk * 33 + (lane & 31)] = W[(size_t)(k0 + kk) * N + n0 + (lane & 31)]; }
    LDS_WAIT(); asm volatile("" ::: "memory");
    const int c = lane & 7;
#pragma unroll
    for (int j = 0; j < 4; ++j) { const int n = (lane >> 3) + 8 * j; const LAS float* s = scr + (8 * c) * 33 + n;
        v4u o; o.x = pk2(s[0 * 33], s[1 * 33]); o.y = pk2(s[2 * 33], s[3 * 33]); o.z = pk2(s[4 * 33], s[5 * 33]); o.w = pk2(s[6 * 33], s[7 * 33]);
        const int dr = PERMUTE ? win_row(n0 + n) : (n0 + n);
        *(GAS v4u*)(WT + (size_t)dr * K + k0 + 8 * c) = o; }
    LDS_WAIT(); asm volatile("" ::: "memory");
}
__device__ __forceinline__ int t5_bucket(int rel) {
    const int n = rel < 0 ? -rel : rel; int b = rel > 0 ? 16 : 0;
    if (n < 8) return b + n;
    int large = 8 + (int)(logf((float)n / 8.f) / logf(128.f) * 8.f);
    if (large > 15) large = 15;
    return b + large;
}
__device__ __forceinline__ void p0_prologue(Frame& F) {
    const int lane_l = hw_lane(), wave_l = F.wave, tid_l = wave_l * 64 + lane_l;
    LAS float* scr = (LAS float*)(F.lds + RING_OFF + wave_l * 16384);
    const int gw = F.vcu * NWAVES + wave_l, NGW = F.G * NWAVES;
    constexpr int I_IN = (D_MODEL / 64) * (NPROJ / 32), I_OUT = (D_MODEL / 64) * (D_MODEL / 32);
    for (int it = gw; it < I_IN + I_OUT; it += NGW) {
        if (it < I_IN) p0_transpose_item<true>(F.w_in, D_MODEL, NPROJ, F.WinT, scr, it, lane_l);
        else p0_transpose_item<false>(F.w_out, D_MODEL, D_MODEL, F.WoutT, scr, it - I_IN, lane_l);
    }
    f32x4 nw[4];
#pragma unroll
    for (int j = 0; j < 4; ++j) nw[j] = ((const f32x4*)F.norm_w)[lane_l + 64 * j];
    for (int m = gw; m < M; m += NGW) {
        const GAS f32x4* xr = (const GAS f32x4*)(F.x + (size_t)m * D_MODEL) + lane_l;
        f32x4 v[4]; float s = 0.f;
#pragma unroll
        for (int j = 0; j < 4; ++j) { v[j] = xr[64 * j]; s += (v[j].x * v[j].x + v[j].y * v[j].y) + (v[j].z * v[j].z + v[j].w * v[j].w); }
        const float rstd = 1.f / sqrtf(wave_sum(s) * (1.f / D_MODEL) + 1e-6f);
        GAS unsigned long long* o8 = (GAS unsigned long long*)(F.XN + (size_t)m * D_MODEL) + lane_l;
#pragma unroll
        for (int j = 0; j < 4; ++j) { const f32x4 y = v[j] * rstd * nw[j]; o8[64 * j] = (unsigned long long)pk2(y.x, y.y) | ((unsigned long long)pk2(y.z, y.w) << 32); }
    }
    if (blockIdx.x == 0) {
        const float mq = wave_max(fabsf(F.qw[lane_l])), mk = wave_max(fabsf(F.kw[lane_l]));
        float mb = 0.f;
#pragma unroll
        for (int j = 0; j < 4; ++j) mb = fmaxf(mb, fabsf(F.rel_bias[lane_l + 64 * j]));
        mb = wave_max(mb);
        const float M2 = (8.f * mq * mk + mb) * 1.4426950408889634f;
        for (int i = tid_l; i < 3 * 8 * 192; i += NWAVES * 64) {
            const int jp = i % 192, h = (i / 192) & 7, c = i / (192 * 8), j = jp - 32;
            const int dil = c == 0 ? 1 : (c == 1 ? 4 : 16);
            float v = -1e30f;
            if (j >= 0 && j <= 128) v = F.rel_bias[t5_bucket((j - 64) * dil) * 8 + h] * 1.4426950408889634f - M2;
            F.TBG[i] = v;
        }
    }
}

__device__ __forceinline__ int crow(int r, int hi) { return (r & 3) + 8 * (r >> 2) + 4 * hi; }
__device__ __forceinline__ unsigned cvtpk_s(float lo, float hi) { typedef float f2 __attribute__((ext_vector_type(2))); typedef __bf16 b2 __attribute__((ext_vector_type(2))); f2 v = {lo, hi}; b2 b = __builtin_convertvector(v, b2); return __builtin_bit_cast(unsigned, b); }
typedef short v4i16_t __attribute__((ext_vector_type(4)));
__device__ __forceinline__ s16x4 vtr(LAS const unsigned char* p) { return __builtin_bit_cast(s16x4, __builtin_amdgcn_ds_read_tr16_b64_v4i16((LAS v4i16_t*)p)); }

__device__ __forceinline__ void conv_fixup_item(Frame& F, int idx, int lane) {
    const int ridx = idx >> 3, ch = (idx & 7) * 64 + lane, pm = ridx >> 1, last = ridx & 1;
    const bool hasp = last || (pm % (SEQ / 256) != 0), hasn = !last || (pm % (SEQ / 256) != SEQ / 256 - 1);
    const float tc = F.SBT[(size_t)(pm * 4 + (last ? 3 : 0)) * 512 + ch];
    const float tp = last ? F.SBT[(size_t)(pm * 4 + 2) * 512 + ch] : F.SBT[(size_t)((hasp ? pm - 1 : pm) * 4 + 3) * 512 + ch];
    const float tn = last ? F.SBT[(size_t)((hasn ? pm + 1 : pm) * 4 + 0) * 512 + ch] : F.SBT[(size_t)(pm * 4 + 1) * 512 + ch];
    const float g = F.SBG[(size_t)(pm * 2 + last) * 512 + ch];
    const float y = g * (F.conv_w[ch] * (hasp ? tp : 0.f) + F.conv_w[512 + ch] * tc + F.conv_w[1024 + ch] * (hasn ? tn : 0.f) + F.conv_b[ch]);
    F.Y[(size_t)(pm * 256 + (last ? 255 : 0)) * D_MODEL + ch] = (bf16)f2bf(y);
}
constexpr int AT_TILE = 8448, AT_KCH = 528, AT_VOFF = 4224, AT_VPC = 1056, AT_NT = 12;
constexpr int AT_OST = AT_NT * AT_TILE;
constexpr int AT_TBL = AT_OST + NWAVES * 4096;
constexpr int AT_LW = AT_TBL + 768;
static_assert(AT_LW + NWAVES * 128 <= LDSCTL_OFF, "attention LDS map");
struct TaskD { int dil, L, i0, hq, c, h, tok0, sb, start; };
template <bool FINAL>
__device__ __forceinline__ TaskD unit_decode(int vcu, int i) {
    TaskD D; const int x = vcu >> 5, j = vcu & 31;
    int pair, r, blk;
    if (FINAL) { pair = 2 * x + 1 - (i >> 1);     r = 0; blk = 2 * j + (i & 1); D.c = 0; D.dil = 1; D.L = SEQ; }
    else { pair = 2 * x + (i >> 2); const int k = i & 3;
        if (j < 16) { D.c = 1; D.dil = 4; D.L = SEQ / 4; r = j >> 2; blk = 4 * (j & 3) + k; } else { D.c = 2; D.dil = 16; D.L = SEQ / 16; r = j - 16; blk = k; } }
    D.h = pair & 7; D.hq = D.h * 64; D.tok0 = (pair >> 3) * SEQ + r; D.i0 = blk * 256;
    D.sb = 4 * ((2 * blk) % 3);
    D.start = FINAL ? ((i & 1) == 0) : ((i & 3) == 0);
    return D;
}
#define AT_BAR() do { asm volatile("s_waitcnt lgkmcnt(0)" ::: "memory"); __builtin_amdgcn_s_barrier(); asm volatile("" ::: "memory"); } while (0)
template <bool FINAL>
__device__ __forceinline__ void attn_units(Frame& F) {
    constexpr int u0 = 0, u1 = FINAL ? 4 : 8;
    const int lane = hw_lane(), w = F.wave, tid_l = w * 64 + lane, r32 = lane & 31, hi = lane >> 5;
    LAS unsigned char* L0 = F.lds;
    LAS unsigned short* stgb = (LAS unsigned short*)(F.lds + AT_OST + w * 4096);
    LAS float* tbl = (LAS float*)(F.lds + AT_TBL);
    LAS float* lw = (LAS float*)(F.lds + AT_LW) + w * 32;
    const int vaddr = AT_VOFF + ((lane >> 4) & 1) * 32 + (lane & 3) * 8 + (4 * hi + ((lane & 15) >> 2)) * 64;
    const bool isV = w >= 4; const int srow = 8 * (w & 3) + (lane >> 3), sch = lane & 7;
    const int sdst = isV ? (AT_VOFF + (sch >> 2) * (2 * AT_VPC) + (srow >> 4) * AT_VPC + (srow & 15) * 64 + (sch & 3) * 16) : (sch * AT_KCH + srow * 16);
    const bf16* ssrc = isV ? F.V : F.K;
    bf16x8 st[AT_NT], qr[4];
#define STAGE_LOAD(D_) do { _Pragma("unroll") for (int t_ = 0; t_ < AT_NT; ++t_) if (t_ >= 4 || (D_).start) { int key_ = (D_).i0 - 64 + 32 * t_ + srow; key_ = key_ < 0 ? 0 : (key_ > (D_).L - 1 ? (D_).L - 1 : key_); \
        st[t_] = *(const bf16x8*)(ssrc + (unsigned)(((D_).tok0 + (D_).dil * key_) * AW + (D_).hq + sch * 8)); } } while (0)
#define LOADQN(D_) do { const unsigned qo_ = (unsigned)(((D_).tok0 + (D_).dil * ((D_).i0 + 32 * w + r32)) * AW + (D_).hq + hi * 8); \
        _Pragma("unroll") for (int d0 = 0; d0 < 4; ++d0) qr[d0] = *(const bf16x8*)(F.Q + qo_ + d0 * 16); } while (0)
#define SBAR() __builtin_amdgcn_sched_barrier(0)
#define TSLOT(kc) ((sw0 + (kc)) >= 12 ? (sw0 + (kc)) - 12 : (sw0 + (kc)))
#define LDK(kc, KF) do { const LAS unsigned char* tk_ = L0 + TSLOT(kc) * AT_TILE + hi * AT_KCH + r32 * 16; \
        _Pragma("unroll") for (int d0 = 0; d0 < 4; ++d0) KF[d0] = *(const LAS bf16x8*)(tk_ + 2 * d0 * AT_KCH); } while (0)
#define LDT(kc, A) do { const int k0_ = i0w - 64 + 32 * (kc);     \
        const LAS float* tp_ = tbl + ((k0_ >= 0 && k0_ < D.L) ? (32 + 32 * (kc) + 4 * hi - r32) : 0); \
        _Pragma("unroll") for (int rr = 0; rr < 16; ++rr) A[rr] = tp_[(rr & 3) + 8 * (rr >> 2)]; } while (0)
#define LDVH(kc, h) do { const LAS unsigned char* vb_ = L0 + TSLOT(kc) * AT_TILE + vaddr; \
        _Pragma("unroll") for (int pc = 2 * (h); pc < 2 * (h) + 2; ++pc) { vl[pc] = vtr(vb_ + pc * AT_VPC); vh[pc] = vtr(vb_ + pc * AT_VPC + 512); } } while (0)
#define LDV(kc) do { LDVH(kc, 0); LDVH(kc, 1); } while (0)
#define VFR(pc) (bf16x8){vl[pc][0], vl[pc][1], vl[pc][2], vl[pc][3], vh[pc][0], vh[pc][1], vh[pc][2], vh[pc][3]}
#define SMM(KF, A) do { _Pragma("unroll") for (int d0 = 0; d0 < 4; ++d0) A = __builtin_amdgcn_mfma_f32_32x32x16_bf16(KF[d0], qr[d0], A, 0, 0, 0); } while (0)
#define EXPK(A) do { _Pragma("unroll") for (int rr = 0; rr < 16; ++rr) A[rr] = __builtin_amdgcn_exp2f(A[rr]); \
        ls0 += (A[0] + A[1]) + (A[2] + A[3]); ls1 += (A[4] + A[5]) + (A[6] + A[7]); ls2 += (A[8] + A[9]) + (A[10] + A[11]); ls3 += (A[12] + A[13]) + (A[14] + A[15]); \
        pw0.x = cvtpk_s(A[0], A[1]); pw0.y = cvtpk_s(A[2], A[3]); pw0.z = cvtpk_s(A[4], A[5]); pw0.w = cvtpk_s(A[6], A[7]); \
        pw1.x = cvtpk_s(A[8], A[9]); pw1.y = cvtpk_s(A[10], A[11]); pw1.z = cvtpk_s(A[12], A[13]); pw1.w = cvtpk_s(A[14], A[15]); } while (0)
#define PVM() do { \
        o0 = __builtin_amdgcn_mfma_f32_32x32x16_bf16(__builtin_bit_cast(bf16x8, pw0), VFR(0), o0, 0, 0, 0); \
        o0 = __builtin_amdgcn_mfma_f32_32x32x16_bf16(__builtin_bit_cast(bf16x8, pw1), VFR(1), o0, 0, 0, 0); \
        o1 = __builtin_amdgcn_mfma_f32_32x32x16_bf16(__builtin_bit_cast(bf16x8, pw0), VFR(2), o1, 0, 0, 0); \
        o1 = __builtin_amdgcn_mfma_f32_32x32x16_bf16(__builtin_bit_cast(bf16x8, pw1), VFR(3), o1, 0, 0, 0); } while (0)
#define CHUNK1(kc) do { LDVH(kc, 0); SBAR(); SMM(kf, aA); SBAR(); LDVH(kc, 1); if ((kc) < 4) { LDK((kc) + 1, kf); SBAR(); } else { LOADQN(Dn); SBAR(); } EXPK(aA); SBAR(); if ((kc) < 4) { LDT((kc) + 1, aA); SBAR(); } PVM(); SBAR(); } while (0)
#define CHUNKS() do { LDK(0, kf); LDT(0, aA); SBAR(); CHUNK1(0); CHUNK1(1); CHUNK1(2); CHUNK1(3); CHUNK1(4); } while (0)
    TaskD D = unit_decode<FINAL>(F.vcu, u0);
    STAGE_LOAD(D); LOADQN(D);
    if (!FINAL) { for (int idx = F.vcu * NWAVES + w; idx < 8 * 2 * (M / 256); idx += F.G * NWAVES) conv_fixup_item(F, idx, lane); }
    int tb_ch = -1;
    for (int u = u0; u < u1; ++u) {
        const TaskD Dn = unit_decode<FINAL>(F.vcu, u + 1 < u1 ? u + 1 : u);
        AT_BAR();
#pragma unroll
        for (int t_ = 0; t_ < AT_NT; ++t_) if (t_ >= 4 || D.start) { int sl_ = D.sb + t_; sl_ = sl_ >= 12 ? sl_ - 12 : sl_; *(LAS bf16x8*)(L0 + sl_ * AT_TILE + sdst) = st[t_]; }
        if (tb_ch != D.c * 8 + D.h) { tb_ch = D.c * 8 + D.h; if (tid_l < 192) tbl[tid_l] = F.TBG[tb_ch * 192 + tid_l]; }
        AT_BAR();
        STAGE_LOAD(Dn);
        const int i0w = D.i0 + 32 * w; const int sw0 = (D.sb + w) >= 12 ? D.sb + w - 12 : D.sb + w;
        v4u p4[4], p16[4], zg[4]; float l4[4], l16[4];
#define FIN_LOAD(i) do { const int row = (i) * 8 + (lane >> 3), ch = lane & 7; const unsigned tok = (unsigned)(D.tok0 + i0w + row); const unsigned eo = tok * AW + D.hq + ch * 8; \
            p4[i] = *(const v4u*)(F.OP4 + eo); p16[i] = *(const v4u*)(F.OP16 + eo); zg[i] = *(const v4u*)(F.ZG + eo); l4[i] = F.LP4[tok + (7 * (D.tok0 / SEQ) + D.h) * SEQ]; l16[i] = F.LP16[tok + (7 * (D.tok0 / SEQ) + D.h) * SEQ]; } while (0)
        if (false) { FIN_LOAD(0); }
        f32x16 o0 = {}, o1 = {}, aA; float ls0 = 0.f, ls1 = 0.f, ls2 = 0.f, ls3 = 0.f; bf16x8 kf[4]; s16x4 vl[4], vh[4]; v4u pw0, pw1;
        CHUNKS();
        float lsum = (ls0 + ls1) + (ls2 + ls3);
        lsum += __shfl_xor(lsum, 32);
#pragma unroll
        for (int rr = 0; rr < 16; rr += 2) {
            const unsigned a01 = cvtpk_s(o0[rr], o0[rr + 1]), b01 = cvtpk_s(o1[rr], o1[rr + 1]);
            const int q0 = crow(rr, hi), q1 = crow(rr + 1, hi);
            stgb[q0 * 64 + r32] = (unsigned short)(a01 & 0xffffu); stgb[q1 * 64 + r32] = (unsigned short)(a01 >> 16);
            stgb[q0 * 64 + 32 + r32] = (unsigned short)(b01 & 0xffffu); stgb[q1 * 64 + 32 + r32] = (unsigned short)(b01 >> 16);
        }
        if (FINAL) { if (hi == 0) lw[r32] = lsum; FIN_LOAD(0); FIN_LOAD(1); FIN_LOAD(2); FIN_LOAD(3); }
        else { if (hi == 0) { float* lp = F.LP4 + (size_t)(D.c - 1) * (size_t)(256u << 10) + (unsigned)((D.tok0 + D.dil * (i0w + r32)) + (7 * (D.tok0 / SEQ) + D.h) * SEQ); *lp = lsum;     } }
#pragma unroll
        for (int i = 0; i < 4; ++i) {
            const int row = i * 8 + (lane >> 3), ch = lane & 7;
            const unsigned tok = (unsigned)(D.tok0 + D.dil * (i0w + row));
            const v4u ov = *(const LAS v4u*)(stgb + row * 64 + ch * 8);
            if (!FINAL) {
                *(v4u*)(F.OP4 + (size_t)(D.c - 1) * (size_t)(16u << 20) + (tok * AW + D.hq + ch * 8)) = ov;
            } else {
                const float inv = 1.f / (lw[row] + l4[i] + l16[i]);
                float y[8];
#define SZ(x) pg8::silu_f(x)
                y[0] = (bflo(ov.x) + bflo(p4[i].x) + bflo(p16[i].x)) * inv * SZ(bflo(zg[i].x)); y[1] = (bfhi(ov.x) + bfhi(p4[i].x) + bfhi(p16[i].x)) * inv * SZ(bfhi(zg[i].x));
                y[2] = (bflo(ov.y) + bflo(p4[i].y) + bflo(p16[i].y)) * inv * SZ(bflo(zg[i].y)); y[3] = (bfhi(ov.y) + bfhi(p4[i].y) + bfhi(p16[i].y)) * inv * SZ(bfhi(zg[i].y));
                y[4] = (bflo(ov.z) + bflo(p4[i].z) + bflo(p16[i].z)) * inv * SZ(bflo(zg[i].z)); y[5] = (bfhi(ov.z) + bfhi(p4[i].z) + bfhi(p16[i].z)) * inv * SZ(bfhi(zg[i].z));
                y[6] = (bflo(ov.w) + bflo(p4[i].w) + bflo(p16[i].w)) * inv * SZ(bflo(zg[i].w)); y[7] = (bfhi(ov.w) + bfhi(p4[i].w) + bfhi(p16[i].w)) * inv * SZ(bfhi(zg[i].w));
#undef SZ
                v4u wv; wv.x = cvtpk_s(y[0], y[1]); wv.y = cvtpk_s(y[2], y[3]); wv.z = cvtpk_s(y[4], y[5]); wv.w = cvtpk_s(y[6], y[7]);
                *(v4u*)(F.Y + (tok * D_MODEL + 512 + D.hq + ch * 8)) = wv;
            }
        }
        D = Dn;
    }
    AT_BAR();
#undef STAGE_LOAD
#undef LOADQN
#undef SBAR
#undef LDK
#undef TSLOT
#undef LDT
#undef LDV
#undef LDVH
#undef VFR
#undef SMM
#undef EXPK
#undef PVM
#undef CHUNK1
#undef CHUNKS
#undef FIN_LOAD
}
__device__ __forceinline__ void attn_pass_a(Frame& F) {
    attn_units<false>(F);
}
__device__ __forceinline__ void attn_pass_b(Frame& F) {
    attn_units<true>(F);
}

struct Args { const float* in[9]; float* out; unsigned char* ws; int ph_lo, ph_hi; };
__global__ void __launch_bounds__(NWAVES * 64, 2) mega(Args args) {
    extern __shared__ __attribute__((aligned(16))) unsigned char lds[];
    Frame F;
    F.lds = (LAS unsigned char*)lds;
    F.MISC = (volatile LAS unsigned*)(F.lds + MISC_OFF);
    F.wave = __builtin_amdgcn_readfirstlane((int)threadIdx.x >> 6); F.G = gridDim.x; { const int bx = blockIdx.x; F.vcu = (F.G % 8 == 0) ? (bx % 8) * (F.G / 8) + bx / 8 : bx; }
    unsigned char* ws = args.ws;
    F.ctl = (gu32*)(ws + WS_CTL);
    F.x = args.in[0]; F.norm_w = args.in[1]; F.w_in = args.in[2]; F.conv_w = args.in[3]; F.conv_b = args.in[4]; F.qw = args.in[5]; F.kw = args.in[6]; F.rel_bias = args.in[7]; F.w_out = args.in[8];
    F.out = args.out;
    F.WinT = (bf16*)(ws + WS_WIN); F.WoutT = (bf16*)(ws + WS_WOUT); F.XN = (bf16*)(ws + WS_XN);
    F.SBT = (float*)(ws + WS_SBT); F.SBG = (float*)(ws + WS_SBG); F.Q = (bf16*)(ws + WS_Q); F.K = (bf16*)(ws + WS_K); F.V = (bf16*)(ws + WS_V); F.ZG = (bf16*)(ws + WS_ZG);
    F.OP4 = (bf16*)(ws + WS_OP4); F.OP16 = (bf16*)(ws + WS_OP16); F.Y = (bf16*)(ws + WS_Y);
    F.TBG = (float*)(ws + WS_TBG); F.LP4 = (float*)(ws + WS_LP4); F.LP16 = (float*)(ws + WS_LP16);
    for (int u = threadIdx.x; u < (LDS_BYTES - LDSCTL_OFF) / 4; u += NWAVES * 64) ((LAS unsigned*)(F.lds + LDSCTL_OFF))[u] = 0u;
    __syncthreads();
    const int lo = args.ph_lo, hi = args.ph_hi;
    const bool multi = (hi - lo) > 1;
    XcdBarrier bar; bar.bar = (unsigned*)(F.ctl + CW_BAR); bar.x = 0; bar.st = nullptr;
    if (multi) bar = xcd_barrier_post((unsigned*)(F.ctl + CW_BAR), F.MISC + 8);
#define IN(k) (lo <= (k) && (k) < hi)
#define BOTH(k) (IN(k) && IN((k) + 1))
    if (IN(0)) { p0_prologue(F); if (BOTH(0)) xcd_barrier(bar, F.wave); }
    if (IN(1)) {
        pg8::Gemm g{F.XN, F.WinT, M, NPROJ, D_MODEL}; pg8::StaticOrder S; S.init(M, NPROJ, F.G, (int)blockIdx.x);
        { LAS float* cwl = (LAS float*)(F.lds + XL_OFF + 2048);
          const int tl = F.wave * 64 + hw_lane();
          for (int i = tl; i < 2048; i += NWAVES * 64) cwl[i] = i < 1536 ? F.conv_w[i] : F.conv_b[i - 1536];
          if (tl < 128) cwl[2048 + tl] = tl < 64 ? F.qw[tl] : F.kw[tl - 64];
          __syncthreads(); }
        pg8::EpiProj E{F.Y, F.Q, F.SBT, F.SBG, F.lds + XL_OFF};
        pg8::gemm_phase<pg8::EpiProj, pg8::StaticOrder, true, true>(F.lds + RING_OFF, g, S, E, F.wave);
        if (BOTH(1)) xcd_barrier(bar, F.wave);
    }
    if (IN(2)) { attn_pass_a(F); if (BOTH(2)) xcd_barrier(bar, F.wave); }
    if (IN(3)) { attn_pass_b(F); if (BOTH(3)) xcd_barrier(bar, F.wave); }
    if (IN(4)) {
        pg8::Gemm g{F.Y, F.WoutT, M, D_MODEL, D_MODEL}; pg8::StaticOrder S; S.init(M, D_MODEL, F.G, (int)blockIdx.x);
        pg8::EpiRes E{F.x, F.out, D_MODEL};
        pg8::gemm_phase<pg8::EpiRes, pg8::StaticOrder, true, true>(F.lds + RING_OFF, g, S, E, F.wave);
    }
#undef IN
#undef BOTH
}

extern "C" void kernel_launch(void* const* d_in, const int* in_sizes, int n_in, void* d_out, int out_size, void* d_ws, size_t ws_size, hipStream_t stream) {
    static int grid = 0;
    if (grid == 0) {
        if (n_in != 9 || in_sizes[0] != M * D_MODEL || out_size != M * D_MODEL || ws_size < WS_END) { fprintf(stderr, "kernel_launch: unexpected shapes (n_in %d, in0 %d, out %d, ws %zu)\n", n_in, n_in > 0 ? in_sizes[0] : -1, out_size, ws_size); grid = -1; return; }
        int dev = 0, cus = 0, per_cu = 0;
        if (hipGetDevice(&dev) != hipSuccess || hipDeviceGetAttribute(&cus, hipDeviceAttributeMultiprocessorCount, dev) != hipSuccess) { grid = -1; return; }
        if (hipFuncSetAttribute((const void*)mega, hipFuncAttributeMaxDynamicSharedMemorySize, LDS_BYTES) != hipSuccess) { fprintf(stderr, "kernel_launch: hipFuncSetAttribute failed\n"); grid = -1; return; }
        if (hipOccupancyMaxActiveBlocksPerMultiprocessor(&per_cu, (const void*)mega, NWAVES * 64, LDS_BYTES) != hipSuccess || per_cu < 1) { fprintf(stderr, "kernel_launch: occupancy query says %d blocks per CU\n", per_cu); (void)hipGetLastError(); grid = -1; return; }
        grid = cus;
        if (grid != 256) { fprintf(stderr, "kernel_launch: built for a 256-CU device (got %d CUs)\n", cus); grid = -1; return; }
    }
    if (grid < 0) return;
    (void)hipMemsetAsync((char*)d_ws + WS_CTL, 0, CTL_ZERO_BYTES, stream);
    Args a{};
    for (int i = 0; i < 9; ++i) a.in[i] = (const float*)d_in[i];
    a.out = (float*)d_out; a.ws = (unsigned char*)d_ws;
    unsigned char* ws = (unsigned char*)d_ws;
#if STAGE == 4
    a.ph_lo = 0; a.ph_hi = 5;
    hipLaunchKernelGGL(mega, dim3(grid), dim3(NWAVES * 64), LDS_BYTES, stream, a);
    if (PROBE_PHASE >= 0) { a.ph_lo = PROBE_PHASE; a.ph_hi = PROBE_PHASE + 1; hipLaunchKernelGGL(mega, dim3(grid), dim3(NWAVES * 64), LDS_BYTES, stream, a); }
#else
    const int nper = 5;
    for (int p = 0; p < nper; ++p) { a.ph_lo = p; a.ph_hi = p + 1; hipLaunchKernelGGL(mega, dim3(grid), dim3(NWAVES * 64), LDS_BYTES, stream, a); }
#endif
}
```

```cpp
#include <hip/hip_runtime.h>
#include <cstdio>
#include <cstdint>

#ifndef PROBE_PHASE
#define PROBE_PHASE -1
#endif
#ifndef STAGE
#define STAGE 4
#endif

__device__ __forceinline__ int hw_lane() { return (int)__builtin_amdgcn_mbcnt_hi(~0u, __builtin_amdgcn_mbcnt_lo(~0u, 0u)); }

namespace pg8 {
#define PG8_LAS __attribute__((address_space(3)))
typedef unsigned short bf16_t;
typedef short bf16x8 __attribute__((ext_vector_type(8)));
typedef float f32x4 __attribute__((ext_vector_type(4)));
typedef unsigned u32x4 __attribute__((ext_vector_type(4)));
typedef unsigned u32x2 __attribute__((ext_vector_type(2)));
constexpr int BM = 256, BK = 64, HALF = 128, HTB = HALF * BK * 2, STAGE_BYTES = 8 * HTB, NXCD = 8, WGM = 8;

__host__ __device__ __forceinline__ int lds_byte(int r, int c) { const int st = (r >> 4) * 2 + (c >> 5), rr = r & 15, cc = c & 31, ob = rr * 64 + cc * 2; return st * 1024 + (ob ^ (((ob >> 9) & 1) << 5)); }
__host__ __device__ __forceinline__ void stage_rc(int b, int& R, int& C) { const int st = b / 1024, sb = b % 1024, swz = sb ^ (((sb >> 9) & 1) << 5); R = (st >> 1) * 16 + swz / 64; C = (st & 1) * 32 + (swz % 64) / 2; }

struct Unit { int pm, pn; };
struct Gemm { const bf16_t* A; const bf16_t* Bt; int M, N, K; };

struct StaticOrder {
    int nM, nN, nwg, G, c;
    __host__ __device__ void init(int M, int N, int G_, int c_) { nM = M / BM; nN = N / BM; nwg = nM * nN; G = G_; c = c_; }
    __host__ __device__ bool next(int i, Unit& u) const {
        const long L = (long)i * G + c; if (L >= nwg) return false;
        int wgid = (int)L; { const int q = nwg / NXCD, r = nwg % NXCD, xcd = wgid % NXCD, off = wgid / NXCD; wgid = (xcd < r ? xcd * (q + 1) : r * (q + 1) + (xcd - r) * q) + off; }
        const int nig = WGM * nN, gid = wgid / nig, fm = gid * WGM, gsz = (nM - fm) < WGM ? (nM - fm) : WGM;
        u.pm = fm + ((wgid % nig) % gsz); u.pn = (wgid % nig) / gsz; return true;
    }
};

__device__ __forceinline__ unsigned cvt_pk_bf16(float lo, float hi) { unsigned r; asm volatile("v_cvt_pk_bf16_f32 %0, %1, %2" : "=v"(r) : "v"(lo), "v"(hi)); return r; }
__device__ __forceinline__ float silu_f(float z) { return z * __builtin_amdgcn_rcpf(1.f + __builtin_amdgcn_exp2f(-1.4426950408889634f * z)); }

struct EpiProj {
    static constexpr bool PERM = false, AFTER_DRAIN = false, XPRE = false;
    bf16_t *Y, *QKVZ; float *SBT, *SBG; PG8_LAS unsigned char* xl;
    __device__ __forceinline__ void operator()(const f32x4 (&acc)[2][2][4][2], const Unit& u, int wr, int wc, int fr, int fq) const {
        const int row0 = u.pm * BM + wr * 64 + fr;
        if (u.pn < 8) {
            const int lane = fr + 16 * fq, chl = 16 * wc + 4 * fq, ch0 = 64 * u.pn + chl;
            PG8_LAS float* X = (PG8_LAS float*)xl;
            const PG8_LAS float* CWl = (const PG8_LAS float*)(xl + 2048);
            f32x4 t[2][4], g[2][4];
#pragma unroll
            for (int ai = 0; ai < 2; ++ai)
#pragma unroll
                for (int m = 0; m < 4; ++m) {
                    const f32x4 uu = acc[ai][0][m][0], gb = acc[ai][0][m][1], gc = acc[ai][1][m][0], z = acc[ai][1][m][1];
                    t[ai][m] = gc * uu;
#pragma unroll
                    for (int i = 0; i < 4; ++i) g[ai][m][i] = gb[i] * silu_f(z[i]);
                }
#pragma unroll
            for (int ai = 0; ai < 2; ++ai) { const int grpi = 2 * ai + wr;
                if (fr == 0) *(PG8_LAS f32x4*)(X + (grpi * 2 + 0) * 64 + chl) = t[ai][0];
                if (fr == 15) *(PG8_LAS f32x4*)(X + (grpi * 2 + 1) * 64 + chl) = t[ai][3]; }
            if (wr == 0 && fr < 2) { *(f32x4*)(SBT + ((size_t)(u.pm * 4 + fr) * 512 + ch0)) = t[0][0]; if (fr == 0) *(f32x4*)(SBG + ((size_t)(u.pm * 2 + 0) * 512 + ch0)) = g[0][0]; }
            if (wr == 1 && fr >= 14) { *(f32x4*)(SBT + ((size_t)(u.pm * 4 + fr - 12) * 512 + ch0)) = t[1][3]; if (fr == 15) *(f32x4*)(SBG + ((size_t)(u.pm * 2 + 1) * 512 + ch0)) = g[1][3]; }
            asm volatile("s_waitcnt lgkmcnt(0)" ::: "memory"); __builtin_amdgcn_s_barrier(); asm volatile("" ::: "memory");
            const f32x4 w0 = *(const PG8_LAS f32x4*)(CWl + ch0), w1 = *(const PG8_LAS f32x4*)(CWl + 512 + ch0), w2 = *(const PG8_LAS f32x4*)(CWl + 1024 + ch0), cb = *(const PG8_LAS f32x4*)(CWl + 1536 + ch0);
#pragma unroll
            for (int ai = 0; ai < 2; ++ai) { const int grpi = 2 * ai + wr;
                const f32x4 xprev = *(const PG8_LAS f32x4*)(X + (((grpi + 3) & 3) * 2 + 1) * 64 + chl), xnext = *(const PG8_LAS f32x4*)(X + (((grpi + 1) & 3) * 2 + 0) * 64 + chl);
#pragma unroll
                for (int m = 0; m < 4; ++m) {
                    const f32x4 ps = m > 0 ? t[ai][m - 1] : xprev, ns = m < 3 ? t[ai][m + 1] : xnext, tc = t[ai][m];
                    f32x4 tp, tn;
#pragma unroll
                    for (int i = 0; i < 4; ++i) {
                        tp[i] = __builtin_bit_cast(float, __builtin_amdgcn_update_dpp(0, __builtin_bit_cast(int, fr == 15 ? ps[i] : tc[i]), 0x121, 0xf, 0xf, false));
                        tn[i] = __builtin_bit_cast(float, __builtin_amdgcn_update_dpp(0, __builtin_bit_cast(int, fr == 0 ? ns[i] : tc[i]), 0x12F, 0xf, 0xf, false)); }
                    const f32x4 y = g[ai][m] * (w0 * tp + w1 * tc + w2 * tn + cb);
                    const int rt = 128 * ai + 64 * wr + 16 * m + fr;
                    u32x2 yw; yw.x = cvt_pk_bf16(y[0], y[1]); yw.y = cvt_pk_bf16(y[2], y[3]);
                    if (rt != 0 && rt != 255) *(u32x2*)(Y + (size_t)(u.pm * BM + rt) * 1024 + ch0) = yw;
                }
            }
        } else {
            const int grp = (u.pn - 8) >> 1, head = 4 * ((u.pn - 8) & 1) + wc;
            bf16_t* dst = QKVZ + (size_t)grp * (size_t)(16u << 20);
            const int col0 = head * 64 + 8 * fq;
            f32x4 wv[2][2];
            if (grp < 2) { const PG8_LAS float* w = (const PG8_LAS float*)(xl + 10240) + 64 * grp;
#pragma unroll
                for (int bj = 0; bj < 2; ++bj)
#pragma unroll
                    for (int n = 0; n < 2; ++n) wv[bj][n] = *(const PG8_LAS f32x4*)(w + 32 * bj + 8 * fq + 4 * n); }
            const float sc = grp == 0 ? 0.125f * 1.4426950408889634f : 1.f;
#pragma unroll
            for (int ai = 0; ai < 2; ++ai)
#pragma unroll
                for (int m = 0; m < 4; ++m) {
                    f32x4 v[2][2];
#pragma unroll
                    for (int bj = 0; bj < 2; ++bj)
#pragma unroll
                        for (int n = 0; n < 2; ++n) v[bj][n] = acc[ai][bj][m][n];
                    if (grp < 2) {
                        float ss = 0.f;
#pragma unroll
                        for (int bj = 0; bj < 2; ++bj)
#pragma unroll
                            for (int n = 0; n < 2; ++n) ss += (v[bj][n][0] * v[bj][n][0] + v[bj][n][1] * v[bj][n][1]) + (v[bj][n][2] * v[bj][n][2] + v[bj][n][3] * v[bj][n][3]);
                        ss += __shfl_xor(ss, 16); ss += __shfl_xor(ss, 32);
                        const float rs = __builtin_amdgcn_rsqf(ss * (1.f / 64.f) + 1e-6f) * sc;
#pragma unroll
                        for (int bj = 0; bj < 2; ++bj)
#pragma unroll
                            for (int n = 0; n < 2; ++n) v[bj][n] = v[bj][n] * rs * wv[bj][n];
                    }
                    bf16_t* rowp = dst + (size_t)(row0 + ai * HALF + m * 16) * 512 + col0;
#pragma unroll
                    for (int bj = 0; bj < 2; ++bj) { u32x4 w; w.x = cvt_pk_bf16(v[bj][0][0], v[bj][0][1]); w.y = cvt_pk_bf16(v[bj][0][2], v[bj][0][3]); w.z = cvt_pk_bf16(v[bj][1][0], v[bj][1][1]); w.w = cvt_pk_bf16(v[bj][1][2], v[bj][1][3]);
                        *(u32x4*)(rowp + 32 * bj) = w; }
                }
        }
    }
};
struct EpiRes {
    static constexpr bool PERM = false, AFTER_DRAIN = false, XPRE = true;
    const float* X; float* O; int ldc;
    __device__ __forceinline__ void xissue(const Unit& u, int it, int wr, int wc, int fr, int fq, f32x4 (&xv)[4]) const {
        const int ai = it >> 2, bj = (it >> 1) & 1, m0 = 2 * (it & 1);
        const float* ba = X + ((size_t)(u.pm * BM + ai * HALF + m0 * 16) * ldc + u.pn * BM + bj * HALF);
        const float* bb = ba + (size_t)16 * ldc;
        const unsigned voff = (unsigned)(((wr * 64 + fr) * ldc + wc * 32 + 4 * fq) * 4);
        asm volatile("global_load_dwordx4 %0, %4, %5\n\tglobal_load_dwordx4 %1, %4, %5 offset:64\n\tglobal_load_dwordx4 %2, %4, %6\n\tglobal_load_dwordx4 %3, %4, %6 offset:64"
                     : "=&v"(xv[0]), "=&v"(xv[1]), "=&v"(xv[2]), "=&v"(xv[3]) : "v"(voff), "s"(ba), "s"(bb) : "memory");
    }
    __device__ __forceinline__ void xadd(f32x4 (&acc)[2][2][4][2], int it, f32x4 (&xv)[4]) const {
        asm volatile("" : "+v"(xv[0]), "+v"(xv[1]), "+v"(xv[2]), "+v"(xv[3]));
#define XA(AI, BJ, M0) do { acc[AI][BJ][M0][0] += xv[0]; acc[AI][BJ][M0][1] += xv[1]; acc[AI][BJ][M0 + 1][0] += xv[2]; acc[AI][BJ][M0 + 1][1] += xv[3]; } while (0)
        switch (it) { case 0: XA(0, 0, 0); break; case 1: XA(0, 0, 2); break; case 2: XA(0, 1, 0); break; case 3: XA(0, 1, 2); break;
                      case 4: XA(1, 0, 0); break; case 5: XA(1, 0, 2); break; case 6: XA(1, 1, 0); break; default: XA(1, 1, 2); break; }
#undef XA
    }
    __device__ __forceinline__ void operator()(const f32x4 (&acc)[2][2][4][2], const Unit& u, int wr, int wc, int fr, int fq) const {
        const int row0 = u.pm * BM + wr * 64 + fr, col0 = u.pn * BM + wc * 32 + 4 * fq;
#pragma unroll
        for (int ai = 0; ai < 2; ++ai)
#pragma unroll
            for (int m = 0; m < 4; ++m) { const size_t off = (size_t)(row0 + ai * HALF + m * 16) * ldc + col0;
#pragma unroll
                for (int bj = 0; bj < 2; ++bj)
#pragma unroll
                    for (int n = 0; n < 2; ++n) *(f32x4*)(O + off + bj * HALF + n * 16) = acc[ai][bj][m][n]; }
    }
};

template <class Epi, class Sched, bool ALIGN_EPI = false, bool SP2 = false>
__device__ __forceinline__ void gemm_phase(PG8_LAS unsigned char* lds, const Gemm g, const Sched& S, const Epi& E, const int widx) {
    const int lane = hw_lane(), wid = widx, tid = wid * 64 + lane, wr = wid >> 2, wc = wid & 3, fr = lane & 15, fq = lane >> 4;
    const int K = g.K, nt = K / BK;
    unsigned voffA[2], voffB[2];
#pragma unroll
    for (int i = 0; i < 2; ++i) { int R, C; stage_rc(tid * 16 + i * 8192, R, C);
        voffA[i] = (unsigned)(R * K + C) * 2u; voffB[i] = (unsigned)(R * K + C) * 2u; }
    const size_t kstep = (size_t)(BK * 2);
    const size_t hstep = (size_t)HALF * K * 2;
    const size_t tstep = 2 * hstep;
    const unsigned ldsw = (unsigned)wid * 1024u;
    const int aoff = lds_byte(wr * 64 + fr, fq * 8), boff = lds_byte(wc * 32 + fr, fq * 8);
#define PG8_SA(b, h) (((b) * 2 + (h)) * HTB)
#define PG8_SB(b, h) ((4 + (b) * 2 + (h)) * HTB)
#define PG8_STAGE(bufoff, gbase, voff) do { _Pragma("unroll") for (int _i = 0; _i < 2; ++_i) \
        __builtin_amdgcn_global_load_lds((const unsigned*)((const char*)(gbase) + (voff)[_i]), (PG8_LAS unsigned*)(lds + (bufoff) + ldsw + _i * 8192), 16, 0, 0); } while (0)
#define PG8_LDA(dst, b, h) do { _Pragma("unroll") for (int m = 0; m < 4; ++m) _Pragma("unroll") for (int k = 0; k < 2; ++k) dst[m][k] = *(const PG8_LAS bf16x8*)(lds + PG8_SA(b, h) + aoff + m * 2048 + k * 1024); } while (0)
#define PG8_LDB(dst, b, h) do { _Pragma("unroll") for (int n = 0; n < 2; ++n) _Pragma("unroll") for (int k = 0; k < 2; ++k) dst[n][k] = *(const PG8_LAS bf16x8*)(lds + PG8_SB(b, h) + boff + n * 2048 + k * 1024); } while (0)
#define PG8_MMA(ai, bj, At, Bt) do { __builtin_amdgcn_s_setprio(1); _Pragma("unroll") for (int m = 0; m < 4; ++m) _Pragma("unroll") for (int n = 0; n < 2; ++n) _Pragma("unroll") for (int k = 0; k < 2; ++k) \
        acc[ai][bj][m][n] = __builtin_amdgcn_mfma_f32_16x16x32_bf16(Bt[n][k], At[m][k], acc[ai][bj][m][n], 0, 0, 0); __builtin_amdgcn_s_setprio(0); } while (0)
#define PG8_WAIT_V(n) asm volatile("s_waitcnt vmcnt(" #n ")" ::: "memory")
#define PG8_WAIT_L(n) asm volatile("s_waitcnt lgkmcnt(" #n ")" ::: "memory")
#define PG8_BAR __builtin_amdgcn_s_barrier()
#define PG8_SCHED __builtin_amdgcn_sched_barrier(0)
    Unit cur, nxt; int ui = 0;
    if (!S.next(0, cur)) return;
    f32x4 acc[2][2][4][2];
#pragma unroll
    for (int a = 0; a < 2; ++a)
#pragma unroll
        for (int b = 0; b < 2; ++b)
#pragma unroll
            for (int m = 0; m < 4; ++m)
#pragma unroll
                for (int n = 0; n < 2; ++n) acc[a][b][m][n] = (f32x4){0.f, 0.f, 0.f, 0.f};
    bf16x8 At[4][2], B0[2][2], B1[2][2]; f32x4 xv[4];
    const char* cA = (const char*)g.A + (size_t)cur.pm * tstep; const char* cB = (const char*)g.Bt + (size_t)cur.pn * tstep;
    if constexpr (SP2) {
        PG8_STAGE(PG8_SB(0, 0), cB, voffB); PG8_STAGE(PG8_SB(0, 1), cB + hstep, voffB); PG8_STAGE(PG8_SA(0, 0), cA, voffA); PG8_STAGE(PG8_SA(0, 1), cA + hstep, voffA);
        if (wr == 1) PG8_BAR;
        PG8_WAIT_V(2); PG8_BAR;
        PG8_STAGE(PG8_SB(1, 0), cB + kstep, voffB); PG8_STAGE(PG8_SA(1, 0), cA + kstep, voffA); PG8_STAGE(PG8_SB(1, 1), cB + hstep + kstep, voffB);
        PG8_WAIT_V(6); PG8_BAR;
    } else {
        PG8_STAGE(PG8_SB(0, 0), cB, voffB); PG8_STAGE(PG8_SA(0, 0), cA, voffA); PG8_STAGE(PG8_SB(0, 1), cB + hstep, voffB); PG8_STAGE(PG8_SA(0, 1), cA + hstep, voffA);
        if (wr == 1) PG8_BAR;
        PG8_WAIT_V(4); PG8_BAR;
        PG8_STAGE(PG8_SB(1, 0), cB + kstep, voffB); PG8_STAGE(PG8_SA(1, 0), cA + kstep, voffA); PG8_STAGE(PG8_SB(1, 1), cB + hstep + kstep, voffB);
        PG8_WAIT_V(6); PG8_BAR;
    }
    for (;;) {
        const bool has_next = S.next(ui + 1, nxt);
        const char* nA = has_next ? (const char*)g.A + (size_t)nxt.pm * tstep : cA; const char* nB = has_next ? (const char*)g.Bt + (size_t)nxt.pn * tstep : cB;
        if constexpr (Epi::XPRE) {
#pragma unroll
        for (int t = 0; t < 16; t += 2) {
            const bool last = (t == nt - 2);
            const char* a1 = cA + (size_t)(t + 1) * kstep;
            const char* a2 = last ? nA : cA + (size_t)(t + 2) * kstep; const char* b2 = last ? nB : cB + (size_t)(t + 2) * kstep;
            const char* a3 = a2 + kstep; const char* b3 = b2 + kstep;
            if constexpr (SP2) {
            if constexpr (Epi::XPRE) E.xissue(cur, t >> 1, wr, wc, fr, fq, xv);
            PG8_LDB(B0, 0, 0); PG8_LDB(B1, 0, 1); PG8_SCHED; PG8_LDA(At, 0, 0); PG8_STAGE(PG8_SA(1, 1), a1 + hstep, voffA);
            if constexpr (Epi::XPRE) PG8_WAIT_V(12); else PG8_WAIT_V(8);
            PG8_WAIT_L(0); PG8_BAR; PG8_MMA(0, 0, At, B0); PG8_MMA(0, 1, At, B1); PG8_BAR; PG8_SCHED;
            PG8_LDA(At, 0, 1); PG8_STAGE(PG8_SB(0, 0), b2, voffB); PG8_STAGE(PG8_SB(0, 1), b2 + hstep, voffB); PG8_STAGE(PG8_SA(0, 0), a2, voffA);
            if constexpr (Epi::XPRE) PG8_WAIT_V(12); else PG8_WAIT_V(8);
            PG8_WAIT_L(0); PG8_BAR; PG8_MMA(1, 0, At, B0); PG8_MMA(1, 1, At, B1); PG8_BAR; PG8_SCHED;
            PG8_LDB(B0, 1, 0); PG8_LDB(B1, 1, 1); PG8_SCHED; PG8_LDA(At, 1, 0); PG8_STAGE(PG8_SA(0, 1), a2 + hstep, voffA);
            PG8_WAIT_V(8); PG8_WAIT_L(0); PG8_BAR;
            if constexpr (Epi::XPRE) E.xadd(acc, t >> 1, xv);
            PG8_MMA(0, 0, At, B0); PG8_MMA(0, 1, At, B1); PG8_BAR; PG8_SCHED;
            PG8_LDA(At, 1, 1); PG8_STAGE(PG8_SB(1, 0), b3, voffB); PG8_STAGE(PG8_SB(1, 1), b3 + hstep, voffB); PG8_STAGE(PG8_SA(1, 0), a3, voffA);
            PG8_WAIT_V(8); PG8_WAIT_L(0); PG8_BAR; PG8_MMA(1, 0, At, B0); PG8_MMA(1, 1, At, B1); PG8_BAR; PG8_SCHED;
            } else {
            PG8_LDB(B0, 0, 0); PG8_SCHED; PG8_LDA(At, 0, 0); PG8_STAGE(PG8_SA(1, 1), a1 + hstep, voffA);
            PG8_WAIT_L(8); PG8_BAR; PG8_WAIT_L(0); PG8_MMA(0, 0, At, B0); PG8_BAR; PG8_SCHED;
            PG8_LDB(B1, 0, 1); PG8_STAGE(PG8_SB(0, 0), b2, voffB);
            PG8_BAR; PG8_WAIT_L(0); PG8_MMA(0, 1, At, B1); PG8_BAR;
            PG8_LDA(At, 0, 1); PG8_STAGE(PG8_SA(0, 0), a2, voffA);
            PG8_BAR; PG8_WAIT_L(0); PG8_MMA(1, 0, At, B0); PG8_BAR; PG8_SCHED;
            PG8_STAGE(PG8_SB(0, 1), b2 + hstep, voffB);
            PG8_WAIT_V(6); PG8_BAR; PG8_MMA(1, 1, At, B1); PG8_BAR;
            PG8_LDB(B0, 1, 0); PG8_SCHED; PG8_LDA(At, 1, 0); PG8_STAGE(PG8_SA(0, 1), a2 + hstep, voffA);
            PG8_WAIT_L(8); PG8_BAR; PG8_WAIT_L(0); PG8_MMA(0, 0, At, B0); PG8_BAR; PG8_SCHED;
            PG8_LDB(B1, 1, 1); PG8_STAGE(PG8_SB(1, 0), b3, voffB);
            PG8_BAR; PG8_WAIT_L(0); PG8_MMA(0, 1, At, B1); PG8_BAR;
            PG8_LDA(At, 1, 1); PG8_STAGE(PG8_SA(1, 0), a3, voffA);
            PG8_BAR; PG8_WAIT_L(0); PG8_MMA(1, 0, At, B0); PG8_BAR; PG8_SCHED;
            PG8_STAGE(PG8_SB(1, 1), b3 + hstep, voffB);
            PG8_WAIT_V(6); PG8_BAR; PG8_MMA(1, 1, At, B1); PG8_BAR;
            }
                }
        } else {
        for (int t = 0; t < nt; t += 2) {
            const bool last = (t == nt - 2);
            const char* a1 = cA + (size_t)(t + 1) * kstep;
            const char* a2 = last ? nA : cA + (size_t)(t + 2) * kstep; const char* b2 = last ? nB : cB + (size_t)(t + 2) * kstep;
            const char* a3 = a2 + kstep; const char* b3 = b2 + kstep;
            if constexpr (SP2) {
            if constexpr (Epi::XPRE) E.xissue(cur, t >> 1, wr, wc, fr, fq, xv);
            PG8_LDB(B0, 0, 0); PG8_LDB(B1, 0, 1); PG8_SCHED; PG8_LDA(At, 0, 0); PG8_STAGE(PG8_SA(1, 1), a1 + hstep, voffA);
            if constexpr (Epi::XPRE) PG8_WAIT_V(12); else PG8_WAIT_V(8);
            PG8_WAIT_L(0); PG8_BAR; PG8_MMA(0, 0, At, B0); PG8_MMA(0, 1, At, B1); PG8_BAR; PG8_SCHED;
            PG8_LDA(At, 0, 1); PG8_STAGE(PG8_SB(0, 0), b2, voffB); PG8_STAGE(PG8_SB(0, 1), b2 + hstep, voffB); PG8_STAGE(PG8_SA(0, 0), a2, voffA);
            if constexpr (Epi::XPRE) PG8_WAIT_V(12); else PG8_WAIT_V(8);
            PG8_WAIT_L(0); PG8_BAR; PG8_MMA(1, 0, At, B0); PG8_MMA(1, 1, At, B1); PG8_BAR; PG8_SCHED;
            PG8_LDB(B0, 1, 0); PG8_LDB(B1, 1, 1); PG8_SCHED; PG8_LDA(At, 1, 0); PG8_STAGE(PG8_SA(0, 1), a2 + hstep, voffA);
            PG8_WAIT_V(8); PG8_WAIT_L(0); PG8_BAR;
            if constexpr (Epi::XPRE) E.xadd(acc, t >> 1, xv);
            PG8_MMA(0, 0, At, B0); PG8_MMA(0, 1, At, B1); PG8_BAR; PG8_SCHED;
            PG8_LDA(At, 1, 1); PG8_STAGE(PG8_SB(1, 0), b3, voffB); PG8_STAGE(PG8_SB(1, 1), b3 + hstep, voffB); PG8_STAGE(PG8_SA(1, 0), a3, voffA);
            PG8_WAIT_V(8); PG8_WAIT_L(0); PG8_BAR; PG8_MMA(1, 0, At, B0); PG8_MMA(1, 1, At, B1); PG8_BAR; PG8_SCHED;
            } else {
            PG8_LDB(B0, 0, 0); PG8_SCHED; PG8_LDA(At, 0, 0); PG8_STAGE(PG8_SA(1, 1), a1 + hstep, voffA);
            PG8_WAIT_L(8); PG8_BAR; PG8_WAIT_L(0); PG8_MMA(0, 0, At, B0); PG8_BAR; PG8_SCHED;
            PG8_LDB(B1, 0, 1); PG8_STAGE(PG8_SB(0, 0), b2, voffB);
            PG8_BAR; PG8_WAIT_L(0); PG8_MMA(0, 1, At, B1); PG8_BAR;
            PG8_LDA(At, 0, 1); PG8_STAGE(PG8_SA(0, 0), a2, voffA);
            PG8_BAR; PG8_WAIT_L(0); PG8_MMA(1, 0, At, B0); PG8_BAR; PG8_SCHED;
            PG8_STAGE(PG8_SB(0, 1), b2 + hstep, voffB);
            PG8_WAIT_V(6); PG8_BAR; PG8_MMA(1, 1, At, B1); PG8_BAR;
            PG8_LDB(B0, 1, 0); PG8_SCHED; PG8_LDA(At, 1, 0); PG8_STAGE(PG8_SA(0, 1), a2 + hstep, voffA);
            PG8_WAIT_L(8); PG8_BAR; PG8_WAIT_L(0); PG8_MMA(0, 0, At, B0); PG8_BAR; PG8_SCHED;
            PG8_LDB(B1, 1, 1); PG8_STAGE(PG8_SB(1, 0), b3, voffB);
            PG8_BAR; PG8_WAIT_L(0); PG8_MMA(0, 1, At, B1); PG8_BAR;
            PG8_LDA(At, 1, 1); PG8_STAGE(PG8_SA(1, 0), a3, voffA);
            PG8_BAR; PG8_WAIT_L(0); PG8_MMA(1, 0, At, B0); PG8_BAR; PG8_SCHED;
            PG8_STAGE(PG8_SB(1, 1), b3 + hstep, voffB);
            PG8_WAIT_V(6); PG8_BAR; PG8_MMA(1, 1, At, B1); PG8_BAR;
            }
                }
        }
        if constexpr (ALIGN_EPI) { if (wr == 0) PG8_BAR; }
        E(acc, cur, wr, wc, fr, fq);
        if (!has_next) break;
#pragma unroll
        for (int a = 0; a < 2; ++a)
#pragma unroll
            for (int b = 0; b < 2; ++b)
#pragma unroll
                for (int m = 0; m < 4; ++m)
#pragma unroll
                    for (int n = 0; n < 2; ++n) acc[a][b][m][n] = (f32x4){0.f, 0.f, 0.f, 0.f};
        cur = nxt; cA = nA; cB = nB; ++ui;
        if constexpr (ALIGN_EPI) { if (wr == 1) PG8_BAR; }
    }
    PG8_WAIT_V(0);
    if constexpr (!ALIGN_EPI) { if (wr == 0) PG8_BAR; }
    PG8_BAR;
#undef PG8_SA
#undef PG8_SB
#undef PG8_STAGE
#undef PG8_LDA
#undef PG8_LDB
#undef PG8_MMA
#undef PG8_WAIT_V
#undef PG8_WAIT_L
#undef PG8_BAR
#undef PG8_SCHED
}
}

constexpr int D_MODEL = 1024, BATCH = 2, SEQ = 16384, M = BATCH * SEQ, NPROJ = 4096, AW = 512, NHEAD = 8;
constexpr int NWAVES = 8;
constexpr size_t MiB = 1u << 20;
constexpr size_t WS_CTL = 0, CTL_ZERO_BYTES = 32768;
#ifndef WS_SHIFT_MIB
#define WS_SHIFT_MIB 0
#endif
constexpr size_t WS_SH = (size_t)WS_SHIFT_MIB * MiB;
constexpr size_t WS_TBG = WS_SH + 1 * MiB;
constexpr size_t WS_WIN = WS_SH + 2 * MiB;
constexpr size_t WS_WOUT = WS_SH + 10 * MiB;
constexpr size_t WS_LP4 = WS_SH + 12 * MiB, WS_LP16 = WS_SH + 13 * MiB;
constexpr size_t WS_SBT = WS_SH + 14 * MiB, WS_SBG = WS_SH + 15 * MiB;
constexpr size_t WS_XN = WS_SH + 16 * MiB;
constexpr size_t WS_Q = WS_SH + 80 * MiB, WS_K = WS_SH + 112 * MiB, WS_V = WS_SH + 144 * MiB, WS_ZG = WS_SH + 176 * MiB;
constexpr size_t WS_OP4 = WS_XN, WS_OP16 = WS_XN + 32 * MiB;
constexpr size_t WS_Y = WS_SH + 208 * MiB;
constexpr size_t WS_END = WS_SH + 272 * MiB;
constexpr int CW_BAR = 4096;

constexpr int RING_OFF = 0, RING_BYTES = 131072;
constexpr int LDSCTL_OFF = 146432, MISC_OFF = LDSCTL_OFF + 320;
constexpr int LDS_BYTES = 147456;
constexpr int XL_OFF = 131072;
static_assert(XL_OFF + 10752 <= LDSCTL_OFF, "LDS map");

#define GAS __attribute__((address_space(1)))
#define LAS __attribute__((address_space(3)))
typedef unsigned short bf16;
typedef unsigned v4u __attribute__((ext_vector_type(4)));
typedef float f32x4 __attribute__((ext_vector_type(4)));
typedef float f32x16 __attribute__((ext_vector_type(16)));
typedef short bf16x8 __attribute__((ext_vector_type(8)));
typedef short s16x4 __attribute__((ext_vector_type(4)));
typedef GAS unsigned gu32;
#define RLX_AGENT __ATOMIC_RELAXED, __HIP_MEMORY_SCOPE_AGENT
#define LDS_WAIT() asm volatile("s_waitcnt lgkmcnt(0)" ::: "memory")
__device__ __forceinline__ unsigned f2bf(float f) { unsigned u = __builtin_bit_cast(unsigned, f); return (u + 0x7fffu + ((u >> 16) & 1u)) >> 16; }
__device__ __forceinline__ unsigned pk2(float lo, float hi) { return f2bf(lo) | (f2bf(hi) << 16); }
__device__ __forceinline__ float bf2f(unsigned short b) { return __builtin_bit_cast(float, (unsigned)b << 16); }
__device__ __forceinline__ float bflo(unsigned w) { return __builtin_bit_cast(float, w << 16); }
__device__ __forceinline__ float bfhi(unsigned w) { return __builtin_bit_cast(float, w & 0xffff0000u); }

#define XB_TMO      128
#define XB_XCNT(j)  (256  + 64 * (j))
#define XB_XSUB(j)  (1280 + 64 * (j))
#define XB_XGEN(j)  (2304 + 64 * (j))
#define XB_TOP      3328
#define XB_TOPGEN   3392
#define XCD_BAR_WORDS 3456
#define XB_SPIN_CAP (1u << 18)
__device__ __forceinline__ unsigned xb_ld(unsigned* p)              { return __hip_atomic_load(p, __ATOMIC_RELAXED, __HIP_MEMORY_SCOPE_AGENT); }
__device__ __forceinline__ unsigned xb_add(unsigned* p, unsigned v) { return __hip_atomic_fetch_add(p, v, __ATOMIC_RELAXED, __HIP_MEMORY_SCOPE_AGENT); }
__device__ __forceinline__ unsigned xb_xcc_id() { return (unsigned)__builtin_amdgcn_s_getreg((3 << 11) | 20) & 0xFu; }
#define XB_SPIN(cond, bar) do { unsigned _sp = 0; while (cond) { __builtin_amdgcn_s_sleep(1); \
    if ((++_sp & 255u) == 0u) { if (xb_ld(&(bar)[XB_TMO])) break; if (_sp > XB_SPIN_CAP) { atomicAdd(&(bar)[XB_TMO], 1u); break; } } } } while (0)
struct XcdBarrier { unsigned* bar; unsigned x; volatile LAS unsigned* st; };
__device__ __forceinline__ XcdBarrier xcd_barrier_post(unsigned* bar, volatile LAS unsigned* st) {
    XcdBarrier b; b.bar = bar; b.x = xb_xcc_id(); b.st = st;
    if (threadIdx.x == 0) (void)xb_add(&bar[XB_XCNT(b.x)], 1u);
    return b;
}
__device__ __forceinline__ void xcd_barrier_complete(unsigned* bar, unsigned x, unsigned& nloc, unsigned& nx) {
    const unsigned G = gridDim.x * gridDim.y * gridDim.z;
    unsigned sum, cnt, mine, sp = 0u;
    for (;;) {
        sum = 0u; cnt = 0u; mine = 0u;
#pragma unroll
        for (unsigned j = 0; j < 16; ++j) { const unsigned c = xb_ld(&bar[XB_XCNT(j)]); sum += c; cnt += (c > 0u) ? 1u : 0u; mine = (j == x) ? c : mine; }
        if (sum == G) break;
        __builtin_amdgcn_s_sleep(1);
        if ((++sp & 255u) == 0u) { if (xb_ld(&bar[XB_TMO])) break; if (sp > XB_SPIN_CAP) { atomicAdd(&bar[XB_TMO], 1u); break; } }
    }
    nloc = mine > 0u ? mine : 1u; nx = cnt > 0u ? cnt : 1u;
}
__device__ __forceinline__ void xcd_barrier(const XcdBarrier& b, const int wave) {
    asm volatile("s_waitcnt vmcnt(0)" ::: "memory");
    __syncthreads();
    if (wave == 0 && hw_lane() == 0) {
        unsigned* bar = b.bar;
        __builtin_amdgcn_s_waitcnt(0);
        unsigned nloc = b.st[0], nx = b.st[1];
        if (nloc == 0u) { xcd_barrier_complete(bar, b.x, nloc, nx); b.st[0] = nloc; b.st[1] = nx; }
        const unsigned old = xb_add(&bar[XB_XSUB(b.x)], 1u);
        const unsigned gen = old / nloc;
        if (old + 1u == (gen + 1u) * nloc) {
            __builtin_amdgcn_fence(__ATOMIC_RELEASE, "agent");
            asm volatile("s_waitcnt vmcnt(0)" ::: "memory");
            const unsigned og = xb_add(&bar[XB_TOP], 1u);
            const unsigned tg = og / nx;
            if (og + 1u == (tg + 1u) * nx) xb_add(&bar[XB_TOPGEN], 1u);
            else XB_SPIN(xb_ld(&bar[XB_TOPGEN]) == tg, bar);
            __builtin_amdgcn_fence(__ATOMIC_ACQUIRE, "agent");
            xb_add(&bar[XB_XGEN(b.x)], 1u);
            asm volatile("s_waitcnt vmcnt(0)" ::: "memory");
        } else {
            XB_SPIN(xb_ld(&bar[XB_XGEN(b.x)]) == gen, bar);
            __builtin_amdgcn_fence(__ATOMIC_ACQUIRE, "agent");
            asm volatile("s_waitcnt vmcnt(0)" ::: "memory");
        }
    }
    __syncthreads();
}

struct Frame {
    LAS unsigned char* lds;
    volatile LAS unsigned* MISC;
    gu32* ctl;
    int vcu, G, wave;
    const float *x, *norm_w, *w_in, *conv_w, *conv_b, *qw, *kw, *rel_bias, *w_out; float* out;
    bf16 *WinT, *WoutT, *XN, *Q, *K, *V, *ZG, *OP4, *OP16, *Y;
    float *TBG, *LP4, *LP16, *SBT, *SBG;
};
__device__ __forceinline__ float wave_sum(float v) {
#pragma unroll
    for (int o = 1; o < 64; o <<= 1) v += __shfl_xor(v, o);
    return v;
}
__device__ __forceinline__ float wave_max(float v) {
#pragma unroll
    for (int o = 1; o < 64; o <<= 1) v = fmaxf(v, __shfl_xor(v, o));
    return v;
}
__device__ __forceinline__ int win_row(int L) {
    int pn, wc, bj, n, fq, reg;
    if (L < 2048) { const int which = L >> 9, ch = L & 511; pn = ch >> 6; wc = (ch >> 4) & 3; fq = (ch >> 2) & 3; reg = ch & 3; bj = which >> 1; n = which & 1; }
    else { const int Lp = L - 2048, grp = Lp >> 9, head = (Lp >> 6) & 7, e = Lp & 63; pn = 8 + 2 * grp + (head >> 2); wc = head & 3; bj = e >> 5; fq = (e >> 3) & 3; n = (e >> 2) & 1; reg = e & 3; }
    return pn * 256 + 128 * bj + 32 * wc + 16 * n + 4 * fq + reg;
}
template <bool PERMUTE>
__device__ __forceinline__ void p0_transpose_item(const float* W, int K, int N, bf16* WT, LAS float* scr, int item, int lane) {
    const int nblk = N / 32, kb = item / nblk, nb = item % nblk, k0 = 64 * kb, n0 = 32 * nb;
#pragma unroll 8
    for (int i = 0; i < 32; ++i) { const int kk = 2 * i + (lane >> 5); scr[kk * 33 + (lane & 31)] = W[(size_t)(k0 + kk) * N + n0 + (lane & 31)]; }
    LDS_WAIT(); asm volatile("" ::: "memory");
    const int c = lane & 7;
#pragma unroll
    for (int j = 0; j < 4; ++j) { const int n = (lane >> 3) + 8 * j; const LAS float* s = scr + (8 * c) * 33 + n;
        v4u o; o.x = pk2(s[0 * 33], s[1 * 33]); o.y = pk2(s[2 * 33], s[3 * 33]); o.z = pk2(s[4 * 33], s[5 * 33]); o.w = pk2(s[6 * 33], s[7 * 33]);
        const int dr = PERMUTE ? win_row(n0 + n) : (n0 + n);
        *(GAS v4u*)(WT + (size_t)dr * K + k0 + 8 * c) = o; }
    LDS_WAIT(); asm volatile("" ::: "memory");
}
__device__ __forceinline__ int t5_bucket(int rel) {
    const int n = rel < 0 ? -rel : rel; int b = rel > 0 ? 16 : 0;
    if (n < 8) return b + n;
    int large = 8 + (int)(logf((float)n / 8.f) / logf(128.f) * 8.f);
    if (large > 15) large = 15;
    return b + large;
}
__device__ __forceinline__ void p0_prologue(Frame& F) {
    const int lane_l = hw_lane(), wave_l = F.wave, tid_l = wave_l * 64 + lane_l;
    LAS float* scr = (LAS float*)(F.lds + RING_OFF + wave_l * 16384);
    const int gw = F.vcu * NWAVES + wave_l, NGW = F.G * NWAVES;
    constexpr int I_IN = (D_MODEL / 64) * (NPROJ / 32), I_OUT = (D_MODEL / 64) * (D_MODEL / 32);
    for (int it = gw; it < I_IN + I_OUT; it += NGW) {
        if (it < I_IN) p0_transpose_item<true>(F.w_in, D_MODEL, NPROJ, F.WinT, scr, it, lane_l);
        else p0_transpose_item<false>(F.w_out, D_MODEL, D_MODEL, F.WoutT, scr, it - I_IN, lane_l);
    }
    f32x4 nw[4];
#pragma unroll
    for (int j = 0; j < 4; ++j) nw[j] = ((const f32x4*)F.norm_w)[lane_l + 64 * j];
    for (int m = gw; m < M; m += NGW) {
        const GAS f32x4* xr = (const GAS f32x4*)(F.x + (size_t)m * D_MODEL) + lane_l;
        f32x4 v[4]; float s = 0.f;
#pragma unroll
        for (int j = 0; j < 4; ++j) { v[j] = __builtin_nontemporal_load(xr + 64 * j); s += (v[j].x * v[j].x + v[j].y * v[j].y) + (v[j].z * v[j].z + v[j].w * v[j].w); }
        const float rstd = 1.f / sqrtf(wave_sum(s) * (1.f / D_MODEL) + 1e-6f);
        GAS unsigned long long* o8 = (GAS unsigned long long*)(F.XN + (size_t)m * D_MODEL) + lane_l;
#pragma unroll
        for (int j = 0; j < 4; ++j) { const f32x4 y = v[j] * rstd * nw[j]; o8[64 * j] = (unsigned long long)pk2(y.x, y.y) | ((unsigned long long)pk2(y.z, y.w) << 32); }
    }
    if (blockIdx.x == 0) {
        const float mq = wave_max(fabsf(F.qw[lane_l])), mk = wave_max(fabsf(F.kw[lane_l]));
        float mb = 0.f;
#pragma unroll
        for (int j = 0; j < 4; ++j) mb = fmaxf(mb, fabsf(F.rel_bias[lane_l + 64 * j]));
        mb = wave_max(mb);
        const float M2 = (8.f * mq * mk + mb) * 1.4426950408889634f;
        for (int i = tid_l; i < 3 * 8 * 192; i += NWAVES * 64) {
            const int jp = i % 192, h = (i / 192) & 7, c = i / (192 * 8), j = jp - 32;
            const int dil = c == 0 ? 1 : (c == 1 ? 4 : 16);
            float v = -1e30f;
            if (j >= 0 && j <= 128) v = F.rel_bias[t5_bucket((j - 64) * dil) * 8 + h] * 1.4426950408889634f - M2;
            F.TBG[i] = v;
        }
    }
}

__device__ __forceinline__ int crow(int r, int hi) { return (r & 3) + 8 * (r >> 2) + 4 * hi; }
__device__ __forceinline__ unsigned cvtpk_s(float lo, float hi) { typedef float f2 __attribute__((ext_vector_type(2))); typedef __bf16 b2 __attribute__((ext_vector_type(2))); f2 v = {lo, hi}; b2 b = __builtin_convertvector(v, b2); return __builtin_bit_cast(unsigned, b); }
typedef short v4i16_t __attribute__((ext_vector_type(4)));
__device__ __forceinline__ s16x4 vtr(LAS const unsigned char* p) { return __builtin_bit_cast(s16x4, __builtin_amdgcn_ds_read_tr16_b64_v4i16((LAS v4i16_t*)p)); }

__device__ __forceinline__ void conv_fixup_item(Frame& F, int idx, int lane) {
    const int ridx = idx >> 3, ch = (idx & 7) * 64 + lane, pm = ridx >> 1, last = ridx & 1;
    const bool hasp = last || (pm % (SEQ / 256) != 0), hasn = !last || (pm % (SEQ / 256) != SEQ / 256 - 1);
    const float tc = F.SBT[(size_t)(pm * 4 + (last ? 3 : 0)) * 512 + ch];
    const float tp = last ? F.SBT[(size_t)(pm * 4 + 2) * 512 + ch] : F.SBT[(size_t)((hasp ? pm - 1 : pm) * 4 + 3) * 512 + ch];
    const float tn = last ? F.SBT[(size_t)((hasn ? pm + 1 : pm) * 4 + 0) * 512 + ch] : F.SBT[(size_t)(pm * 4 + 1) * 512 + ch];
    const float g = F.SBG[(size_t)(pm * 2 + last) * 512 + ch];
    const float y = g * (F.conv_w[ch] * (hasp ? tp : 0.f) + F.conv_w[512 + ch] * tc + F.conv_w[1024 + ch] * (hasn ? tn : 0.f) + F.conv_b[ch]);
    F.Y[(size_t)(pm * 256 + (last ? 255 : 0)) * D_MODEL + ch] = (bf16)f2bf(y);
}
constexpr int AT_TILE = 8448, AT_KCH = 528, AT_VOFF = 4224, AT_VPC = 1056, AT_NT = 12;
constexpr int AT_OST = AT_NT * AT_TILE;
constexpr int AT_TBL = AT_OST + NWAVES * 4096;
constexpr int AT_LW = AT_TBL + 768;
static_assert(AT_LW + NWAVES * 128 <= LDSCTL_OFF, "attention LDS map");
struct TaskD { int dil, L, i0, hq, c, h, tok0, sb, start; };
template <bool FINAL>
__device__ __forceinline__ TaskD unit_decode(int vcu, int i) {
    TaskD D; const int x = vcu >> 5, j = vcu & 31;
    int pair, r, blk;
    if (FINAL) { pair = 2 * x + 1 - (i >> 1);     r = 0; blk = 2 * j + (i & 1); D.c = 0; D.dil = 1; D.L = SEQ; }
    else { pair = 2 * x + (i >> 2); const int k = i & 3;
        if (j < 16) { D.c = 1; D.dil = 4; D.L = SEQ / 4; r = j >> 2; blk = 4 * (j & 3) + k; } else { D.c = 2; D.dil = 16; D.L = SEQ / 16; r = j - 16; blk = k; } }
    D.h = pair & 7; D.hq = D.h * 64; D.tok0 = (pair >> 3) * SEQ + r; D.i0 = blk * 256;
    D.sb = 4 * ((2 * blk) % 3);
    D.start = FINAL ? ((i & 1) == 0) : ((i & 3) == 0);
    return D;
}
#define AT_BAR() do { asm volatile("s_waitcnt lgkmcnt(0)" ::: "memory"); __builtin_amdgcn_s_barrier(); asm volatile("" ::: "memory"); } while (0)
template <bool FINAL>
__device__ __forceinline__ void attn_units(Frame& F) {
    constexpr int u0 = 0, u1 = FINAL ? 4 : 8;
    const int lane = hw_lane(), w = F.wave, tid_l = w * 64 + lane, r32 = lane & 31, hi = lane >> 5;
    LAS unsigned char* L0 = F.lds;
    LAS unsigned short* stgb = (LAS unsigned short*)(F.lds + AT_OST + w * 4096);
    LAS float* tbl = (LAS float*)(F.lds + AT_TBL);
    LAS float* lw = (LAS float*)(F.lds + AT_LW) + w * 32;
    const int vaddr = AT_VOFF + ((lane >> 4) & 1) * 32 + (lane & 3) * 8 + (4 * hi + ((lane & 15) >> 2)) * 64;
    const bool isV = w >= 4; const int srow = 8 * (w & 3) + (lane >> 3), sch = lane & 7;
    const int sdst = isV ? (AT_VOFF + (sch >> 2) * (2 * AT_VPC) + (srow >> 4) * AT_VPC + (srow & 15) * 64 + (sch & 3) * 16) : (sch * AT_KCH + srow * 16);
    const bf16* ssrc = isV ? F.V : F.K;
    bf16x8 st[AT_NT], qr[4];
#define STAGE_LOAD(D_) do { _Pragma("unroll") for (int t_ = 0; t_ < AT_NT; ++t_) if (t_ >= 4 || (D_).start) { int key_ = (D_).i0 - 64 + 32 * t_ + srow; key_ = key_ < 0 ? 0 : (key_ > (D_).L - 1 ? (D_).L - 1 : key_); \
        st[t_] = *(const bf16x8*)(ssrc + (unsigned)(((D_).tok0 + (D_).dil * key_) * AW + (D_).hq + sch * 8)); } } while (0)
#define LOADQN(D_) do { const unsigned qo_ = (unsigned)(((D_).tok0 + (D_).dil * ((D_).i0 + 32 * w + r32)) * AW + (D_).hq + hi * 8); \
        _Pragma("unroll") for (int d0 = 0; d0 < 4; ++d0) qr[d0] = *(const bf16x8*)(F.Q + qo_ + d0 * 16); } while (0)
#define SBAR() __builtin_amdgcn_sched_barrier(0)
#define TSLOT(kc) ((sw0 + (kc)) >= 12 ? (sw0 + (kc)) - 12 : (sw0 + (kc)))
#define LDK(kc, KF) do { const LAS unsigned char* tk_ = L0 + TSLOT(kc) * AT_TILE + hi * AT_KCH + r32 * 16; \
        _Pragma("unroll") for (int d0 = 0; d0 < 4; ++d0) KF[d0] = *(const LAS bf16x8*)(tk_ + 2 * d0 * AT_KCH); } while (0)
#define LDT(kc, A) do { const int k0_ = i0w - 64 + 32 * (kc);     \
        const LAS float* tp_ = tbl + ((k0_ >= 0 && k0_ < D.L) ? (32 + 32 * (kc) + 4 * hi - r32) : 0); \
        _Pragma("unroll") for (int rr = 0; rr < 16; ++rr) A[rr] = tp_[(rr & 3) + 8 * (rr >> 2)]; } while (0)
#define LDVH(kc, h) do { const LAS unsigned char* vb_ = L0 + TSLOT(kc) * AT_TILE + vaddr; \
        _Pragma("unroll") for (int pc = 2 * (h); pc < 2 * (h) + 2; ++pc) { vl[pc] = vtr(vb_ + pc * AT_VPC); vh[pc] = vtr(vb_ + pc * AT_VPC + 512); } } while (0)
#define LDV(kc) do { LDVH(kc, 0); LDVH(kc, 1); } while (0)
#define VFR(pc) (bf16x8){vl[pc][0], vl[pc][1], vl[pc][2], vl[pc][3], vh[pc][0], vh[pc][1], vh[pc][2], vh[pc][3]}
#define SMM(KF, A) do { _Pragma("unroll") for (int d0 = 0; d0 < 4; ++d0) A = __builtin_amdgcn_mfma_f32_32x32x16_bf16(KF[d0], qr[d0], A, 0, 0, 0); } while (0)
#define EXPK(A) do { _Pragma("unroll") for (int rr = 0; rr < 16; ++rr) A[rr] = __builtin_amdgcn_exp2f(A[rr]); \
        ls0 += (A[0] + A[1]) + (A[2] + A[3]); ls1 += (A[4] + A[5]) + (A[6] + A[7]); ls2 += (A[8] + A[9]) + (A[10] + A[11]); ls3 += (A[12] + A[13]) + (A[14] + A[15]); \
        pw0.x = cvtpk_s(A[0], A[1]); pw0.y = cvtpk_s(A[2], A[3]); pw0.z = cvtpk_s(A[4], A[5]); pw0.w = cvtpk_s(A[6], A[7]); \
        pw1.x = cvtpk_s(A[8], A[9]); pw1.y = cvtpk_s(A[10], A[11]); pw1.z = cvtpk_s(A[12], A[13]); pw1.w = cvtpk_s(A[14], A[15]); } while (0)
#define PVM() do { \
        o0 = __builtin_amdgcn_mfma_f32_32x32x16_bf16(__builtin_bit_cast(bf16x8, pw0), VFR(0), o0, 0, 0, 0); \
        o0 = __builtin_amdgcn_mfma_f32_32x32x16_bf16(__builtin_bit_cast(bf16x8, pw1), VFR(1), o0, 0, 0, 0); \
        o1 = __builtin_amdgcn_mfma_f32_32x32x16_bf16(__builtin_bit_cast(bf16x8, pw0), VFR(2), o1, 0, 0, 0); \
        o1 = __builtin_amdgcn_mfma_f32_32x32x16_bf16(__builtin_bit_cast(bf16x8, pw1), VFR(3), o1, 0, 0, 0); } while (0)
#define CHUNK1(kc) do { LDVH(kc, 0); SBAR(); SMM(kf, aA); SBAR(); LDVH(kc, 1); if ((kc) < 4) { LDK((kc) + 1, kf); SBAR(); } else { LOADQN(Dn); SBAR(); } EXPK(aA); SBAR(); if ((kc) < 4) { LDT((kc) + 1, aA); SBAR(); } PVM(); SBAR(); } while (0)
#define CHUNKS() do { LDK(0, kf); LDT(0, aA); SBAR(); CHUNK1(0); CHUNK1(1); CHUNK1(2); CHUNK1(3); CHUNK1(4); } while (0)
    TaskD D = unit_decode<FINAL>(F.vcu, u0);
    STAGE_LOAD(D); LOADQN(D);
    if (!FINAL) { for (int idx = F.vcu * NWAVES + w; idx < 8 * 2 * (M / 256); idx += F.G * NWAVES) conv_fixup_item(F, idx, lane); }
    int tb_ch = -1;
    for (int u = u0; u < u1; ++u) {
        const TaskD Dn = unit_decode<FINAL>(F.vcu, u + 1 < u1 ? u + 1 : u);
        AT_BAR();
#pragma unroll
        for (int t_ = 0; t_ < AT_NT; ++t_) if (t_ >= 4 || D.start) { int sl_ = D.sb + t_; sl_ = sl_ >= 12 ? sl_ - 12 : sl_; *(LAS bf16x8*)(L0 + sl_ * AT_TILE + sdst) = st[t_]; }
        if (tb_ch != D.c * 8 + D.h) { tb_ch = D.c * 8 + D.h; if (tid_l < 192) tbl[tid_l] = F.TBG[tb_ch * 192 + tid_l]; }
        AT_BAR();
        STAGE_LOAD(Dn);
        const int i0w = D.i0 + 32 * w; const int sw0 = (D.sb + w) >= 12 ? D.sb + w - 12 : D.sb + w;
        v4u p4[4], p16[4], zg[4]; float l4[4], l16[4];
#define FIN_LOAD(i) do { const int row = (i) * 8 + (lane >> 3), ch = lane & 7; const unsigned tok = (unsigned)(D.tok0 + i0w + row); const unsigned eo = tok * AW + D.hq + ch * 8; \
            p4[i] = __builtin_nontemporal_load((const v4u*)(F.OP4 + eo)); p16[i] = __builtin_nontemporal_load((const v4u*)(F.OP16 + eo)); zg[i] = __builtin_nontemporal_load((const v4u*)(F.ZG + eo)); l4[i] = F.LP4[tok + (7 * (D.tok0 / SEQ) + D.h) * SEQ]; l16[i] = F.LP16[tok + (7 * (D.tok0 / SEQ) + D.h) * SEQ]; } while (0)
        if (false) { FIN_LOAD(0); }
        f32x16 o0 = {}, o1 = {}, aA; float ls0 = 0.f, ls1 = 0.f, ls2 = 0.f, ls3 = 0.f; bf16x8 kf[4]; s16x4 vl[4], vh[4]; v4u pw0, pw1;
        CHUNKS();
        float lsum = (ls0 + ls1) + (ls2 + ls3);
        lsum += __shfl_xor(lsum, 32);
#pragma unroll
        for (int rr = 0; rr < 16; rr += 2) {
            const unsigned a01 = cvtpk_s(o0[rr], o0[rr + 1]), b01 = cvtpk_s(o1[rr], o1[rr + 1]);
            const int q0 = crow(rr, hi), q1 = crow(rr + 1, hi);
            stgb[q0 * 64 + r32] = (unsigned short)(a01 & 0xffffu); stgb[q1 * 64 + r32] = (unsigned short)(a01 >> 16);
            stgb[q0 * 64 + 32 + r32] = (unsigned short)(b01 & 0xffffu); stgb[q1 * 64 + 32 + r32] = (unsigned short)(b01 >> 16);
        }
        if (FINAL) { if (hi == 0) lw[r32] = lsum; FIN_LOAD(0); FIN_LOAD(1); FIN_LOAD(2); FIN_LOAD(3); }
        else { if (hi == 0) { float* lp = F.LP4 + (size_t)(D.c - 1) * (size_t)(256u << 10) + (unsigned)((D.tok0 + D.dil * (i0w + r32)) + (7 * (D.tok0 / SEQ) + D.h) * SEQ); *lp = lsum;     } }
#pragma unroll
        for (int i = 0; i < 4; ++i) {
            const int row = i * 8 + (lane >> 3), ch = lane & 7;
            const unsigned tok = (unsigned)(D.tok0 + D.dil * (i0w + row));
            const v4u ov = *(const LAS v4u*)(stgb + row * 64 + ch * 8);
            if (!FINAL) {
                *(v4u*)(F.OP4 + (size_t)(D.c - 1) * (size_t)(16u << 20) + (tok * AW + D.hq + ch * 8)) = ov;
            } else {
                const float inv = 1.f / (lw[row] + l4[i] + l16[i]);
                float y[8];
#define SZ(x) pg8::silu_f(x)
                y[0] = (bflo(ov.x) + bflo(p4[i].x) + bflo(p16[i].x)) * inv * SZ(bflo(zg[i].x)); y[1] = (bfhi(ov.x) + bfhi(p4[i].x) + bfhi(p16[i].x)) * inv * SZ(bfhi(zg[i].x));
                y[2] = (bflo(ov.y) + bflo(p4[i].y) + bflo(p16[i].y)) * inv * SZ(bflo(zg[i].y)); y[3] = (bfhi(ov.y) + bfhi(p4[i].y) + bfhi(p16[i].y)) * inv * SZ(bfhi(zg[i].y));
                y[4] = (bflo(ov.z) + bflo(p4[i].z) + bflo(p16[i].z)) * inv * SZ(bflo(zg[i].z)); y[5] = (bfhi(ov.z) + bfhi(p4[i].z) + bfhi(p16[i].z)) * inv * SZ(bfhi(zg[i].z));
                y[6] = (bflo(ov.w) + bflo(p4[i].w) + bflo(p16[i].w)) * inv * SZ(bflo(zg[i].w)); y[7] = (bfhi(ov.w) + bfhi(p4[i].w) + bfhi(p16[i].w)) * inv * SZ(bfhi(zg[i].w));
#undef SZ
                v4u wv; wv.x = cvtpk_s(y[0], y[1]); wv.y = cvtpk_s(y[2], y[3]); wv.z = cvtpk_s(y[4], y[5]); wv.w = cvtpk_s(y[6], y[7]);
                *(v4u*)(F.Y + (tok * D_MODEL + 512 + D.hq + ch * 8)) = wv;
            }
        }
        D = Dn;
    }
    AT_BAR();
#undef STAGE_LOAD
#undef LOADQN
#undef SBAR
#undef LDK
#undef TSLOT
#undef LDT
#undef LDV
#undef LDVH
#undef VFR
#undef SMM
#undef EXPK
#undef PVM
#undef CHUNK1
#undef CHUNKS
#undef FIN_LOAD
}
__device__ __forceinline__ void attn_pass_a(Frame& F) {
    attn_units<false>(F);
}
__device__ __forceinline__ void attn_pass_b(Frame& F) {
    attn_units<true>(F);
}

struct Args { const float* in[9]; float* out; unsigned char* ws; int ph_lo, ph_hi; };
__global__ void __launch_bounds__(NWAVES * 64, 2) mega(Args args) {
    extern __shared__ __attribute__((aligned(16))) unsigned char lds[];
    Frame F;
    F.lds = (LAS unsigned char*)lds;
    F.MISC = (volatile LAS unsigned*)(F.lds + MISC_OFF);
    F.wave = __builtin_amdgcn_readfirstlane((int)threadIdx.x >> 6); F.G = gridDim.x; { const int bx = blockIdx.x; F.vcu = (F.G % 8 == 0) ? (bx % 8) * (F.G / 8) + bx / 8 : bx; }
    unsigned char* ws = args.ws;
    F.ctl = (gu32*)(ws + WS_CTL);
    F.x = args.in[0]; F.norm_w = args.in[1]; F.w_in = args.in[2]; F.conv_w = args.in[3]; F.conv_b = args.in[4]; F.qw = args.in[5]; F.kw = args.in[6]; F.rel_bias = args.in[7]; F.w_out = args.in[8];
    F.out = args.out;
    F.WinT = (bf16*)(ws + WS_WIN); F.WoutT = (bf16*)(ws + WS_WOUT); F.XN = (bf16*)(ws + WS_XN);
    F.SBT = (float*)(ws + WS_SBT); F.SBG = (float*)(ws + WS_SBG); F.Q = (bf16*)(ws + WS_Q); F.K = (bf16*)(ws + WS_K); F.V = (bf16*)(ws + WS_V); F.ZG = (bf16*)(ws + WS_ZG);
    F.OP4 = (bf16*)(ws + WS_OP4); F.OP16 = (bf16*)(ws + WS_OP16); F.Y = (bf16*)(ws + WS_Y);
    F.TBG = (float*)(ws + WS_TBG); F.LP4 = (float*)(ws + WS_LP4); F.LP16 = (float*)(ws + WS_LP16);
    for (int u = threadIdx.x; u < (LDS_BYTES - LDSCTL_OFF) / 4; u += NWAVES * 64) ((LAS unsigned*)(F.lds + LDSCTL_OFF))[u] = 0u;
    __syncthreads();
    const int lo = args.ph_lo, hi = args.ph_hi;
    const bool multi = (hi - lo) > 1;
    XcdBarrier bar; bar.bar = (unsigned*)(F.ctl + CW_BAR); bar.x = 0; bar.st = nullptr;
    if (multi) bar = xcd_barrier_post((unsigned*)(F.ctl + CW_BAR), F.MISC + 8);
#define IN(k) (lo <= (k) && (k) < hi)
#define BOTH(k) (IN(k) && IN((k) + 1))
    if (IN(0)) { p0_prologue(F); if (BOTH(0)) xcd_barrier(bar, F.wave); }
    if (IN(1)) {
        pg8::Gemm g{F.XN, F.WinT, M, NPROJ, D_MODEL}; pg8::StaticOrder S; S.init(M, NPROJ, F.G, (int)blockIdx.x);
        { LAS float* cwl = (LAS float*)(F.lds + XL_OFF + 2048);
          const int tl = F.wave * 64 + hw_lane();
          for (int i = tl; i < 2048; i += NWAVES * 64) cwl[i] = i < 1536 ? F.conv_w[i] : F.conv_b[i - 1536];
          if (tl < 128) cwl[2048 + tl] = tl < 64 ? F.qw[tl] : F.kw[tl - 64];
          __syncthreads(); }
        pg8::EpiProj E{F.Y, F.Q, F.SBT, F.SBG, F.lds + XL_OFF};
        pg8::gemm_phase<pg8::EpiProj, pg8::StaticOrder, true, true>(F.lds + RING_OFF, g, S, E, F.wave);
        if (BOTH(1)) xcd_barrier(bar, F.wave);
    }
    if (IN(2)) { attn_pass_a(F); if (BOTH(2)) xcd_barrier(bar, F.wave); }
    if (IN(3)) { attn_pass_b(F); if (BOTH(3)) xcd_barrier(bar, F.wave); }
    if (IN(4)) {
        pg8::Gemm g{F.Y, F.WoutT, M, D_MODEL, D_MODEL}; pg8::StaticOrder S; S.init(M, D_MODEL, F.G, (int)blockIdx.x);
        pg8::EpiRes E{F.x, F.out, D_MODEL};
        pg8::gemm_phase<pg8::EpiRes, pg8::StaticOrder, true, true>(F.lds + RING_OFF, g, S, E, F.wave);
    }
#undef IN
#undef BOTH
}

extern "C" void kernel_launch(void* const* d_in, const int* in_sizes, int n_in, void* d_out, int out_size, void* d_ws, size_t ws_size, hipStream_t stream) {
    static int grid = 0;
    if (grid == 0) {
        if (n_in != 9 || in_sizes[0] != M * D_MODEL || out_size != M * D_MODEL || ws_size < WS_END) { fprintf(stderr, "kernel_launch: unexpected shapes (n_in %d, in0 %d, out %d, ws %zu)\n", n_in, n_in > 0 ? in_sizes[0] : -1, out_size, ws_size); grid = -1; return; }
        int dev = 0, cus = 0, per_cu = 0;
        if (hipGetDevice(&dev) != hipSuccess || hipDeviceGetAttribute(&cus, hipDeviceAttributeMultiprocessorCount, dev) != hipSuccess) { grid = -1; return; }
        if (hipFuncSetAttribute((const void*)mega, hipFuncAttributeMaxDynamicSharedMemorySize, LDS_BYTES) != hipSuccess) { fprintf(stderr, "kernel_launch: hipFuncSetAttribute failed\n"); grid = -1; return; }
        if (hipOccupancyMaxActiveBlocksPerMultiprocessor(&per_cu, (const void*)mega, NWAVES * 64, LDS_BYTES) != hipSuccess || per_cu < 1) { fprintf(stderr, "kernel_launch: occupancy query says %d blocks per CU\n", per_cu); (void)hipGetLastError(); grid = -1; return; }
        grid = cus;
        if (grid != 256) { fprintf(stderr, "kernel_launch: built for a 256-CU device (got %d CUs)\n", cus); grid = -1; return; }
    }
    if (grid < 0) return;
    (void)hipMemsetAsync((char*)d_ws + WS_CTL, 0, CTL_ZERO_BYTES, stream);
    Args a{};
    for (int i = 0; i < 9; ++i) a.in[i] = (const float*)d_in[i];
    a.out = (float*)d_out; a.ws = (unsigned char*)d_ws;
    unsigned char* ws = (unsigned char*)d_ws;
#if STAGE == 4
    a.ph_lo = 0; a.ph_hi = 5;
    hipLaunchKernelGGL(mega, dim3(grid), dim3(NWAVES * 64), LDS_BYTES, stream, a);
    if (PROBE_PHASE >= 0) { a.ph_lo = PROBE_PHASE; a.ph_hi = PROBE_PHASE + 1; hipLaunchKernelGGL(mega, dim3(grid), dim3(NWAVES * 64), LDS_BYTES, stream, a); }
#else
    const int nper = 5;
    for (int p = 0; p < nper; ++p) { a.ph_lo = p; a.ph_hi = p + 1; hipLaunchKernelGGL(mega, dim3(grid), dim3(NWAVES * 64), LDS_BYTES, stream, a); }
#endif
}
```
